# Optimizing an MI355X kernel written in HIP

```python
import math
import jax, jax.numpy as jnp
from jax import lax
import numpy as np

D_MODEL = 1024
BATCH = 2
SEQ = 16384
DEPTH = 2

GDN_HEADS = 8
GDN_HEAD_DIM = 64
GDN_WIDTH = GDN_HEADS * GDN_HEAD_DIM
GDN_CONV = 4
GDN_CHUNK = 64
MLA_HEADS = 8
MLA_Q_RANK = 256
MLA_KV_RANK = 128
MLA_NOPE = 64
MLA_ROPE = 32
MLA_QK = MLA_NOPE + MLA_ROPE
MLA_V = 64
MLA_WIDTH = MLA_HEADS * MLA_V
ROPE_THETA = 10000.0
Q_BLOCK = 128
NEG_INF = -1e30
IN_SPLITS = (GDN_WIDTH, GDN_WIDTH, GDN_WIDTH, GDN_WIDTH, GDN_HEADS, GDN_HEADS, MLA_Q_RANK, MLA_KV_RANK, MLA_ROPE)
IN_COLS = sum(IN_SPLITS)
MIX_WIDTH = GDN_WIDTH + MLA_WIDTH
RWKV_HEADS = 16
RWKV_HEAD_DIM = 64
DECAY_LORA = 64
AAA_LORA = 64
GATE_LORA = 160
RWKV_GN_EPS = 64e-5
D_FF = 4 * D_MODEL
EPS = 1e-6

kernel_name = "hybrid_gdn_mla_rwkv7_adaln"


def rms_norm(t):
    tf = t.astype(jnp.float32)
    return (tf * lax.rsqrt(jnp.mean(tf * tf, axis=-1, keepdims=True) + EPS)).astype(t.dtype)


def l2_normalize(t):
    tf = t.astype(jnp.float32)
    return (tf * lax.rsqrt(jnp.sum(tf * tf, axis=-1, keepdims=True) + 1e-12)).astype(t.dtype)


def adaln(t, shift, scale):
    return rms_norm(t) * (1 + scale[:, None, :]) + shift[:, None, :]


def split_columns(t, sizes):
    offsets = []
    total = 0
    for s in sizes[:-1]:
        total += s
        offsets.append(total)
    return jnp.split(t, offsets, axis=-1)


def causal_depthwise_conv(t, w):
    K = w.shape[0]
    S = t.shape[1]
    tp = jnp.pad(t, ((0, 0), (K - 1, 0), (0, 0)))
    out = tp[:, 0:S] * w[0]
    for j in range(1, K):
        out = out + tp[:, j:j + S] * w[j]
    return out


def rope_tables(positions):
    inv_freq = ROPE_THETA ** (-jnp.arange(0, MLA_ROPE, 2, dtype=jnp.float32) / MLA_ROPE)
    ang = positions.astype(jnp.float32)[..., None] * inv_freq
    return jnp.cos(ang)[:, :, None, :], jnp.sin(ang)[:, :, None, :]


def apply_rope_tail(t, cos, sin):
    t_pass, t_rot = t[..., :MLA_NOPE], t[..., MLA_NOPE:]
    x1, x2 = jnp.split(t_rot.astype(jnp.float32), 2, axis=-1)
    rot = jnp.concatenate([x1 * cos - x2 * sin, x2 * cos + x1 * sin], axis=-1).astype(t.dtype)
    return jnp.concatenate([t_pass, rot], axis=-1)


def chunked_gated_delta_rule(q, k, v, g, beta):
    B, S, H, Dk = q.shape
    Dv = v.shape[-1]
    C = GDN_CHUNK
    N = S // C
    f32 = jnp.float32

    def to_chunks(t):
        t = t.astype(f32).reshape((B, N, C, H) + t.shape[3:])
        return jnp.moveaxis(t, 3, 1)

    q = to_chunks(q) * (Dk ** -0.5)
    k = to_chunks(k)
    v = to_chunks(v)
    beta = to_chunks(beta)
    g = jnp.cumsum(to_chunks(g), axis=-1)
    causal = jnp.tril(jnp.ones((C, C), dtype=bool))
    strict = jnp.tril(jnp.ones((C, C), dtype=bool), -1)
    gdiff = g[..., :, None] - g[..., None, :]
    decay = jnp.where(causal, jnp.exp(jnp.where(causal, gdiff, 0.0)), 0.0)
    k_beta = k * beta[..., None]
    L = jnp.where(strict, jnp.einsum('bhnid,bhnjd->bhnij', k_beta, k) * decay, 0.0)
    eye = jnp.eye(C, dtype=f32)
    T = lax.linalg.triangular_solve(eye + L, jnp.broadcast_to(eye, L.shape),
                                    left_side=True, lower=True, unit_diagonal=True)
    u = T @ (v * beta[..., None])
    w = T @ (k_beta * jnp.exp(g)[..., None])
    qk = jnp.where(causal, jnp.einsum('bhnid,bhnjd->bhnij', q, k) * decay, 0.0)
    g_last = g[..., -1]
    q_dec = q * jnp.exp(g)[..., None]
    k_dec = k * jnp.exp(g_last[..., None] - g)[..., None]

    def step(state, inp):
        q_i, k_i, w_i, u_i, qk_i, gl_i = inp
        v_new = u_i - w_i @ state
        o_i = q_i @ state + qk_i @ v_new
        state = state * jnp.exp(gl_i)[..., None, None] + jnp.swapaxes(k_i, -1, -2) @ v_new
        return state, o_i

    xs = tuple(jnp.moveaxis(t, 2, 0) for t in (q_dec, k_dec, w, u, qk, g_last))
    state0 = jnp.zeros((B, H, Dk, Dv), f32)
    _, o = lax.scan(step, state0, xs)
    return o.transpose(1, 0, 3, 2, 4).reshape(B, S, H, Dv)


def causal_block_attention(q, k, v):
    B, S, H, Dqk = q.shape
    Dv = v.shape[-1]
    nb = S // Q_BLOCK
    q_blocks = jnp.moveaxis(q.reshape(B, nb, Q_BLOCK, H, Dqk), 1, 0)
    key_pos = jnp.arange(S)
    scale = Dqk ** -0.5

    def one_block(args):
        q_blk, blk = args
        s = jnp.einsum('bqhd,bkhd->bhqk', q_blk, k, preferred_element_type=jnp.float32) * scale
        query_pos = blk * Q_BLOCK + jnp.arange(Q_BLOCK)
        s = jnp.where(key_pos[None, :] <= query_pos[:, None], s, NEG_INF)
        p = jax.nn.softmax(s, axis=-1).astype(v.dtype)
        return jnp.einsum('bhqk,bkhd->bqhd', p, v)

    o = lax.map(one_block, (q_blocks, jnp.arange(nb)))
    return jnp.moveaxis(o, 0, 1).reshape(B, S, H, Dv)


def gdn_mla_mixer(h, cos, sin, w_in, conv_w, a_log, dt_bias, gdn_gain, q_norm_gain, kv_norm_gain,
                  w_uq, w_ukv, q_head_gain, k_head_gain, w_out):
    B, S, _ = h.shape
    proj = h @ w_in
    q, k, v, z, a, b, dq, dkv, k_rope = split_columns(proj, IN_SPLITS)
    qkv = jax.nn.silu(causal_depthwise_conv(jnp.concatenate([q, k, v], axis=-1), conv_w))
    q, k, v = jnp.split(qkv, 3, axis=-1)
    gshape = (B, S, GDN_HEADS, GDN_HEAD_DIM)
    q = l2_normalize(q.reshape(gshape))
    k = l2_normalize(k.reshape(gshape))
    v = v.reshape(gshape)
    beta = jax.nn.sigmoid(b.astype(jnp.float32))
    g = -jnp.exp(a_log.astype(jnp.float32)) * jax.nn.softplus(a.astype(jnp.float32) + dt_bias)
    o = chunked_gated_delta_rule(q, k, v, g, beta).astype(h.dtype)
    o_gdn = (rms_norm(o) * gdn_gain * jax.nn.silu(z.reshape(gshape))).reshape(B, S, GDN_WIDTH)
    q_lat = rms_norm(dq) * q_norm_gain
    qm = (q_lat @ w_uq).reshape(B, S, MLA_HEADS, MLA_QK)
    kv_lat = rms_norm(dkv) * kv_norm_gain
    kv = (kv_lat @ w_ukv).reshape(B, S, MLA_HEADS, MLA_NOPE + MLA_V)
    k_nope, vm = kv[..., :MLA_NOPE], kv[..., MLA_NOPE:]
    k_rope_h = jnp.broadcast_to(k_rope[:, :, None, :], (B, S, MLA_HEADS, MLA_ROPE))
    km = jnp.concatenate([k_nope, k_rope_h], axis=-1)
    qm = apply_rope_tail(rms_norm(qm) * q_head_gain, cos, sin)
    km = apply_rope_tail(rms_norm(km) * k_head_gain, cos, sin)
    o_mla = causal_block_attention(qm, km, vm).reshape(B, S, MLA_WIDTH)
    return jnp.concatenate([o_gdn, o_mla], axis=-1) @ w_out


def rwkv7_recurrence(r, w, k, v, a, b):
    B, S, H, N = r.shape

    def step(state, inp):
        r_t, w_t, k_t, v_t, a_t, b_t = inp
        sa = jnp.einsum('bhvk,bhk->bhv', state, a_t)
        state = (state * w_t[:, :, None, :] + sa[..., None] * b_t[:, :, None, :]
                 + v_t[..., None] * k_t[:, :, None, :])
        return state, jnp.einsum('bhvk,bhk->bhv', state, r_t)

    xs = tuple(jnp.moveaxis(t.astype(jnp.float32), 1, 0) for t in (r, w, k, v, a, b))
    _, y = lax.scan(step, jnp.zeros((B, H, N, N), jnp.float32), xs)
    return jnp.moveaxis(y, 0, 1)


def rwkv7_time_mix(h, mu, w_r, w_k, w_v, w_o, w0, w1, w2, a0, a1, a2, g1, g2,
                   k_k, k_a, r_k, ln_gain, ln_bias):
    B, S, D = h.shape
    hshape = (B, S, RWKV_HEADS, RWKV_HEAD_DIM)
    xx = jnp.pad(h[:, :-1], ((0, 0), (1, 0), (0, 0))) - h
    xr, xw, xk, xv, xa, xg = [h + xx * mu[j] for j in range(6)]
    r = xr @ w_r
    k = xk @ w_k
    v = xv @ w_v
    w_log = -jax.nn.softplus(-(w0 + jnp.tanh(xw @ w1) @ w2).astype(jnp.float32)) - 0.5
    decay = jnp.exp(-jnp.exp(w_log))
    a = jax.nn.sigmoid(a0 + (xa @ a1) @ a2)
    g = jax.nn.sigmoid(xg @ g1) @ g2
    kk = l2_normalize((k * k_k).reshape(hshape))
    k = k * (1 + (a - 1) * k_a)
    r_h, k_h, v_h, a_h = r.reshape(hshape), k.reshape(hshape), v.reshape(hshape), a.reshape(hshape)
    y = rwkv7_recurrence(r_h, decay.reshape(hshape), k_h, v_h, -kk, kk * a_h)
    mean = jnp.mean(y, axis=-1, keepdims=True)
    var = jnp.mean(jnp.square(y - mean), axis=-1, keepdims=True)
    y = ((y - mean) * lax.rsqrt(var + RWKV_GN_EPS)).reshape(B, S, D) * ln_gain + ln_bias
    bonus = jnp.sum((r_h * k_h * r_k).astype(jnp.float32), axis=-1, keepdims=True) * v_h
    y = (y + bonus.reshape(B, S, D)) * g
    return y.astype(h.dtype) @ w_o


def squared_relu_mlp(h, w_up, w_down):
    return jnp.square(jax.nn.relu(h @ w_up)) @ w_down


def setup_inputs(seed: int = 0) -> dict:
    key = jax.random.key(seed)
    keys = iter(jax.random.split(key, 48))
    f32 = jnp.float32
    n_even = (DEPTH + 1) // 2
    n_odd = DEPTH // 2

    def nrm(shape, s):
        return jax.random.normal(next(keys), shape, f32) * s

    def uni(shape, lo, hi):
        return jax.random.uniform(next(keys), shape, f32, minval=lo, maxval=hi)

    x = nrm((BATCH, SEQ, D_MODEL), 1.0)
    c = nrm((BATCH, D_MODEL), 1.0)
    positions = (jnp.arange(SEQ, dtype=jnp.int32)[None, :]
                 + jax.random.randint(next(keys), (BATCH, 1), 0, 4096, dtype=jnp.int32))
    dt = jnp.exp(uni((n_even, GDN_HEADS), math.log(1e-3), math.log(1e-1)))
    return {
        "x": x,
        "c": c,
        "positions": positions,
        "w_mod": nrm((DEPTH, D_MODEL, 6 * D_MODEL), D_MODEL ** -0.5),
        "b_mod": nrm((DEPTH, 6 * D_MODEL), 0.01),
        "w_in0": nrm((n_even, D_MODEL, IN_COLS), D_MODEL ** -0.5),
        "gdn_conv_w": nrm((n_even, GDN_CONV, 3 * GDN_WIDTH), GDN_CONV ** -0.5),
        "gdn_a_log": jnp.log(uni((n_even, GDN_HEADS), 1.0, 16.0)),
        "gdn_dt_bias": dt + jnp.log(-jnp.expm1(-dt)),
        "gdn_norm_gain": 1.0 + nrm((n_even, GDN_HEAD_DIM), 0.02),
        "mla_q_norm_gain": 1.0 + nrm((n_even, MLA_Q_RANK), 0.02),
        "mla_kv_norm_gain": 1.0 + nrm((n_even, MLA_KV_RANK), 0.02),
        "mla_w_uq": nrm((n_even, MLA_Q_RANK, MLA_HEADS * MLA_QK), MLA_Q_RANK ** -0.5),
        "mla_w_ukv": nrm((n_even, MLA_KV_RANK, MLA_HEADS * (MLA_NOPE + MLA_V)), MLA_KV_RANK ** -0.5),
        "mla_q_head_gain": 1.0 + nrm((n_even, MLA_QK), 0.02),
        "mla_k_head_gain": 1.0 + nrm((n_even, MLA_QK), 0.02),
        "w_out0": nrm((n_even, MIX_WIDTH, D_MODEL), MIX_WIDTH ** -0.5),
        "rwkv_mu": uni((n_odd, 6, D_MODEL), 0.0, 1.0),
        "rwkv_w_r": nrm((n_odd, D_MODEL, D_MODEL), D_MODEL ** -0.5),
        "rwkv_w_k": nrm((n_odd, D_MODEL, D_MODEL), D_MODEL ** -0.5),
        "rwkv_w_v": nrm((n_odd, D_MODEL, D_MODEL), D_MODEL ** -0.5),
        "rwkv_w_o": nrm((n_odd, D_MODEL, D_MODEL), D_MODEL ** -0.5),
        "rwkv_w0": uni((n_odd, D_MODEL), -6.0, -1.0),
        "rwkv_w1": nrm((n_odd, D_MODEL, DECAY_LORA), 0.1 * D_MODEL ** -0.5),
        "rwkv_w2": nrm((n_odd, DECAY_LORA, D_MODEL), 0.1 * DECAY_LORA ** -0.5),
        "rwkv_a0": nrm((n_odd, D_MODEL), 0.1),
        "rwkv_a1": nrm((n_odd, D_MODEL, AAA_LORA), 0.1 * D_MODEL ** -0.5),
        "rwkv_a2": nrm((n_odd, AAA_LORA, D_MODEL), 0.1 * AAA_LORA ** -0.5),
        "rwkv_g1": nrm((n_odd, D_MODEL, GATE_LORA), D_MODEL ** -0.5),
        "rwkv_g2": nrm((n_odd, GATE_LORA, D_MODEL), GATE_LORA ** -0.5),
        "rwkv_k_k": 0.85 + nrm((n_odd, D_MODEL), 0.02),
        "rwkv_k_a": 1.0 + nrm((n_odd, D_MODEL), 0.02),
        "rwkv_r_k": nrm((n_odd, RWKV_HEADS, RWKV_HEAD_DIM), 0.1),
        "rwkv_ln_gain": 1.0 + nrm((n_odd, D_MODEL), 0.02),
        "rwkv_ln_bias": nrm((n_odd, D_MODEL), 0.01),
        "w_up": nrm((DEPTH, D_MODEL, D_FF), D_MODEL ** -0.5),
        "w_down": nrm((DEPTH, D_FF, D_MODEL), D_FF ** -0.5),
    }


def reference(x, c, positions, w_mod, b_mod, w_in0, gdn_conv_w, gdn_a_log, gdn_dt_bias, gdn_norm_gain,
              mla_q_norm_gain, mla_kv_norm_gain, mla_w_uq, mla_w_ukv, mla_q_head_gain, mla_k_head_gain, w_out0,
              rwkv_mu, rwkv_w_r, rwkv_w_k, rwkv_w_v, rwkv_w_o, rwkv_w0, rwkv_w1, rwkv_w2,
              rwkv_a0, rwkv_a1, rwkv_a2, rwkv_g1, rwkv_g2, rwkv_k_k, rwkv_k_a, rwkv_r_k,
              rwkv_ln_gain, rwkv_ln_bias, w_up, w_down):
    cond = jax.nn.silu(c)
    cos, sin = rope_tables(positions)
    for layer in range(DEPTH):
        mod = cond @ w_mod[layer] + b_mod[layer]
        shift1, scale1, gate1, shift2, scale2, gate2 = jnp.split(mod, 6, axis=-1)
        h = adaln(x, shift1, scale1)
        i = layer // 2
        if layer % 2 == 0:
            y = gdn_mla_mixer(h, cos, sin, w_in0[i], gdn_conv_w[i], gdn_a_log[i], gdn_dt_bias[i],
                              gdn_norm_gain[i], mla_q_norm_gain[i], mla_kv_norm_gain[i], mla_w_uq[i],
                              mla_w_ukv[i], mla_q_head_gain[i], mla_k_head_gain[i], w_out0[i])
        else:
            y = rwkv7_time_mix(h, rwkv_mu[i], rwkv_w_r[i], rwkv_w_k[i], rwkv_w_v[i], rwkv_w_o[i],
                               rwkv_w0[i], rwkv_w1[i], rwkv_w2[i], rwkv_a0[i], rwkv_a1[i], rwkv_a2[i],
                               rwkv_g1[i], rwkv_g2[i], rwkv_k_k[i], rwkv_k_a[i], rwkv_r_k[i],
                               rwkv_ln_gain[i], rwkv_ln_bias[i])
        x = x + gate1[:, None, :] * y
        h = adaln(x, shift2, scale2)
        x = x + gate2[:, None, :] * squared_relu_mlp(h, w_up[layer], w_down[layer])
    return x
```

```cpp
#include <hip/hip_runtime.h>
#include <hip/hip_cooperative_groups.h>
#include <cstdint>
#include <cstdio>
namespace cg = cooperative_groups;

#ifndef ONLY
#define ONLY -1
#endif
#ifndef COOP
#define COOP 0
#endif

typedef unsigned short bf16_t;
typedef short bf16x8 __attribute__((ext_vector_type(8)));
typedef float f32x4 __attribute__((ext_vector_type(4)));
typedef float f32x2 __attribute__((ext_vector_type(2)));
typedef float f32x16 __attribute__((ext_vector_type(16)));
typedef unsigned u32x4 __attribute__((ext_vector_type(4)));
typedef unsigned u32x2 __attribute__((ext_vector_type(2)));
typedef __bf16 bf16x2_t __attribute__((ext_vector_type(2)));

constexpr int SEQ = 16384, NBATCH = 2, MTOK = NBATCH * SEQ, DM = 1024, DFF = 4096;
constexpr int PROJ_LD = 2560;
constexpr size_t MiB = 1u << 20;
constexpr size_t WS_CTL = 0;
constexpr size_t WS_MOD = 64 * 1024;
constexpr size_t WS_WT = 1 * MiB;
constexpr size_t WS_H = 64 * MiB;
constexpr size_t WS_AR = 128 * MiB;
constexpr size_t W_IN = 0;
constexpr size_t W_UQ = W_IN + (size_t)2560 * 1024;
constexpr size_t W_UKV = W_UQ + (size_t)768 * 256;
constexpr size_t W_OUT = W_UKV + (size_t)1024 * 128;
constexpr size_t W_RKV = W_OUT + (size_t)1024 * 1024;
constexpr size_t W_W2 = W_RKV + (size_t)3456 * 2048;
constexpr size_t W_A2 = W_W2 + (size_t)1024 * 64;
constexpr size_t W_G2 = W_A2 + (size_t)1024 * 64;
constexpr size_t W_O = W_G2 + (size_t)1024 * 192;
constexpr size_t W_UP0 = W_O + (size_t)1024 * 1024;
constexpr size_t W_UP1 = W_UP0 + (size_t)4096 * 1024;
constexpr size_t W_DN0 = W_UP1 + (size_t)4096 * 1024;
constexpr size_t W_DN1 = W_DN0 + (size_t)4096 * 1024;
constexpr size_t W_END = W_DN1 + (size_t)4096 * 1024;
static_assert(W_END * 2 <= 63 * MiB, "weights fit");
constexpr size_t A_PROJ = WS_AR;
constexpr size_t A_GQ = WS_AR + 160 * MiB;
constexpr size_t A_GK = A_GQ + 32 * MiB;
constexpr size_t A_GV = A_GK + 32 * MiB;
constexpr size_t A_KN = WS_AR + 256 * MiB;
constexpr size_t A_QLAT = WS_AR + 320 * MiB;
constexpr size_t A_KVLAT = WS_AR + 336 * MiB;
constexpr size_t A_GA = WS_AR + 344 * MiB;
constexpr size_t A_GB = WS_AR + 345 * MiB;
constexpr size_t A_GO = WS_AR + 346 * MiB;
constexpr size_t O_QH = 0;
constexpr size_t O_KH = 48 * MiB;
constexpr size_t O_VT = 96 * MiB;
constexpr size_t A_U = WS_AR;
constexpr size_t A_A2 = WS_AR;
constexpr size_t A_WL = WS_AR;
constexpr size_t A_AL = WS_AR + 64 * MiB;
constexpr size_t A_RKV = WS_AR + 128 * MiB;
constexpr size_t A_LORA = WS_AR + 320 * MiB;
constexpr size_t A_INV = WS_AR + 344 * MiB;
constexpr size_t A_SB = WS_AR + 346 * MiB;
constexpr size_t WS_NEED = 512 * MiB;

struct Params { const float* in[37]; float* out; char* ws; };

__device__ __forceinline__ float bf2f(bf16_t h) { return __uint_as_float(((unsigned)h) << 16); }
__device__ __forceinline__ float bflo(unsigned u) { return __uint_as_float(u << 16); }
__device__ __forceinline__ float bfhi(unsigned u) { return __uint_as_float(u & 0xffff0000u); }
__device__ __forceinline__ unsigned pk2(float lo, float hi) { f32x2 v = {lo, hi}; bf16x2_t b = __builtin_convertvector(v, bf16x2_t); return __builtin_bit_cast(unsigned, b); }
__device__ __forceinline__ bf16_t f2bf(float f) { return (bf16_t)(pk2(f, 0.f) & 0xffffu); }
__device__ __forceinline__ float wave_sum(float v) {
#pragma unroll
  for (int o = 32; o; o >>= 1) v += __shfl_xor(v, o);
  return v;
}
template <int W> __device__ __forceinline__ float group_sum(float v) {
#pragma unroll
  for (int o = W / 2; o; o >>= 1) v += __shfl_xor(v, o);
  return v;
}
__device__ __forceinline__ float sigmoidf_(float x) { return 1.f / (1.f + __expf(-x)); }
__device__ __forceinline__ float siluf_(float x) { return x / (1.f + __expf(-x)); }
__device__ __forceinline__ float softplusf_(float x) { return x > 20.f ? x : log1pf(expf(x)); }
template <int CTRL> __device__ __forceinline__ float dpp_add(float x) {
  return x + __int_as_float(__builtin_amdgcn_update_dpp(0, __float_as_int(x), CTRL, 0xf, 0xf, false));
}
__device__ __forceinline__ float row16_sum(float x) {
  x = dpp_add<0x128>(x); x = dpp_add<0x124>(x); x = dpp_add<0x122>(x); x = dpp_add<0x121>(x);
  return x;
}

__device__ __forceinline__ void conv_job(char* smem, const float* __restrict__ src, int K, int N, bf16_t* dst, int ldd, int koff, int Kp, int Np,
                         const float* mu, int mode, int& tbase) {
  bf16_t* tile = (bf16_t*)smem;
  const int tid = threadIdx.x, G = gridDim.x;
  const int tk = Kp / 64, tn = Np / 64, nt = tk * tn;
  int first = ((int)blockIdx.x - (tbase % G) + G) % G;
  for (int t = first; t < nt; t += G) {
    const int k0 = (t % tk) * 64, n0 = (t / tk) * 64;
    const int nl = tid & 63, kq = tid >> 6;
#pragma unroll 4
    for (int i = 0; i < 16; ++i) {
      const int kl = kq + 4 * i, k = k0 + kl, n = n0 + nl;
      float v = 0.f;
      if (k < K && n < N) { v = src[(size_t)k * N + n]; if (mode == 1) v *= mu[k]; else if (mode == 2) v *= (1.f - mu[k]); }
      tile[nl * 72 + kl] = f2bf(v);
    }
    __syncthreads();
    {
      const int n = tid >> 2, seg = (tid & 3) * 16;
      const u32x4 a = *(const u32x4*)(tile + n * 72 + seg), b = *(const u32x4*)(tile + n * 72 + seg + 8);
      bf16_t* d = dst + (size_t)(n0 + n) * ldd + koff + k0 + seg;
      *(u32x4*)d = a; *(u32x4*)(d + 8) = b;
    }
    __syncthreads();
  }
  tbase += nt;
}

__device__ __forceinline__ void phase_prologue(char* smem, const Params& p) {
  const int tid = threadIdx.x, wid = tid >> 6, lane = tid & 63;
  if (blockIdx.x == 0 && tid < 64) ((unsigned*)(p.ws + WS_CTL))[tid] = 0u;
  {
    float* sc = (float*)smem;
    float* red = sc + 2048;
    const float* c = p.in[1];
    for (int i = tid; i < 2048; i += 256) sc[i] = siluf_(c[i]);
    __syncthreads();
    float* MOD = (float*)(p.ws + WS_MOD);
    for (int item = blockIdx.x; item < 192; item += gridDim.x) {
      const int l = item / 96, jg = item % 96, col = jg * 64 + lane;
      const float* w = p.in[3] + (size_t)l * 1024 * 6144 + col;
      float a0 = 0.f, a1 = 0.f;
      const int kb = wid * 256;
#pragma unroll 8
      for (int k = 0; k < 256; ++k) { const float wv = w[(size_t)(kb + k) * 6144]; a0 += sc[kb + k] * wv; a1 += sc[1024 + kb + k] * wv; }
      red[(wid * 2 + 0) * 64 + lane] = a0; red[(wid * 2 + 1) * 64 + lane] = a1;
      __syncthreads();
      if (wid < 2) {
        float s = red[(0 * 2 + wid) * 64 + lane] + red[(1 * 2 + wid) * 64 + lane] + red[(2 * 2 + wid) * 64 + lane] + red[(3 * 2 + wid) * 64 + lane];
        MOD[(size_t)(l * 2 + wid) * 6144 + col] = s + p.in[4][l * 6144 + col];
      }
      __syncthreads();
    }
    __syncthreads();
  }
  bf16_t* WT = (bf16_t*)(p.ws + WS_WT);
  int tb = 0;
  conv_job(smem, p.in[5], 1024, 2480, WT + W_IN, 1024, 0, 1024, 2560, nullptr, 0, tb);
  conv_job(smem, p.in[12], 256, 768, WT + W_UQ, 256, 0, 256, 768, nullptr, 0, tb);
  conv_job(smem, p.in[13], 128, 1024, WT + W_UKV, 128, 0, 128, 1024, nullptr, 0, tb);
  conv_job(smem, p.in[16], 1024, 1024, WT + W_OUT, 1024, 0, 1024, 1024, nullptr, 0, tb);
  const float* mu = p.in[17];
  conv_job(smem, p.in[18], 1024, 1024, WT + W_RKV + (size_t)0 * 2048, 2048, 0, 1024, 1024, mu + 0 * 1024, 2, tb);
  conv_job(smem, p.in[18], 1024, 1024, WT + W_RKV + (size_t)0 * 2048, 2048, 1024, 1024, 1024, mu + 0 * 1024, 1, tb);
  conv_job(smem, p.in[19], 1024, 1024, WT + W_RKV + (size_t)1024 * 2048, 2048, 0, 1024, 1024, mu + 2 * 1024, 2, tb);
  conv_job(smem, p.in[19], 1024, 1024, WT + W_RKV + (size_t)1024 * 2048, 2048, 1024, 1024, 1024, mu + 2 * 1024, 1, tb);
  conv_job(smem, p.in[20], 1024, 1024, WT + W_RKV + (size_t)2048 * 2048, 2048, 0, 1024, 1024, mu + 3 * 1024, 2, tb);
  conv_job(smem, p.in[20], 1024, 1024, WT + W_RKV + (size_t)2048 * 2048, 2048, 1024, 1024, 1024, mu + 3 * 1024, 1, tb);
  conv_job(smem, p.in[23], 1024, 64, WT + W_RKV + (size_t)3072 * 2048, 2048, 0, 1024, 64, mu + 1 * 1024, 2, tb);
  conv_job(smem, p.in[23], 1024, 64, WT + W_RKV + (size_t)3072 * 2048, 2048, 1024, 1024, 64, mu + 1 * 1024, 1, tb);
  conv_job(smem, p.in[26], 1024, 64, WT + W_RKV + (size_t)3136 * 2048, 2048, 0, 1024, 64, mu + 4 * 1024, 2, tb);
  conv_job(smem, p.in[26], 1024, 64, WT + W_RKV + (size_t)3136 * 2048, 2048, 1024, 1024, 64, mu + 4 * 1024, 1, tb);
  conv_job(smem, p.in[28], 1024, 160, WT + W_RKV + (size_t)3200 * 2048, 2048, 0, 1024, 256, mu + 5 * 1024, 2, tb);
  conv_job(smem, p.in[28], 1024, 160, WT + W_RKV + (size_t)3200 * 2048, 2048, 1024, 1024, 256, mu + 5 * 1024, 1, tb);
  conv_job(smem, p.in[24], 64, 1024, WT + W_W2, 64, 0, 64, 1024, nullptr, 0, tb);
  conv_job(smem, p.in[27], 64, 1024, WT + W_A2, 64, 0, 64, 1024, nullptr, 0, tb);
  conv_job(smem, p.in[29], 160, 1024, WT + W_G2, 192, 0, 192, 1024, nullptr, 0, tb);
  conv_job(smem, p.in[21], 1024, 1024, WT + W_O, 1024, 0, 1024, 1024, nullptr, 0, tb);
  conv_job(smem, p.in[35], 1024, 4096, WT + W_UP0, 1024, 0, 1024, 4096, nullptr, 0, tb);
  conv_job(smem, p.in[35] + (size_t)1024 * 4096, 1024, 4096, WT + W_UP1, 1024, 0, 1024, 4096, nullptr, 0, tb);
  conv_job(smem, p.in[36], 4096, 1024, WT + W_DN0, 4096, 0, 4096, 1024, nullptr, 0, tb);
  conv_job(smem, p.in[36] + (size_t)4096 * 1024, 4096, 1024, WT + W_DN1, 4096, 0, 4096, 1024, nullptr, 0, tb);
}

template <int MODE> __device__ __forceinline__ void phase_adaln(const Params& p, const float* src, int layer, int which, bf16_t* dst) {
  const int tid = threadIdx.x, wid = tid >> 6, lane = tid & 63;
  const float* MOD = (const float*)(p.ws + WS_MOD);
  const int gw = blockIdx.x * 4 + wid, nw = gridDim.x * 4;
  for (int row = gw; row < MTOK; row += nw) {
    const int b = row >> 14, s = row & (SEQ - 1);
    const float* shift = MOD + (size_t)(layer * 2 + b) * 6144 + which * 3072;
    const float* scale = shift + 1024;
    const float* xr = src + (size_t)row * DM;
    f32x4 v[4]; float ss = 0.f;
#pragma unroll
    for (int i = 0; i < 4; ++i) { v[i] = *(const f32x4*)(xr + i * 256 + lane * 4); ss += v[i][0] * v[i][0] + v[i][1] * v[i][1] + v[i][2] * v[i][2] + v[i][3] * v[i][3]; }
    ss = wave_sum(ss);
    const float r = rsqrtf(ss * (1.f / 1024.f) + 1e-6f);
#pragma unroll
    for (int i = 0; i < 4; ++i) {
      const int col = i * 256 + lane * 4;
      const f32x4 sc = *(const f32x4*)(scale + col), sh = *(const f32x4*)(shift + col);
      u32x2 w;
      w.x = pk2(v[i][0] * r * (1.f + sc[0]) + sh[0], v[i][1] * r * (1.f + sc[1]) + sh[1]);
      w.y = pk2(v[i][2] * r * (1.f + sc[2]) + sh[2], v[i][3] * r * (1.f + sc[3]) + sh[3]);
      if (MODE == 0) { *(u32x2*)(dst + (size_t)row * 1024 + col) = w; }
      else {
        *(u32x2*)(dst + (size_t)row * 2048 + col) = w;
        if (s + 1 < SEQ) *(u32x2*)(dst + (size_t)(row + 1) * 2048 + 1024 + col) = w;
        if (s == 0) { u32x2 z = {0u, 0u}; *(u32x2*)(dst + (size_t)row * 2048 + 1024 + col) = z; }
      }
    }
  }
}

struct EpiStore { bf16_t* C; int ldc;
  __device__ __forceinline__ void operator()(int row, int col, f32x4 v) const { u32x2 w = {pk2(v[0], v[1]), pk2(v[2], v[3])}; *(u32x2*)(C + (size_t)row * ldc + col) = w; } };
struct EpiKV { bf16_t* KN; bf16_t* Vt;
  __device__ __forceinline__ void operator()(int row, int col, f32x4 v) const {
    const int h = col >> 7, c = col & 127;
    if (c < 64) { u32x2 w = {pk2(v[0], v[1]), pk2(v[2], v[3])}; *(u32x2*)(KN + (size_t)row * 512 + h * 64 + c) = w; }
    else { const int b = row >> 14, s = row & (SEQ - 1); bf16_t* d = Vt + ((size_t)((b * 8 + h) * 64 + (c - 64))) * SEQ + s;
#pragma unroll
      for (int j = 0; j < 4; ++j) d[(size_t)j * SEQ] = f2bf(v[j]); }
  } };
struct EpiResid { const float* base; float* out; const float* gate;
  __device__ __forceinline__ void operator()(int row, int col, f32x4 v) const {
    const int b = row >> 14; const f32x4 g = *(const f32x4*)(gate + (size_t)b * 6144 + col);
    const f32x4 x = *(const f32x4*)(base + (size_t)row * DM + col);
    *(f32x4*)(out + (size_t)row * DM + col) = x + g * v; } };
struct EpiUp { bf16_t* U;
  __device__ __forceinline__ void operator()(int row, int col, f32x4 v) const {
    f32x4 r;
#pragma unroll
    for (int j = 0; j < 4; ++j) { const float t = v[j] > 0.f ? v[j] : 0.f; r[j] = t * t; }
    u32x2 w = {pk2(r[0], r[1]), pk2(r[2], r[3])}; *(u32x2*)(U + (size_t)row * DFF + col) = w; } };
struct EpiRkv { bf16_t* RKV; bf16_t* LORA;
  __device__ __forceinline__ void operator()(int row, int col, f32x4 v) const {
    if (col < 3072) { u32x2 w = {pk2(v[0], v[1]), pk2(v[2], v[3])}; *(u32x2*)(RKV + (size_t)row * 3072 + col) = w; }
    else { const int c = col - 3072; f32x4 r;
      if (c < 64) { for (int j = 0; j < 4; ++j) r[j] = tanhf(v[j]); }
      else if (c < 128) r = v;
      else if (c < 288) { for (int j = 0; j < 4; ++j) r[j] = sigmoidf_(v[j]); }
      else r = (f32x4){0.f, 0.f, 0.f, 0.f};
      u32x2 w = {pk2(r[0], r[1]), pk2(r[2], r[3])}; *(u32x2*)(LORA + (size_t)row * 384 + c) = w; }
  } };

template <class Epi>
__device__ __forceinline__ void gemm_phase(char* smem, const bf16_t* __restrict__ A, int lda, const bf16_t* __restrict__ Bt, int ldb, int M, int N, int K, const Epi epi) {
  const int tid = threadIdx.x, wid = tid >> 6, lane = tid & 63, wr = wid >> 1, wc = wid & 1, fr = lane & 15, fq = lane >> 4;
  const int nN = N / 128, ntiles = (M / 128) * nN, nk = K / 64;
  int srow[4], sc[4], soff[4];
#pragma unroll
  for (int i = 0; i < 4; ++i) { const int id = tid + 256 * i; srow[i] = id >> 3; sc[i] = id & 7; soff[i] = srow[i] * 128 + ((sc[i] ^ ((srow[i] >> 1) & 7)) << 4); }
  for (int tile = blockIdx.x; tile < ntiles; tile += gridDim.x) {
    const int tm = tile / nN, tn = tile % nN;
    const bf16_t* Ag = A + (size_t)(tm * 128) * lda;
    const bf16_t* Bg = Bt + (size_t)(tn * 128) * ldb;
    f32x4 acc[4][4];
#pragma unroll
    for (int a = 0; a < 4; ++a)
#pragma unroll
      for (int b = 0; b < 4; ++b) acc[a][b] = (f32x4){0.f, 0.f, 0.f, 0.f};
    u32x4 ra[4], rb[4];
#pragma unroll
    for (int i = 0; i < 4; ++i) { ra[i] = *(const u32x4*)(Ag + (size_t)srow[i] * lda + sc[i] * 8); rb[i] = *(const u32x4*)(Bg + (size_t)srow[i] * ldb + sc[i] * 8); }
#pragma unroll
    for (int i = 0; i < 4; ++i) { *(u32x4*)(smem + soff[i]) = ra[i]; *(u32x4*)(smem + 16384 + soff[i]) = rb[i]; }
    __syncthreads();
    for (int kt = 0; kt < nk; ++kt) {
      char* cur = smem + (kt & 1) * 32768;
      char* nxt = smem + ((kt + 1) & 1) * 32768;
      const bool more = kt + 1 < nk;
      if (more) {
#pragma unroll
        for (int i = 0; i < 4; ++i) { ra[i] = *(const u32x4*)(Ag + (size_t)srow[i] * lda + (kt + 1) * 64 + sc[i] * 8); rb[i] = *(const u32x4*)(Bg + (size_t)srow[i] * ldb + (kt + 1) * 64 + sc[i] * 8); }
      }
#pragma unroll
      for (int ks = 0; ks < 2; ++ks) {
        bf16x8 af[4], bfr[4];
        const int ch = ks * 4 + fq;
#pragma unroll
        for (int m = 0; m < 4; ++m) { const int r = wr * 64 + m * 16 + fr; af[m] = *(const bf16x8*)(cur + r * 128 + ((ch ^ ((r >> 1) & 7)) << 4)); }
#pragma unroll
        for (int n = 0; n < 4; ++n) { const int r = wc * 64 + n * 16 + fr; bfr[n] = *(const bf16x8*)(cur + 16384 + r * 128 + ((ch ^ ((r >> 1) & 7)) << 4)); }
#pragma unroll
        for (int m = 0; m < 4; ++m)
#pragma unroll
          for (int n = 0; n < 4; ++n) acc[m][n] = __builtin_amdgcn_mfma_f32_16x16x32_bf16(bfr[n], af[m], acc[m][n], 0, 0, 0);
      }
      if (more) {
#pragma unroll
        for (int i = 0; i < 4; ++i) { *(u32x4*)(nxt + soff[i]) = ra[i]; *(u32x4*)(nxt + 16384 + soff[i]) = rb[i]; }
      }
      __syncthreads();
    }
#pragma unroll
    for (int m = 0; m < 4; ++m)
#pragma unroll
      for (int n = 0; n < 4; ++n) epi(tm * 128 + wr * 64 + m * 16 + fr, tn * 128 + wc * 64 + n * 16 + fq * 4, acc[m][n]);
  }
}

__device__ __forceinline__ void phase_prep0(const Params& p) {
  const int tid = threadIdx.x, wid = tid >> 6, lane = tid & 63;
  const bf16_t* PROJ = (const bf16_t*)(p.ws + A_PROJ);
  bf16_t* GQKV[3] = {(bf16_t*)(p.ws + A_GQ), (bf16_t*)(p.ws + A_GK), (bf16_t*)(p.ws + A_GV)};
  float* GA = (float*)(p.ws + A_GA); float* GB = (float*)(p.ws + A_GB);
  bf16_t* QLAT = (bf16_t*)(p.ws + A_QLAT); bf16_t* KVLAT = (bf16_t*)(p.ws + A_KVLAT);
  const float* cw = p.in[6];
  const int gw = blockIdx.x * 4 + wid, nw = gridDim.x * 4;
  for (int row = gw; row < MTOK; row += nw) {
    const int s = row & (SEQ - 1);
    const bf16_t* pr = PROJ + (size_t)row * PROJ_LD;
#pragma unroll
    for (int part = 0; part < 3; ++part) {
      const int col = part * 512 + lane * 8;
      float acc[8];
#pragma unroll
      for (int e = 0; e < 8; ++e) acc[e] = 0.f;
#pragma unroll
      for (int j = 0; j < 4; ++j) {
        const int ds = 3 - j;
        if (s - ds >= 0) {
          const u32x4 t = *(const u32x4*)(pr - (size_t)ds * PROJ_LD + col);
          const f32x4 w0 = *(const f32x4*)(cw + j * 1536 + col), w1 = *(const f32x4*)(cw + j * 1536 + col + 4);
          acc[0] += w0[0] * bflo(t.x); acc[1] += w0[1] * bfhi(t.x); acc[2] += w0[2] * bflo(t.y); acc[3] += w0[3] * bfhi(t.y);
          acc[4] += w1[0] * bflo(t.z); acc[5] += w1[1] * bfhi(t.z); acc[6] += w1[2] * bflo(t.w); acc[7] += w1[3] * bfhi(t.w);
        }
      }
      float ss = 0.f;
#pragma unroll
      for (int e = 0; e < 8; ++e) { acc[e] = siluf_(acc[e]); ss += acc[e] * acc[e]; }
      if (part < 2) {
        ss = group_sum<8>(ss);
        const float r = rsqrtf(ss + 1e-12f);
#pragma unroll
        for (int e = 0; e < 8; ++e) acc[e] *= r;
      }
      u32x4 w = {pk2(acc[0], acc[1]), pk2(acc[2], acc[3]), pk2(acc[4], acc[5]), pk2(acc[6], acc[7])};
      *(u32x4*)(GQKV[part] + (size_t)row * 512 + lane * 8) = w;
    }
    if (lane < 8) {
      const float a = bf2f(pr[2048 + lane]), bb = bf2f(pr[2056 + lane]);
      const float g = -expf(p.in[7][lane]) * softplusf_(a + p.in[8][lane]);
      GA[(size_t)row * 8 + lane] = expf(g);
      GB[(size_t)row * 8 + lane] = sigmoidf_(bb);
    }
    {
      const u32x2 t = *(const u32x2*)(pr + 2064 + lane * 4);
      float v0 = bflo(t.x), v1 = bfhi(t.x), v2 = bflo(t.y), v3 = bfhi(t.y);
      float ss = wave_sum(v0 * v0 + v1 * v1 + v2 * v2 + v3 * v3);
      const float r = rsqrtf(ss * (1.f / 256.f) + 1e-6f);
      const f32x4 g = *(const f32x4*)(p.in[10] + lane * 4);
      u32x2 w = {pk2(v0 * r * g[0], v1 * r * g[1]), pk2(v2 * r * g[2], v3 * r * g[3])};
      *(u32x2*)(QLAT + (size_t)row * 256 + lane * 4) = w;
    }
    {
      const unsigned t = *(const unsigned*)(pr + 2320 + lane * 2);
      float v0 = bflo(t), v1 = bfhi(t);
      float ss = wave_sum(v0 * v0 + v1 * v1);
      const float r = rsqrtf(ss * (1.f / 128.f) + 1e-6f);
      const f32x2 g = *(const f32x2*)(p.in[11] + lane * 2);
      *(unsigned*)(KVLAT + (size_t)row * 128 + lane * 2) = pk2(v0 * r * g[0], v1 * r * g[1]);
    }
  }
}

__device__ __forceinline__ void phase_qkrope(const Params& p) {
  const int tid = threadIdx.x, wid = tid >> 6, lane = tid & 63;
  const int h = lane >> 3, sub = lane & 7;
  bf16_t* QH = (bf16_t*)((char*)p.out + O_QH); bf16_t* KH = (bf16_t*)((char*)p.out + O_KH);
  const bf16_t* KN = (const bf16_t*)(p.ws + A_KN); const bf16_t* PROJ = (const bf16_t*)(p.ws + A_PROJ);
  const int* pos = (const int*)p.in[2];
  const float* qg = p.in[14]; const float* kg = p.in[15];
  float qgn[8], kgn[8], qg1[2], qg2[2], kg1[2], kg2[2];
#pragma unroll
  for (int e = 0; e < 8; ++e) { qgn[e] = qg[sub * 8 + e]; kgn[e] = kg[sub * 8 + e]; }
#pragma unroll
  for (int e = 0; e < 2; ++e) { qg1[e] = qg[64 + 2 * sub + e]; qg2[e] = qg[80 + 2 * sub + e]; kg1[e] = kg[64 + 2 * sub + e]; kg2[e] = kg[80 + 2 * sub + e]; }
  float invf[2];
#pragma unroll
  for (int e = 0; e < 2; ++e) invf[e] = powf(10000.0f, -(float)(2 * (2 * sub + e)) / 32.0f);
  const float qscale = 0.10206207261596577f * 1.4426950408889634f;
  const int gw = blockIdx.x * 4 + wid, nw = gridDim.x * 4;
  for (int row = gw; row < MTOK; row += nw) {
    const float fp = (float)pos[row];
    float cs[2], sn[2];
#pragma unroll
    for (int e = 0; e < 2; ++e) {
      const float ang = fp * invf[e];
      const double rev = (double)ang * 0.15915494309189535;
      const float fr = (float)(rev - rint(rev));
      sn[e] = __builtin_amdgcn_sinf(fr); cs[e] = __builtin_amdgcn_cosf(fr);
    }
    {
      bf16_t* q = QH + (size_t)row * 768 + h * 96;
      const u32x4 t = *(const u32x4*)(q + sub * 8);
      const unsigned t1 = *(const unsigned*)(q + 64 + 2 * sub), t2 = *(const unsigned*)(q + 80 + 2 * sub);
      float v[8] = {bflo(t.x), bfhi(t.x), bflo(t.y), bfhi(t.y), bflo(t.z), bfhi(t.z), bflo(t.w), bfhi(t.w)};
      float x1[2] = {bflo(t1), bfhi(t1)}, x2[2] = {bflo(t2), bfhi(t2)};
      float ss = x1[0] * x1[0] + x1[1] * x1[1] + x2[0] * x2[0] + x2[1] * x2[1];
#pragma unroll
      for (int e = 0; e < 8; ++e) ss += v[e] * v[e];
      ss = group_sum<8>(ss);
      const float r = rsqrtf(ss * (1.f / 96.f) + 1e-6f) * qscale;
#pragma unroll
      for (int e = 0; e < 8; ++e) v[e] *= r * qgn[e];
      float o1[2], o2[2];
#pragma unroll
      for (int e = 0; e < 2; ++e) { const float a = x1[e] * r * qg1[e], b = x2[e] * r * qg2[e]; o1[e] = a * cs[e] - b * sn[e]; o2[e] = b * cs[e] + a * sn[e]; }
      u32x4 w = {pk2(v[0], v[1]), pk2(v[2], v[3]), pk2(v[4], v[5]), pk2(v[6], v[7])};
      *(u32x4*)(q + sub * 8) = w; *(unsigned*)(q + 64 + 2 * sub) = pk2(o1[0], o1[1]); *(unsigned*)(q + 80 + 2 * sub) = pk2(o2[0], o2[1]);
    }
    {
      const bf16_t* kn = KN + (size_t)row * 512 + h * 64; const bf16_t* kr = PROJ + (size_t)row * PROJ_LD + 2448;
      bf16_t* k = KH + (size_t)row * 768 + h * 96;
      const u32x4 t = *(const u32x4*)(kn + sub * 8);
      const unsigned t1 = *(const unsigned*)(kr + 2 * sub), t2 = *(const unsigned*)(kr + 16 + 2 * sub);
      float v[8] = {bflo(t.x), bfhi(t.x), bflo(t.y), bfhi(t.y), bflo(t.z), bfhi(t.z), bflo(t.w), bfhi(t.w)};
      float x1[2] = {bflo(t1), bfhi(t1)}, x2[2] = {bflo(t2), bfhi(t2)};
      float ss = x1[0] * x1[0] + x1[1] * x1[1] + x2[0] * x2[0] + x2[1] * x2[1];
#pragma unroll
      for (int e = 0; e < 8; ++e) ss += v[e] * v[e];
      ss = group_sum<8>(ss);
      const float r = rsqrtf(ss * (1.f / 96.f) + 1e-6f);
#pragma unroll
      for (int e = 0; e < 8; ++e) v[e] *= r * kgn[e];
      float o1[2], o2[2];
#pragma unroll
      for (int e = 0; e < 2; ++e) { const float a = x1[e] * r * kg1[e], b = x2[e] * r * kg2[e]; o1[e] = a * cs[e] - b * sn[e]; o2[e] = b * cs[e] + a * sn[e]; }
      u32x4 w = {pk2(v[0], v[1]), pk2(v[2], v[3]), pk2(v[4], v[5]), pk2(v[6], v[7])};
      *(u32x4*)(k + sub * 8) = w; *(unsigned*)(k + 64 + 2 * sub) = pk2(o1[0], o1[1]); *(unsigned*)(k + 80 + 2 * sub) = pk2(o2[0], o2[1]);
    }
  }
}

template <int MODE> __device__ __forceinline__ void scan_unit(char* smem, const Params& p, int unit) {
  constexpr int T = 16, STEPF = 336, NH = MODE == 0 ? 8 : 16;
  const int tid = threadIdx.x, rowl = tid >> 4, j = tid & 15;
  const int bh = unit >> 2, row0 = (unit & 3) * 16;
  const int b = bh / NH, h = bh % NH;
  float* buf = (float*)smem;
  const bf16_t* GQ = (const bf16_t*)(p.ws + A_GQ); const bf16_t* GK = (const bf16_t*)(p.ws + A_GK); const bf16_t* GV = (const bf16_t*)(p.ws + A_GV);
  const float* GA = (const float*)(p.ws + A_GA); const float* GB = (const float*)(p.ws + A_GB);
  bf16_t* GO = (bf16_t*)(p.ws + A_GO);
  const bf16_t* RKV = (const bf16_t*)(p.ws + A_RKV); const bf16_t* EE = (const bf16_t*)(p.ws + A_WL); const bf16_t* AA = (const bf16_t*)(p.ws + A_AL);
  const float* INV = (const float*)(p.ws + A_INV);
  bf16_t* Y = (bf16_t*)(p.ws + WS_H);
  f32x4 ckk = {0.f, 0.f, 0.f, 0.f}, cka = {0.f, 0.f, 0.f, 0.f};
  if (MODE == 1) { ckk = *(const f32x4*)(p.in[30] + h * 64 + 4 * j); cka = *(const f32x4*)(p.in[31] + h * 64 + 4 * j); }
  u32x2 g0, g1, g2, g3; float gs0 = 0.f, gs1 = 0.f; bf16_t gv;
  auto gload = [&](int chunk) {
    const size_t tok = (size_t)b * SEQ + (size_t)chunk * T + rowl;
    if (MODE == 0) {
      g0 = *(const u32x2*)(GQ + tok * 512 + h * 64 + 4 * j); g1 = *(const u32x2*)(GK + tok * 512 + h * 64 + 4 * j);
      gs0 = GA[tok * 8 + h]; gs1 = GB[tok * 8 + h]; gv = GV[tok * 512 + h * 64 + row0 + j];
    } else {
      g0 = *(const u32x2*)(RKV + tok * 3072 + h * 64 + 4 * j); g1 = *(const u32x2*)(RKV + tok * 3072 + 1024 + h * 64 + 4 * j);
      g2 = *(const u32x2*)(EE + tok * 1024 + h * 64 + 4 * j); g3 = *(const u32x2*)(AA + tok * 1024 + h * 64 + 4 * j);
      gs0 = INV[tok * 16 + h]; gv = RKV[tok * 3072 + 2048 + h * 64 + row0 + j];
    }
  };
  auto gstore = [&](float* dst) {
    float* d = dst + rowl * STEPF;
    f32x4 r, w, k, a, bb; float v;
    if (MODE == 0) {
      const f32x4 q = {bflo(g0.x), bfhi(g0.x), bflo(g0.y), bfhi(g0.y)};
      k = (f32x4){bflo(g1.x), bfhi(g1.x), bflo(g1.y), bfhi(g1.y)};
      const float al = gs0, be = gs1;
      r = q * 0.125f; w = (f32x4){al, al, al, al}; a = k * (-al * be); bb = k; v = be * bf2f(gv);
    } else {
      r = (f32x4){bflo(g0.x), bfhi(g0.x), bflo(g0.y), bfhi(g0.y)};
      const f32x4 k0 = {bflo(g1.x), bfhi(g1.x), bflo(g1.y), bfhi(g1.y)};
      const f32x4 e = {bflo(g2.x), bfhi(g2.x), bflo(g2.y), bfhi(g2.y)};
      const f32x4 av = {bflo(g3.x), bfhi(g3.x), bflo(g3.y), bfhi(g3.y)};
      const f32x4 kk = k0 * ckk * gs0;
      a = -kk; bb = kk * av; k = k0 * (1.f + (av - 1.f) * cka);
      w = (f32x4){__expf(-e[0]), __expf(-e[1]), __expf(-e[2]), __expf(-e[3])};
      v = bf2f(gv);
    }
    *(f32x4*)(d + 4 * j) = r; *(f32x4*)(d + 64 + 4 * j) = w; *(f32x4*)(d + 128 + 4 * j) = k; *(f32x4*)(d + 192 + 4 * j) = a; *(f32x4*)(d + 256 + 4 * j) = bb;
    d[320 + j] = v;
  };
  f32x4 s = {0.f, 0.f, 0.f, 0.f};
  gload(0); gstore(buf);
  __syncthreads();
  constexpr int NCH = SEQ / T;
  for (int c = 0; c < NCH; ++c) {
    const float* cur = buf + (c & 1) * (T * STEPF);
    float* nxt = buf + ((c + 1) & 1) * (T * STEPF);
    if (c + 1 < NCH) gload(c + 1);
    const size_t tok0 = (size_t)b * SEQ + (size_t)c * T;
#pragma unroll
    for (int t = 0; t < T; ++t) {
      const float* d = cur + t * STEPF;
      const f32x4 r = *(const f32x4*)(d + 4 * j), w = *(const f32x4*)(d + 64 + 4 * j), k = *(const f32x4*)(d + 128 + 4 * j),
                  a = *(const f32x4*)(d + 192 + 4 * j), bb = *(const f32x4*)(d + 256 + 4 * j);
      const float v = d[320 + rowl];
      float pa = (s[0] * a[0] + s[1] * a[1]) + (s[2] * a[2] + s[3] * a[3]);
      const f32x4 tkw = s * w + k * v;
      pa = row16_sum(pa);
      s = tkw + bb * pa;
      float y = (s[0] * r[0] + s[1] * r[1]) + (s[2] * r[2] + s[3] * r[3]);
      y = row16_sum(y);
      if (j == 0) {
        if (MODE == 0) GO[(tok0 + t) * 512 + h * 64 + row0 + rowl] = f2bf(y);
        else Y[(tok0 + t) * 1024 + h * 64 + row0 + rowl] = f2bf(y);
      }
    }
    if (c + 1 < NCH) gstore(nxt);
    __syncthreads();
  }
}

__device__ __forceinline__ void attn_unit(char* smem, const Params& p, int b, int h, int qb) {
  const int tid = threadIdx.x, wid = tid >> 6, lane = tid & 63, r32 = lane & 31, hi = lane >> 5;
  const bf16_t* QH = (const bf16_t*)((const char*)p.out + O_QH); const bf16_t* KH = (const bf16_t*)((const char*)p.out + O_KH);
  const bf16_t* VT = (const bf16_t*)((const char*)p.out + O_VT);
  bf16_t* MIX = (bf16_t*)(p.ws + WS_H);
  const int q0 = qb * 128, qrow = q0 + wid * 32 + r32;
  const size_t tokq = (size_t)b * SEQ + qrow;
  bf16x8 qr[6];
#pragma unroll
  for (int ks = 0; ks < 6; ++ks) qr[ks] = *(const bf16x8*)(QH + tokq * 768 + h * 96 + ks * 16 + hi * 8);
  f32x16 o0 = {}, o1 = {};
  float m = -1e30f, l = 0.f;
  const int ntiles = (q0 + 128) / 64;
  const bf16_t* Kg = KH + ((size_t)b * SEQ) * 768 + h * 96;
  const bf16_t* Vg = VT + ((size_t)(b * 8 + h) * 64) * SEQ;
  int krow[3], kc[3]; int vrow[2], vc[2];
#pragma unroll
  for (int i = 0; i < 3; ++i) { const int id = tid + 256 * i; krow[i] = id / 12; kc[i] = id % 12; }
#pragma unroll
  for (int i = 0; i < 2; ++i) { const int id = tid + 256 * i; vrow[i] = id >> 3; vc[i] = id & 7; }
  u32x4 rk[3], rv[2];
  constexpr int STG = 22528, KSZ = 13312;
  auto gload = [&](int t) {
    const int kv0 = t * 64;
#pragma unroll
    for (int i = 0; i < 3; ++i) rk[i] = *(const u32x4*)(Kg + (size_t)(kv0 + krow[i]) * 768 + kc[i] * 8);
#pragma unroll
    for (int i = 0; i < 2; ++i) rv[i] = *(const u32x4*)(Vg + (size_t)vrow[i] * SEQ + kv0 + vc[i] * 8);
  };
  auto sstore = [&](char* st) {
#pragma unroll
    for (int i = 0; i < 3; ++i) *(u32x4*)(st + krow[i] * 208 + kc[i] * 16) = rk[i];
#pragma unroll
    for (int i = 0; i < 2; ++i) { char* d = st + KSZ + vrow[i] * 144 + (vc[i] >> 1) * 32 + (vc[i] & 1) * 8;
      *(u32x2*)d = (u32x2){rv[i].x, rv[i].y}; *(u32x2*)(d + 16) = (u32x2){rv[i].z, rv[i].w}; }
  };
  gload(0); sstore(smem);
  __syncthreads();
  for (int t = 0; t < ntiles; ++t) {
    char* cur = smem + (t & 1) * STG; char* nxt = smem + ((t + 1) & 1) * STG;
    const bool more = t + 1 < ntiles;
    if (more) gload(t + 1);
    const int kv0 = t * 64;
    const int wq0 = q0 + wid * 32;
    if (kv0 <= wq0 + 31) {
      f32x16 s0 = {}, s1 = {};
#pragma unroll
      for (int ks = 0; ks < 6; ++ks) {
        const bf16x8 k0 = *(const bf16x8*)(cur + r32 * 208 + ks * 32 + hi * 16);
        const bf16x8 k1 = *(const bf16x8*)(cur + (32 + r32) * 208 + ks * 32 + hi * 16);
        s0 = __builtin_amdgcn_mfma_f32_32x32x16_bf16(k0, qr[ks], s0, 0, 0, 0);
        s1 = __builtin_amdgcn_mfma_f32_32x32x16_bf16(k1, qr[ks], s1, 0, 0, 0);
      }
      if (kv0 + 63 > wq0) {
#pragma unroll
        for (int r = 0; r < 16; ++r) { const int kv = kv0 + (r & 3) + 8 * (r >> 2) + 4 * hi; if (kv > qrow) s0[r] = -INFINITY; if (kv + 32 > qrow) s1[r] = -INFINITY; }
      }
      float mx = fmaxf(s0[0], s1[0]);
#pragma unroll
      for (int r = 1; r < 16; ++r) mx = fmaxf(mx, fmaxf(s0[r], s1[r]));
      { auto rr = __builtin_amdgcn_permlane32_swap(__float_as_uint(mx), __float_as_uint(mx), false, false); mx = fmaxf(__uint_as_float(rr[0]), __uint_as_float(rr[1])); }
      const float mn = fmaxf(m, mx);
      const float f = __builtin_amdgcn_exp2f(m - mn);
      m = mn; l *= f;
#pragma unroll
      for (int r = 0; r < 16; ++r) { o0[r] *= f; o1[r] *= f; }
      float ps = 0.f;
#pragma unroll
      for (int r = 0; r < 16; ++r) { s0[r] = __builtin_amdgcn_exp2f(s0[r] - mn); s1[r] = __builtin_amdgcn_exp2f(s1[r] - mn); ps += s0[r] + s1[r]; }
      l += ps;
      bf16x8 pf[4];
      { u32x4 w;
        w = (u32x4){pk2(s0[0], s0[1]), pk2(s0[2], s0[3]), pk2(s0[4], s0[5]), pk2(s0[6], s0[7])}; pf[0] = __builtin_bit_cast(bf16x8, w);
        w = (u32x4){pk2(s0[8], s0[9]), pk2(s0[10], s0[11]), pk2(s0[12], s0[13]), pk2(s0[14], s0[15])}; pf[1] = __builtin_bit_cast(bf16x8, w);
        w = (u32x4){pk2(s1[0], s1[1]), pk2(s1[2], s1[3]), pk2(s1[4], s1[5]), pk2(s1[6], s1[7])}; pf[2] = __builtin_bit_cast(bf16x8, w);
        w = (u32x4){pk2(s1[8], s1[9]), pk2(s1[10], s1[11]), pk2(s1[12], s1[13]), pk2(s1[14], s1[15])}; pf[3] = __builtin_bit_cast(bf16x8, w); }
#pragma unroll
      for (int ks = 0; ks < 4; ++ks) {
        const bf16x8 v0 = *(const bf16x8*)(cur + KSZ + r32 * 144 + ks * 32 + hi * 16);
        const bf16x8 v1 = *(const bf16x8*)(cur + KSZ + (32 + r32) * 144 + ks * 32 + hi * 16);
        o0 = __builtin_amdgcn_mfma_f32_32x32x16_bf16(v0, pf[ks], o0, 0, 0, 0);
        o1 = __builtin_amdgcn_mfma_f32_32x32x16_bf16(v1, pf[ks], o1, 0, 0, 0);
      }
    }
    if (more) sstore(nxt);
    __syncthreads();
  }
  { auto rr = __builtin_amdgcn_permlane32_swap(__float_as_uint(l), __float_as_uint(l), false, false); l = __uint_as_float(rr[0]) + __uint_as_float(rr[1]); }
  const float il = 1.f / l;
  bf16_t* orow = MIX + tokq * 1024 + 512 + h * 64;
#pragma unroll
  for (int g = 0; g < 4; ++g) {
    const int d = 8 * g + 4 * hi;
    u32x2 w0 = {pk2(o0[4 * g] * il, o0[4 * g + 1] * il), pk2(o0[4 * g + 2] * il, o0[4 * g + 3] * il)};
    u32x2 w1 = {pk2(o1[4 * g] * il, o1[4 * g + 1] * il), pk2(o1[4 * g + 2] * il, o1[4 * g + 3] * il)};
    *(u32x2*)(orow + d) = w0; *(u32x2*)(orow + 32 + d) = w1;
  }
}

__device__ __forceinline__ void phase_mix0(char* smem, const Params& p) {
  if (blockIdx.x < 64) scan_unit<0>(smem, p, blockIdx.x);
  __syncthreads();
  unsigned* ctr = (unsigned*)(p.ws + WS_CTL);
  volatile int* sh = (volatile int*)(smem + 60000);
  for (;;) {
    if (threadIdx.x == 0) sh[0] = (int)atomicAdd(ctr, 1u);
    __syncthreads();
    const int u = sh[0];
    __syncthreads();
    if (u >= 2048) break;
    attn_unit(smem, p, (u & 15) >> 3, u & 7, 127 - (u >> 4));
  }
}

__device__ __forceinline__ void phase_gdnpost(const Params& p) {
  const int tid = threadIdx.x, wid = tid >> 6, lane = tid & 63;
  const bf16_t* GO = (const bf16_t*)(p.ws + A_GO); const bf16_t* PROJ = (const bf16_t*)(p.ws + A_PROJ);
  bf16_t* MIX = (bf16_t*)(p.ws + WS_H);
  const int sub = lane & 7;
  float gn[8];
#pragma unroll
  for (int e = 0; e < 8; ++e) gn[e] = p.in[9][sub * 8 + e];
  const int gw = blockIdx.x * 4 + wid, nw = gridDim.x * 4;
  for (int row = gw; row < MTOK; row += nw) {
    const u32x4 t = *(const u32x4*)(GO + (size_t)row * 512 + lane * 8);
    const u32x4 z = *(const u32x4*)(PROJ + (size_t)row * PROJ_LD + 1536 + lane * 8);
    float v[8] = {bflo(t.x), bfhi(t.x), bflo(t.y), bfhi(t.y), bflo(t.z), bfhi(t.z), bflo(t.w), bfhi(t.w)};
    float zz[8] = {bflo(z.x), bfhi(z.x), bflo(z.y), bfhi(z.y), bflo(z.z), bfhi(z.z), bflo(z.w), bfhi(z.w)};
    float ss = 0.f;
#pragma unroll
    for (int e = 0; e < 8; ++e) ss += v[e] * v[e];
    ss = group_sum<8>(ss);
    const float r = rsqrtf(ss * (1.f / 64.f) + 1e-6f);
#pragma unroll
    for (int e = 0; e < 8; ++e) v[e] = v[e] * r * gn[e] * siluf_(zz[e]);
    u32x4 w = {pk2(v[0], v[1]), pk2(v[2], v[3]), pk2(v[4], v[5]), pk2(v[6], v[7])};
    *(u32x4*)(MIX + (size_t)row * 1024 + lane * 8) = w;
  }
}

__device__ __forceinline__ void phase_prep1(const Params& p) {
  const int tid = threadIdx.x, wid = tid >> 6, lane = tid & 63;
  bf16_t* WL = (bf16_t*)(p.ws + A_WL); bf16_t* AL = (bf16_t*)(p.ws + A_AL);
  const bf16_t* RKV = (const bf16_t*)(p.ws + A_RKV);
  float* INV = (float*)(p.ws + A_INV); float* SB = (float*)(p.ws + A_SB);
  const int col = lane * 16, h = lane >> 2;
  const int gw = blockIdx.x * 4 + wid, nw = gridDim.x * 4;
  for (int row = gw; row < MTOK; row += nw) {
    float ssk = 0.f, sb = 0.f;
#pragma unroll
    for (int half = 0; half < 2; ++half) {
      const int c0 = col + half * 8;
      const u32x4 tw = *(const u32x4*)(WL + (size_t)row * 1024 + c0), ta = *(const u32x4*)(AL + (size_t)row * 1024 + c0);
      const u32x4 tr = *(const u32x4*)(RKV + (size_t)row * 3072 + c0), tk = *(const u32x4*)(RKV + (size_t)row * 3072 + 1024 + c0);
      float wl[8] = {bflo(tw.x), bfhi(tw.x), bflo(tw.y), bfhi(tw.y), bflo(tw.z), bfhi(tw.z), bflo(tw.w), bfhi(tw.w)};
      float al[8] = {bflo(ta.x), bfhi(ta.x), bflo(ta.y), bfhi(ta.y), bflo(ta.z), bfhi(ta.z), bflo(ta.w), bfhi(ta.w)};
      float rr[8] = {bflo(tr.x), bfhi(tr.x), bflo(tr.y), bfhi(tr.y), bflo(tr.z), bfhi(tr.z), bflo(tr.w), bfhi(tr.w)};
      float kk[8] = {bflo(tk.x), bfhi(tk.x), bflo(tk.y), bfhi(tk.y), bflo(tk.z), bfhi(tk.z), bflo(tk.w), bfhi(tk.w)};
      float eo[8], ao[8];
#pragma unroll
      for (int e = 0; e < 8; ++e) {
        const int c = c0 + e;
        const float wlog = -softplusf_(-(p.in[22][c] + wl[e])) - 0.5f;
        eo[e] = expf(wlog);
        const float a = sigmoidf_(p.in[25][c] + al[e]);
        const unsigned ab = pk2(a, 0.f); const float ar = bflo(ab);
        ao[e] = a;
        const float kkv = kk[e] * p.in[30][c]; ssk += kkv * kkv;
        const float kp = kk[e] * (1.f + (ar - 1.f) * p.in[31][c]);
        sb += rr[e] * kp * p.in[32][c];
      }
      u32x4 we = {pk2(eo[0], eo[1]), pk2(eo[2], eo[3]), pk2(eo[4], eo[5]), pk2(eo[6], eo[7])};
      u32x4 wa = {pk2(ao[0], ao[1]), pk2(ao[2], ao[3]), pk2(ao[4], ao[5]), pk2(ao[6], ao[7])};
      *(u32x4*)(WL + (size_t)row * 1024 + c0) = we; *(u32x4*)(AL + (size_t)row * 1024 + c0) = wa;
    }
    ssk = group_sum<4>(ssk); sb = group_sum<4>(sb);
    if ((lane & 3) == 0) { INV[(size_t)row * 16 + h] = rsqrtf(ssk + 1e-12f); SB[(size_t)row * 16 + h] = sb; }
  }
}

__device__ __forceinline__ void phase_post1(const Params& p) {
  const int tid = threadIdx.x, wid = tid >> 6, lane = tid & 63;
  const bf16_t* Y = (const bf16_t*)(p.ws + WS_H); const bf16_t* G = (const bf16_t*)(p.ws + A_WL);
  const bf16_t* RKV = (const bf16_t*)(p.ws + A_RKV); const float* SB = (const float*)(p.ws + A_SB);
  bf16_t* YG = (bf16_t*)(p.ws + A_AL);
  const int col = lane * 16, h = lane >> 2;
  const int gw = blockIdx.x * 4 + wid, nw = gridDim.x * 4;
  for (int row = gw; row < MTOK; row += nw) {
    float y[16]; float sm = 0.f;
#pragma unroll
    for (int half = 0; half < 2; ++half) {
      const u32x4 t = *(const u32x4*)(Y + (size_t)row * 1024 + col + half * 8);
      float* d = y + half * 8;
      d[0] = bflo(t.x); d[1] = bfhi(t.x); d[2] = bflo(t.y); d[3] = bfhi(t.y); d[4] = bflo(t.z); d[5] = bfhi(t.z); d[6] = bflo(t.w); d[7] = bfhi(t.w);
    }
#pragma unroll
    for (int e = 0; e < 16; ++e) sm += y[e];
    sm = group_sum<4>(sm);
    const float mean = sm * (1.f / 64.f);
    float vs = 0.f;
#pragma unroll
    for (int e = 0; e < 16; ++e) { const float dlt = y[e] - mean; vs += dlt * dlt; }
    vs = group_sum<4>(vs);
    const float rstd = rsqrtf(vs * (1.f / 64.f) + 64e-5f);
    const float sb = SB[(size_t)row * 16 + h];
#pragma unroll
    for (int half = 0; half < 2; ++half) {
      const int c0 = col + half * 8;
      const u32x4 tv = *(const u32x4*)(RKV + (size_t)row * 3072 + 2048 + c0), tg = *(const u32x4*)(G + (size_t)row * 1024 + c0);
      float vv[8] = {bflo(tv.x), bfhi(tv.x), bflo(tv.y), bfhi(tv.y), bflo(tv.z), bfhi(tv.z), bflo(tv.w), bfhi(tv.w)};
      float gg[8] = {bflo(tg.x), bfhi(tg.x), bflo(tg.y), bfhi(tg.y), bflo(tg.z), bfhi(tg.z), bflo(tg.w), bfhi(tg.w)};
      float o[8];
#pragma unroll
      for (int e = 0; e < 8; ++e) { const int c = c0 + e; o[e] = ((y[half * 8 + e] - mean) * rstd * p.in[33][c] + p.in[34][c] + sb * vv[e]) * gg[e]; }
      u32x4 w = {pk2(o[0], o[1]), pk2(o[2], o[3]), pk2(o[4], o[5]), pk2(o[6], o[7])};
      *(u32x4*)(YG + (size_t)row * 1024 + c0) = w;
    }
  }
}

constexpr int NPHASE = 22;
__device__ __forceinline__ void run_phase(int ph, char* smem, const Params& p) {
  bf16_t* WT = (bf16_t*)(p.ws + WS_WT);
  bf16_t* H = (bf16_t*)(p.ws + WS_H);
  const float* MOD = (const float*)(p.ws + WS_MOD);
  switch (ONLY >= 0 ? ONLY : ph) {
    case 0: phase_prologue(smem, p); break;
    case 1: phase_adaln<0>(p, p.in[0], 0, 0, H); break;
    case 2: gemm_phase(smem, H, 1024, WT + W_IN, 1024, MTOK, 2560, 1024, EpiStore{(bf16_t*)(p.ws + A_PROJ), PROJ_LD}); break;
    case 3: phase_prep0(p); break;
    case 4: gemm_phase(smem, (const bf16_t*)(p.ws + A_QLAT), 256, WT + W_UQ, 256, MTOK, 768, 256, EpiStore{(bf16_t*)((char*)p.out + O_QH), 768});
            gemm_phase(smem, (const bf16_t*)(p.ws + A_KVLAT), 128, WT + W_UKV, 128, MTOK, 1024, 128, EpiKV{(bf16_t*)(p.ws + A_KN), (bf16_t*)((char*)p.out + O_VT)}); break;
    case 5: phase_qkrope(p); break;
    case 6: phase_mix0(smem, p); break;
    case 7: phase_gdnpost(p); break;
    case 8: gemm_phase(smem, H, 1024, WT + W_OUT, 1024, MTOK, 1024, 1024, EpiResid{p.in[0], p.out, MOD + 2048}); break;
    case 9: phase_adaln<0>(p, p.out, 0, 1, H); break;
    case 10: gemm_phase(smem, H, 1024, WT + W_UP0, 1024, MTOK, 4096, 1024, EpiUp{(bf16_t*)(p.ws + A_U)}); break;
    case 11: gemm_phase(smem, (const bf16_t*)(p.ws + A_U), 4096, WT + W_DN0, 4096, MTOK, 1024, 4096, EpiResid{p.out, p.out, MOD + 5120}); break;
    case 12: phase_adaln<1>(p, p.out, 1, 0, (bf16_t*)(p.ws + A_A2)); break;
    case 13: gemm_phase(smem, (const bf16_t*)(p.ws + A_A2), 2048, WT + W_RKV, 2048, MTOK, 3456, 2048, EpiRkv{(bf16_t*)(p.ws + A_RKV), (bf16_t*)(p.ws + A_LORA)}); break;
    case 14: gemm_phase(smem, (const bf16_t*)(p.ws + A_LORA), 384, WT + W_W2, 64, MTOK, 1024, 64, EpiStore{(bf16_t*)(p.ws + A_WL), 1024});
             gemm_phase(smem, (const bf16_t*)(p.ws + A_LORA) + 64, 384, WT + W_A2, 64, MTOK, 1024, 64, EpiStore{(bf16_t*)(p.ws + A_AL), 1024}); break;
    case 15: phase_prep1(p); break;
    case 16: for (int u = blockIdx.x; u < 128; u += gridDim.x) scan_unit<1>(smem, p, u); break;
    case 17: gemm_phase(smem, (const bf16_t*)(p.ws + A_LORA) + 128, 384, WT + W_G2, 192, MTOK, 1024, 192, EpiStore{(bf16_t*)(p.ws + A_WL), 1024}); break;
    case 18: phase_post1(p); break;
    case 19: gemm_phase(smem, (const bf16_t*)(p.ws + A_AL), 1024, WT + W_O, 1024, MTOK, 1024, 1024, EpiResid{p.out, p.out, MOD + 2 * 6144 + 2048}); break;
    case 20: phase_adaln<0>(p, p.out, 1, 1, H); break;
    case 21: gemm_phase(smem, H, 1024, WT + W_UP1, 1024, MTOK, 4096, 1024, EpiUp{(bf16_t*)(p.ws + A_U)}); break;
    case 22: gemm_phase(smem, (const bf16_t*)(p.ws + A_U), 4096, WT + W_DN1, 4096, MTOK, 1024, 4096, EpiResid{p.out, p.out, MOD + 2 * 6144 + 5120}); break;
  }
}

template <int PH> __device__ __forceinline__ void do_phase(char* smem, const Params& p, int lo, int hi) {
  if (lo <= PH && PH < hi) {
    run_phase(PH, smem, p);
    if (PH + 1 < hi) { __syncthreads(); cg::this_grid().sync(); }
  }
}
__global__ void __launch_bounds__(256, 2) fwd_kernel(Params p, int lo, int hi) {
  extern __shared__ __attribute__((aligned(16))) char smem[];
  do_phase<0>(smem, p, lo, hi); do_phase<1>(smem, p, lo, hi); do_phase<2>(smem, p, lo, hi); do_phase<3>(smem, p, lo, hi);
  do_phase<4>(smem, p, lo, hi); do_phase<5>(smem, p, lo, hi); do_phase<6>(smem, p, lo, hi); do_phase<7>(smem, p, lo, hi);
  do_phase<8>(smem, p, lo, hi); do_phase<9>(smem, p, lo, hi); do_phase<10>(smem, p, lo, hi); do_phase<11>(smem, p, lo, hi);
  do_phase<12>(smem, p, lo, hi); do_phase<13>(smem, p, lo, hi); do_phase<14>(smem, p, lo, hi); do_phase<15>(smem, p, lo, hi);
  do_phase<16>(smem, p, lo, hi); do_phase<17>(smem, p, lo, hi); do_phase<18>(smem, p, lo, hi); do_phase<19>(smem, p, lo, hi);
  do_phase<20>(smem, p, lo, hi); do_phase<21>(smem, p, lo, hi); do_phase<22>(smem, p, lo, hi);
}

extern "C" void kernel_launch(void* const* d_in, const int* in_sizes, int n_in, void* d_out, int out_size, void* d_ws, size_t ws_size, hipStream_t stream) {
  constexpr size_t kDynLds = 65536;
  static int grid_blocks = 0;
  if (!grid_blocks) {
    int dev = 0, cus = 0, per_cu = 0;
    hipGetDevice(&dev);
    hipDeviceGetAttribute(&cus, hipDeviceAttributeMultiprocessorCount, dev);
    hipFuncSetAttribute((const void*)fwd_kernel, hipFuncAttributeMaxDynamicSharedMemorySize, (int)kDynLds);
    hipOccupancyMaxActiveBlocksPerMultiprocessor(&per_cu, fwd_kernel, 256, kDynLds);
    if (per_cu > 2) per_cu = 2;
    if (per_cu < 1) per_cu = 1;
    grid_blocks = cus * per_cu;
  }
  if (ws_size < WS_NEED) { fprintf(stderr, "workspace too small: %zu\n", ws_size); return; }
  Params p{};
  for (int i = 0; i < 37; ++i) p.in[i] = (const float*)d_in[i];
  p.out = (float*)d_out; p.ws = (char*)d_ws;
  constexpr int NPH = 23;
#if COOP
  int lo = 0, hi = NPH;
  void* args[] = {&p, &lo, &hi};
  hipError_t e = hipLaunchCooperativeKernel((void*)fwd_kernel, dim3(grid_blocks), dim3(256), args, kDynLds, stream);
  if (e != hipSuccess) fprintf(stderr, "cooperative launch failed: %s (grid %d)\n", hipGetErrorString(e), grid_blocks);
#else
  for (int ph = 0; ph < NPH; ++ph) fwd_kernel<<<grid_blocks, 256, kDynLds, stream>>>(p, ph, ph + 1);
#endif
}
```

```cpp
#include <hip/hip_runtime.h>
#include <hip/hip_cooperative_groups.h>
#include <cstdint>
#include <cstdio>
namespace cg = cooperative_groups;

#ifndef ONLY
#define ONLY -1
#endif
#ifndef PROBE_MASK
#define PROBE_MASK 0u
#endif
#ifndef COOP
#define COOP 1
#endif

typedef unsigned short bf16_t;
typedef short bf16x8 __attribute__((ext_vector_type(8)));
typedef float f32x4 __attribute__((ext_vector_type(4)));
typedef float f32x2 __attribute__((ext_vector_type(2)));
typedef float f32x16 __attribute__((ext_vector_type(16)));
typedef unsigned u32x4 __attribute__((ext_vector_type(4)));
typedef unsigned u32x2 __attribute__((ext_vector_type(2)));
typedef __bf16 bf16x2_t __attribute__((ext_vector_type(2)));

constexpr int NW = 8, NT = NW * 64, CTLW = 131072;
constexpr int SEQ = 16384, NBATCH = 2, MTOK = NBATCH * SEQ, DM = 1024, DFF = 4096;
constexpr int PROJ_LD = 2560;
constexpr size_t MiB = 1u << 20;
constexpr size_t WS_CTL = 0;
constexpr size_t WS_MOD = 64 * 1024;
constexpr size_t WS_WT = 1 * MiB;
constexpr size_t WS_H = 64 * MiB;
constexpr size_t WS_AR = 128 * MiB;
constexpr size_t W_IN = 0;
constexpr size_t W_UQ = W_IN + (size_t)2560 * 1024;
constexpr size_t W_UKV = W_UQ + (size_t)768 * 256;
constexpr size_t W_OUT = W_UKV + (size_t)1024 * 128;
constexpr size_t W_RKV = W_OUT + (size_t)1024 * 1024;
constexpr size_t W_W2 = W_RKV + (size_t)3584 * 2048;
constexpr size_t W_A2 = W_W2 + (size_t)1024 * 128;
constexpr size_t W_G2 = W_A2 + (size_t)1024 * 128;
constexpr size_t W_O = W_G2 + (size_t)1024 * 256;
constexpr size_t W_UP0 = W_O + (size_t)1024 * 1024;
constexpr size_t W_UP1 = W_UP0 + (size_t)4096 * 1024;
constexpr size_t W_DN0 = W_UP1 + (size_t)4096 * 1024;
constexpr size_t W_DN1 = W_DN0 + (size_t)4096 * 1024;
constexpr size_t W_END = W_DN1 + (size_t)4096 * 1024;
static_assert(W_END * 2 <= 63 * MiB, "weights fit");
constexpr size_t A_PROJ = WS_AR;
constexpr size_t A_GQ = WS_AR + 160 * MiB;
constexpr size_t A_GK = A_GQ + 32 * MiB;
constexpr size_t A_GV = A_GK + 32 * MiB;
constexpr size_t A_KN = WS_AR + 256 * MiB;
constexpr size_t A_QLAT = WS_AR + 320 * MiB;
constexpr size_t A_KVLAT = WS_AR + 336 * MiB;
constexpr size_t A_GA = WS_AR + 344 * MiB;
constexpr size_t A_GB = WS_AR + 345 * MiB;
constexpr size_t A_GO = WS_AR + 346 * MiB;
constexpr size_t A_Z = WS_AR + 288 * MiB;
constexpr size_t A_KR = WS_AR + 378 * MiB;
constexpr size_t A_GL = WS_AR + 380 * MiB;
constexpr size_t A_GG = WS_AR + 381 * MiB;
constexpr size_t A_CW = WS_AR + 0 * MiB, A_CU = WS_AR + 32 * MiB, A_CQK = WS_AR + 64 * MiB, A_CKD = WS_AR + 96 * MiB, A_CQD = WS_AR + 128 * MiB;
constexpr size_t O_QH = 0;
constexpr size_t O_KH = 48 * MiB;
constexpr size_t O_VT = 96 * MiB;
constexpr size_t A_U = WS_AR;
constexpr size_t A_A2 = WS_AR;
constexpr size_t A_WL = WS_AR;
constexpr size_t A_AL = WS_AR + 64 * MiB;
constexpr size_t A_RKV = WS_AR + 128 * MiB;
constexpr size_t A_LORA = WS_AR + 320 * MiB;
constexpr size_t A_INV = WS_AR + 344 * MiB;
constexpr size_t A_SB = WS_AR + 346 * MiB;
constexpr size_t WS_NEED = 512 * MiB;

struct Params { const float* in[37]; float* out; char* ws; };

__device__ __forceinline__ float bf2f(bf16_t h) { return __uint_as_float(((unsigned)h) << 16); }
__device__ __forceinline__ float bflo(unsigned u) { return __uint_as_float(u << 16); }
__device__ __forceinline__ float bfhi(unsigned u) { return __uint_as_float(u & 0xffff0000u); }
__device__ __forceinline__ unsigned pk2(float lo, float hi) { f32x2 v = {lo, hi}; bf16x2_t b = __builtin_convertvector(v, bf16x2_t); return __builtin_bit_cast(unsigned, b); }
__device__ __forceinline__ bf16_t f2bf(float f) { return (bf16_t)(pk2(f, 0.f) & 0xffffu); }
__device__ __forceinline__ float wave_sum(float v) {
#pragma unroll
  for (int o = 32; o; o >>= 1) v += __shfl_xor(v, o);
  return v;
}
template <int W> __device__ __forceinline__ float group_sum(float v) {
#pragma unroll
  for (int o = W / 2; o; o >>= 1) v += __shfl_xor(v, o);
  return v;
}
__device__ __forceinline__ float sigmoidf_(float x) { return 1.f / (1.f + __expf(-x)); }
__device__ __forceinline__ float siluf_(float x) { return x / (1.f + __expf(-x)); }
__device__ __forceinline__ float softplusf_(float x) { return x > 20.f ? x : log1pf(expf(x)); }
#define LDS_BARRIER() do { asm volatile("s_waitcnt lgkmcnt(0)" ::: "memory"); __builtin_amdgcn_s_barrier(); asm volatile("" ::: "memory"); } while (0)
template <int CTRL> __device__ __forceinline__ float dpp_add(float x) {
  return x + __int_as_float(__builtin_amdgcn_update_dpp(0, __float_as_int(x), CTRL, 0xf, 0xf, false));
}
__device__ __forceinline__ float row16_sum(float x) {
  x = dpp_add<0x128>(x); x = dpp_add<0x124>(x); x = dpp_add<0x122>(x); x = dpp_add<0x121>(x);
  return x;
}

__device__ __forceinline__ void conv_job(char* smem, const float* __restrict__ src, int K, int N, bf16_t* dst, int ldd, int koff, int Kp, int Np,
                         const float* mu, int mode, int& tbase) {
  const int half = threadIdx.x >> 8, tid = threadIdx.x & 255;
  bf16_t* tile = (bf16_t*)smem + half * (64 * 72);
  const int VG = gridDim.x * 2, vb = blockIdx.x * 2 + half;
  const int tk = Kp / 64, tn = Np / 64, nt = tk * tn;
  const int first = (vb - (tbase % VG) + VG) % VG;
  for (int base = 0; base < nt; base += VG) {
    const int t = base + first;
    const bool act = t < nt;
    const int k0 = (t % tk) * 64, n0 = (t / tk) * 64;
    const int nl = tid & 63, kq = tid >> 6;
    if (act) {
#pragma unroll 4
      for (int i = 0; i < 16; ++i) {
        const int kl = kq + 4 * i, k = k0 + kl, n = n0 + nl;
        float v = 0.f;
        if (k < K && n < N) { v = src[(size_t)k * N + n]; if (mode == 1) v *= mu[k]; else if (mode == 2) v *= (1.f - mu[k]); }
        tile[nl * 72 + kl] = f2bf(v);
      }
    }
    __syncthreads();
    if (act) {
      const int n = tid >> 2, seg = (tid & 3) * 16;
      const u32x4 a = *(const u32x4*)(tile + n * 72 + seg), b = *(const u32x4*)(tile + n * 72 + seg + 8);
      bf16_t* d = dst + (size_t)(n0 + n) * ldd + koff + k0 + seg;
      *(u32x4*)d = a; *(u32x4*)(d + 8) = b;
    }
    __syncthreads();
  }
  tbase += nt;
}

__device__ __forceinline__ void phase_prologue(char* smem, const Params& p) {
  const int tid = threadIdx.x, wid = tid >> 6, lane = tid & 63;
  if (blockIdx.x == 0 && tid < 64) ((unsigned*)(p.ws + WS_CTL))[tid] = 0u;
  {
    float* sc = (float*)smem;
    float* red = sc + 2048;
    const float* c = p.in[1];
    for (int i = tid; i < 2048; i += NT) sc[i] = siluf_(c[i]);
    __syncthreads();
    float* MOD = (float*)(p.ws + WS_MOD);
    for (int item = blockIdx.x; item < 192; item += gridDim.x) {
      const int l = item / 96, jg = item % 96, col = jg * 64 + lane;
      const float* w = p.in[3] + (size_t)l * 1024 * 6144 + col;
      float a0 = 0.f, a1 = 0.f;
      const int kb = wid * 128;
#pragma unroll 8
      for (int k = 0; k < 128; ++k) { const float wv = w[(size_t)(kb + k) * 6144]; a0 += sc[kb + k] * wv; a1 += sc[1024 + kb + k] * wv; }
      red[(wid * 2 + 0) * 64 + lane] = a0; red[(wid * 2 + 1) * 64 + lane] = a1;
      __syncthreads();
      if (wid < 2) {
        float s = 0.f;
#pragma unroll
        for (int ww = 0; ww < NW; ++ww) s += red[(ww * 2 + wid) * 64 + lane];
        MOD[(size_t)(l * 2 + wid) * 6144 + col] = s + p.in[4][l * 6144 + col];
      }
      __syncthreads();
    }
    __syncthreads();
  }
  bf16_t* WT = (bf16_t*)(p.ws + WS_WT);
  const float* mu = p.in[17];
  int tb = 0;
  for (int job = 0; job < 24; ++job) {
    const float* src; int K, N; bf16_t* dst; int ldd, koff, Kp, Np; const float* mup; int mode;
    switch (job) {
      case 0: src = p.in[5]; K = 1024; N = 2480; dst = WT + W_IN; ldd = 1024; koff = 0; Kp = 1024; Np = 2560; mup = nullptr; mode = 0; break;
      case 1: src = p.in[12]; K = 256; N = 768; dst = WT + W_UQ; ldd = 256; koff = 0; Kp = 256; Np = 768; mup = nullptr; mode = 0; break;
      case 2: src = p.in[13]; K = 128; N = 1024; dst = WT + W_UKV; ldd = 128; koff = 0; Kp = 128; Np = 1024; mup = nullptr; mode = 0; break;
      case 3: src = p.in[16]; K = 1024; N = 1024; dst = WT + W_OUT; ldd = 1024; koff = 0; Kp = 1024; Np = 1024; mup = nullptr; mode = 0; break;
      case 4: src = p.in[18]; K = 1024; N = 1024; dst = WT + W_RKV + (size_t)0 * 2048; ldd = 2048; koff = 0; Kp = 1024; Np = 1024; mup = mu + 0 * 1024; mode = 2; break;
      case 5: src = p.in[18]; K = 1024; N = 1024; dst = WT + W_RKV + (size_t)0 * 2048; ldd = 2048; koff = 1024; Kp = 1024; Np = 1024; mup = mu + 0 * 1024; mode = 1; break;
      case 6: src = p.in[19]; K = 1024; N = 1024; dst = WT + W_RKV + (size_t)1024 * 2048; ldd = 2048; koff = 0; Kp = 1024; Np = 1024; mup = mu + 2 * 1024; mode = 2; break;
      case 7: src = p.in[19]; K = 1024; N = 1024; dst = WT + W_RKV + (size_t)1024 * 2048; ldd = 2048; koff = 1024; Kp = 1024; Np = 1024; mup = mu + 2 * 1024; mode = 1; break;
      case 8: src = p.in[20]; K = 1024; N = 1024; dst = WT + W_RKV + (size_t)2048 * 2048; ldd = 2048; koff = 0; Kp = 1024; Np = 1024; mup = mu + 3 * 1024; mode = 2; break;
      case 9: src = p.in[20]; K = 1024; N = 1024; dst = WT + W_RKV + (size_t)2048 * 2048; ldd = 2048; koff = 1024; Kp = 1024; Np = 1024; mup = mu + 3 * 1024; mode = 1; break;
      case 10: src = p.in[23]; K = 1024; N = 64; dst = WT + W_RKV + (size_t)3072 * 2048; ldd = 2048; koff = 0; Kp = 1024; Np = 64; mup = mu + 1 * 1024; mode = 2; break;
      case 11: src = p.in[23]; K = 1024; N = 64; dst = WT + W_RKV + (size_t)3072 * 2048; ldd = 2048; koff = 1024; Kp = 1024; Np = 64; mup = mu + 1 * 1024; mode = 1; break;
      case 12: src = p.in[26]; K = 1024; N = 64; dst = WT + W_RKV + (size_t)3136 * 2048; ldd = 2048; koff = 0; Kp = 1024; Np = 64; mup = mu + 4 * 1024; mode = 2; break;
      case 13: src = p.in[26]; K = 1024; N = 64; dst = WT + W_RKV + (size_t)3136 * 2048; ldd = 2048; koff = 1024; Kp = 1024; Np = 64; mup = mu + 4 * 1024; mode = 1; break;
      case 14: src = p.in[28]; K = 1024; N = 160; dst = WT + W_RKV + (size_t)3200 * 2048; ldd = 2048; koff = 0; Kp = 1024; Np = 384; mup = mu + 5 * 1024; mode = 2; break;
      case 15: src = p.in[28]; K = 1024; N = 160; dst = WT + W_RKV + (size_t)3200 * 2048; ldd = 2048; koff = 1024; Kp = 1024; Np = 384; mup = mu + 5 * 1024; mode = 1; break;
      case 16: src = p.in[24]; K = 64; N = 1024; dst = WT + W_W2; ldd = 128; koff = 0; Kp = 128; Np = 1024; mup = nullptr; mode = 0; break;
      case 17: src = p.in[27]; K = 64; N = 1024; dst = WT + W_A2; ldd = 128; koff = 0; Kp = 128; Np = 1024; mup = nullptr; mode = 0; break;
      case 18: src = p.in[29]; K = 160; N = 1024; dst = WT + W_G2; ldd = 256; koff = 0; Kp = 256; Np = 1024; mup = nullptr; mode = 0; break;
      case 19: src = p.in[21]; K = 1024; N = 1024; dst = WT + W_O; ldd = 1024; koff = 0; Kp = 1024; Np = 1024; mup = nullptr; mode = 0; break;
      case 20: src = p.in[35]; K = 1024; N = 4096; dst = WT + W_UP0; ldd = 1024; koff = 0; Kp = 1024; Np = 4096; mup = nullptr; mode = 0; break;
      case 21: src = p.in[35] + (size_t)1024 * 4096; K = 1024; N = 4096; dst = WT + W_UP1; ldd = 1024; koff = 0; Kp = 1024; Np = 4096; mup = nullptr; mode = 0; break;
      case 22: src = p.in[36]; K = 4096; N = 1024; dst = WT + W_DN0; ldd = 4096; koff = 0; Kp = 4096; Np = 1024; mup = nullptr; mode = 0; break;
      default: src = p.in[36] + (size_t)4096 * 1024; K = 4096; N = 1024; dst = WT + W_DN1; ldd = 4096; koff = 0; Kp = 4096; Np = 1024; mup = nullptr; mode = 0; break;
    }
    conv_job(smem, src, K, N, dst, ldd, koff, Kp, Np, mup, mode, tb);
  }
}

template <int MODE> __device__ __forceinline__ void phase_adaln(const Params& p, const float* src, int layer, int which, bf16_t* dst) {
  const int tid = threadIdx.x, wid = tid >> 6, lane = tid & 63;
  const float* MOD = (const float*)(p.ws + WS_MOD);
  const int gw = blockIdx.x * NW + wid, nw = gridDim.x * NW;
  for (int row0 = gw; row0 < MTOK; row0 += 4 * nw) {
    f32x4 v[4][4];
#pragma unroll
    for (int u = 0; u < 4; ++u) {
      const int rowc = (row0 + u * nw < MTOK) ? row0 + u * nw : MTOK - 1;
      const float* xr = src + (size_t)rowc * DM;
#pragma unroll
      for (int i = 0; i < 4; ++i) v[u][i] = *(const f32x4*)(xr + i * 256 + lane * 4);
    }
    const int b0 = row0 >> 14;
    const bool sameb = ((row0 + 3 * nw) >> 14) == b0 || row0 + 3 * nw >= MTOK;
    f32x4 scv[4], shv[4];
    { const float* shift0 = MOD + (size_t)(layer * 2 + b0) * 6144 + which * 3072;
#pragma unroll
      for (int i = 0; i < 4; ++i) { scv[i] = *(const f32x4*)(shift0 + 1024 + i * 256 + lane * 4); shv[i] = *(const f32x4*)(shift0 + i * 256 + lane * 4); } }
#pragma unroll
    for (int u = 0; u < 4; ++u) {
      const int row = row0 + u * nw;
      if (row < MTOK) {
        const int b = row >> 14, s = row & (SEQ - 1);
        const float* shift = MOD + (size_t)(layer * 2 + b) * 6144 + which * 3072;
        const float* scale = shift + 1024;
        float ss = 0.f;
#pragma unroll
        for (int i = 0; i < 4; ++i) ss += v[u][i][0] * v[u][i][0] + v[u][i][1] * v[u][i][1] + v[u][i][2] * v[u][i][2] + v[u][i][3] * v[u][i][3];
        ss = wave_sum(ss);
        const float r = rsqrtf(ss * (1.f / 1024.f) + 1e-6f);
#pragma unroll
        for (int i = 0; i < 4; ++i) {
          const int col = i * 256 + lane * 4;
          f32x4 sc = scv[i], sh = shv[i];
          if (!sameb) { sc = *(const f32x4*)(scale + col); sh = *(const f32x4*)(shift + col); }
          u32x2 w;
          w.x = pk2(v[u][i][0] * r * (1.f + sc[0]) + sh[0], v[u][i][1] * r * (1.f + sc[1]) + sh[1]);
          w.y = pk2(v[u][i][2] * r * (1.f + sc[2]) + sh[2], v[u][i][3] * r * (1.f + sc[3]) + sh[3]);
          if (MODE == 0) { *(u32x2*)(dst + (size_t)row * 1024 + col) = w; }
          else {
            *(u32x2*)(dst + (size_t)row * 2048 + col) = w;
            if (s + 1 < SEQ) *(u32x2*)(dst + (size_t)(row + 1) * 2048 + 1024 + col) = w;
            if (s == 0) { u32x2 z = {0u, 0u}; *(u32x2*)(dst + (size_t)row * 2048 + 1024 + col) = z; }
          }
        }
      }
    }
  }
}

struct EpiStore { bf16_t* C; int ldc;
  __device__ __forceinline__ void operator()(int row, int col, f32x4 v) const { u32x2 w = {pk2(v[0], v[1]), pk2(v[2], v[3])}; *(u32x2*)(C + (size_t)row * ldc + col) = w; } };
struct EpiKV { bf16_t* KN; bf16_t* Vt;
  __device__ __forceinline__ void operator()(int row, int col, f32x4 v) const {
    const int h = col >> 7, c = col & 127;
    if (c < 64) { u32x2 w = {pk2(v[0], v[1]), pk2(v[2], v[3])}; *(u32x2*)(KN + (size_t)row * 512 + h * 64 + c) = w; }
    else { const int b = row >> 14, s = row & (SEQ - 1); bf16_t* d = Vt + ((size_t)((b * 8 + h) * 64 + (c - 64))) * SEQ + s;
#pragma unroll
      for (int j = 0; j < 4; ++j) d[(size_t)j * SEQ] = f2bf(v[j]); }
  } };
struct EpiResid { const float* base; float* out; const float* gate;
  __device__ __forceinline__ void operator()(int row, int col, f32x4 v) const {
    const int b = row >> 14; const f32x4 g = *(const f32x4*)(gate + (size_t)b * 6144 + col);
    const f32x4 x = *(const f32x4*)(base + (size_t)row * DM + col);
    *(f32x4*)(out + (size_t)row * DM + col) = x + g * v; } };
struct EpiUp { bf16_t* U;
  __device__ __forceinline__ void operator()(int row, int col, f32x4 v) const {
    f32x4 r;
#pragma unroll
    for (int j = 0; j < 4; ++j) { const float t = v[j] > 0.f ? v[j] : 0.f; r[j] = t * t; }
    u32x2 w = {pk2(r[0], r[1]), pk2(r[2], r[3])}; *(u32x2*)(U + (size_t)row * DFF + col) = w; } };
struct EpiRkv { bf16_t* RKV; bf16_t* LORA;
  __device__ __forceinline__ void operator()(int row, int col, f32x4 v) const {
    if (col < 3072) { u32x2 w = {pk2(v[0], v[1]), pk2(v[2], v[3])}; *(u32x2*)(RKV + (size_t)row * 3072 + col) = w; }
    else { const int c = col - 3072; f32x4 r;
      if (c < 64) { for (int j = 0; j < 4; ++j) r[j] = tanhf(v[j]); }
      else if (c < 128) r = v;
      else if (c < 288) { for (int j = 0; j < 4; ++j) r[j] = sigmoidf_(v[j]); }
      else r = (f32x4){0.f, 0.f, 0.f, 0.f};
      if (c < 384) { u32x2 w = {pk2(r[0], r[1]), pk2(r[2], r[3])}; *(u32x2*)(LORA + (size_t)row * 384 + c) = w; } }
  } };

namespace pg8 {
#define PG8_LAS __attribute__((address_space(3)))
typedef unsigned short bf16_t;
typedef short bf16x8 __attribute__((ext_vector_type(8)));
typedef float f32x4 __attribute__((ext_vector_type(4)));
typedef unsigned u32x4 __attribute__((ext_vector_type(4)));
constexpr int BM = 256, BK = 64, HALF = 128, HTB = HALF * BK * 2  , STAGE_BYTES = 8 * HTB, NXCD = 8, WGM = 8;

__host__ __device__ __forceinline__ int lds_byte(int r, int c) { const int st = (r >> 4) * 2 + (c >> 5), rr = r & 15, cc = c & 31, ob = rr * 64 + cc * 2; return st * 1024 + (ob ^ (((ob >> 9) & 1) << 5)); }
__host__ __device__ __forceinline__ void stage_rc(int b, int& R, int& C) { const int st = b / 1024, sb = b % 1024, swz = sb ^ (((sb >> 9) & 1) << 5); R = (st >> 1) * 16 + swz / 64; C = (st & 1) * 32 + (swz % 64) / 2; }
__host__ __device__ __forceinline__ int perm32(int rho) { const int n = rho >> 4, i = rho & 15; return 8 * (i >> 2) + 4 * n + (i & 3); }

struct Unit { int pm, pn; };
struct Gemm { const bf16_t* A; const bf16_t* Bt; int M, N, K, lda; };

struct StaticOrder {
    int nM, nN, nwg, G, c;
    __host__ __device__ void init(int M, int N, int G_, int c_) { nM = M / BM; nN = N / BM; nwg = nM * nN; G = G_; c = c_; }
    __host__ __device__ bool next(int i, Unit& u) const {
        const long L = (long)i * G + c; if (L >= nwg) return false;
        int wgid = (int)L; { const int q = nwg / NXCD, r = nwg % NXCD, xcd = wgid % NXCD, off = wgid / NXCD; wgid = (xcd < r ? xcd * (q + 1) : r * (q + 1) + (xcd - r) * q) + off; }
        const int nig = WGM * nN, gid = wgid / nig, fm = gid * WGM, gsz = (nM - fm) < WGM ? (nM - fm) : WGM;
        u.pm = fm + ((wgid % nig) % gsz); u.pn = (wgid % nig) / gsz; return true;
    }
    __device__ __forceinline__ void a_ready(const Unit&) const {}
    __device__ __forceinline__ void done(const Unit&) const {}
};


template <class Epi, class Sched, bool ALIGN_EPI = false, bool SP2 = false>
__device__ __forceinline__ void gemm_phase(PG8_LAS unsigned char* lds, const Gemm g, const Sched& S, const Epi& E) {
    const int tid = threadIdx.x, wid = __builtin_amdgcn_readfirstlane(tid >> 6), lane = tid & 63, wr = wid >> 2, wc = wid & 3, fr = lane & 15, fq = lane >> 4;
    const int K = g.K, nt = K / BK;
    unsigned voffA[2], voffB[2];
#pragma unroll
    for (int i = 0; i < 2; ++i) { int R, C; stage_rc(tid * 16 + i * 8192, R, C); const int Rb = Epi::PERM ? ((R & ~31) + perm32(R & 31)) : R;
        voffA[i] = (unsigned)(R * g.lda + C) * 2u; voffB[i] = (unsigned)(Rb * K + C) * 2u; }
    const size_t kstep = (size_t)(BK * 2);
    const size_t hstepA = (size_t)HALF * g.lda * 2, hstepB = (size_t)HALF * K * 2;
    const size_t tstepA = 2 * hstepA, tstepB = 2 * hstepB;
    const unsigned ldsw = (unsigned)wid * 1024u;
    const int aoff = lds_byte(wr * 64 + fr, fq * 8), boff = lds_byte(wc * 32 + fr, fq * 8);
#define PG8_SA(b, h) (((b) * 2 + (h)) * HTB)
#define PG8_SB(b, h) ((4 + (b) * 2 + (h)) * HTB)
#define PG8_STAGE(bufoff, gbase, voff) do { _Pragma("unroll") for (int _i = 0; _i < 2; ++_i) \
        __builtin_amdgcn_global_load_lds((const unsigned*)((const char*)(gbase) + (voff)[_i]), (PG8_LAS unsigned*)(lds + (bufoff) + ldsw + _i * 8192), 16, 0, 0); } while (0)
#define PG8_LDA(dst, b, h) do { _Pragma("unroll") for (int m = 0; m < 4; ++m) _Pragma("unroll") for (int k = 0; k < 2; ++k) dst[m][k] = *(const PG8_LAS bf16x8*)(lds + PG8_SA(b, h) + aoff + m * 2048 + k * 1024); } while (0)
#define PG8_LDB(dst, b, h) do { _Pragma("unroll") for (int n = 0; n < 2; ++n) _Pragma("unroll") for (int k = 0; k < 2; ++k) dst[n][k] = *(const PG8_LAS bf16x8*)(lds + PG8_SB(b, h) + boff + n * 2048 + k * 1024); } while (0)
#define PG8_MMA(ai, bj, At, Bt) do { __builtin_amdgcn_s_setprio(1); _Pragma("unroll") for (int m = 0; m < 4; ++m) _Pragma("unroll") for (int n = 0; n < 2; ++n) _Pragma("unroll") for (int k = 0; k < 2; ++k) \
        acc[ai][bj][m][n] = __builtin_amdgcn_mfma_f32_16x16x32_bf16(Bt[n][k], At[m][k], acc[ai][bj][m][n], 0, 0, 0); __builtin_amdgcn_s_setprio(0); } while (0)
#define PG8_WAIT_V(n) asm volatile("s_waitcnt vmcnt(" #n ")" ::: "memory")
#define PG8_WAIT_L(n) asm volatile("s_waitcnt lgkmcnt(" #n ")" ::: "memory")
#define PG8_BAR __builtin_amdgcn_s_barrier()
#define PG8_SCHED __builtin_amdgcn_sched_barrier(0)
    Unit cur, nxt; int ui = 0;
    if (!S.next(0, cur)) return;
    f32x4 acc[2][2][4][2];
#pragma unroll
    for (int a = 0; a < 2; ++a)
#pragma unroll
        for (int b = 0; b < 2; ++b)
#pragma unroll
            for (int m = 0; m < 4; ++m)
#pragma unroll
                for (int n = 0; n < 2; ++n) acc[a][b][m][n] = (f32x4){0.f, 0.f, 0.f, 0.f};
    bf16x8 At[4][2], B0[2][2], B1[2][2];
    const char* cA = (const char*)g.A + (size_t)cur.pm * tstepA; const char* cB = (const char*)g.Bt + (size_t)cur.pn * tstepB;
    S.a_ready(cur);
    if constexpr (SP2) {
        PG8_STAGE(PG8_SB(0, 0), cB, voffB); PG8_STAGE(PG8_SB(0, 1), cB + hstepB, voffB); PG8_STAGE(PG8_SA(0, 0), cA, voffA); PG8_STAGE(PG8_SA(0, 1), cA + hstepA, voffA);
        if (wr == 1) PG8_BAR;
        PG8_WAIT_V(2); PG8_BAR;
        PG8_STAGE(PG8_SB(1, 0), cB + kstep, voffB); PG8_STAGE(PG8_SA(1, 0), cA + kstep, voffA); PG8_STAGE(PG8_SB(1, 1), cB + hstepB + kstep, voffB);
        PG8_WAIT_V(6); PG8_BAR;
    } else {
        PG8_STAGE(PG8_SB(0, 0), cB, voffB); PG8_STAGE(PG8_SA(0, 0), cA, voffA); PG8_STAGE(PG8_SB(0, 1), cB + hstepB, voffB); PG8_STAGE(PG8_SA(0, 1), cA + hstepA, voffA);
        if (wr == 1) PG8_BAR;
        PG8_WAIT_V(4); PG8_BAR;
        PG8_STAGE(PG8_SB(1, 0), cB + kstep, voffB); PG8_STAGE(PG8_SA(1, 0), cA + kstep, voffA); PG8_STAGE(PG8_SB(1, 1), cB + hstepB + kstep, voffB);
        PG8_WAIT_V(6); PG8_BAR;
    }
    for (;;) {
        const bool has_next = S.next(ui + 1, nxt);
        const char* nA = has_next ? (const char*)g.A + (size_t)nxt.pm * tstepA : cA; const char* nB = has_next ? (const char*)g.Bt + (size_t)nxt.pn * tstepB : cB;
#pragma unroll 1
        for (int t = 0; t < nt; t += 2) {
            const bool last = (t == nt - 2);
            const char* a1 = cA + (size_t)(t + 1) * kstep;
            const char* a2 = last ? nA : cA + (size_t)(t + 2) * kstep; const char* b2 = last ? nB : cB + (size_t)(t + 2) * kstep;
            const char* a3 = a2 + kstep; const char* b3 = b2 + kstep;
            if (last && has_next) S.a_ready(nxt);
            if constexpr (SP2) {
            PG8_LDB(B0, 0, 0); PG8_LDB(B1, 0, 1); PG8_SCHED; PG8_LDA(At, 0, 0); PG8_STAGE(PG8_SA(1, 1), a1 + hstepA, voffA);
            PG8_WAIT_V(8); PG8_WAIT_L(0); PG8_BAR; PG8_MMA(0, 0, At, B0); PG8_MMA(0, 1, At, B1); PG8_BAR; PG8_SCHED;
            PG8_LDA(At, 0, 1); PG8_STAGE(PG8_SB(0, 0), b2, voffB); PG8_STAGE(PG8_SB(0, 1), b2 + hstepB, voffB); PG8_STAGE(PG8_SA(0, 0), a2, voffA);
            PG8_WAIT_V(8); PG8_WAIT_L(0); PG8_BAR; PG8_MMA(1, 0, At, B0); PG8_MMA(1, 1, At, B1); PG8_BAR; PG8_SCHED;
            PG8_LDB(B0, 1, 0); PG8_LDB(B1, 1, 1); PG8_SCHED; PG8_LDA(At, 1, 0); PG8_STAGE(PG8_SA(0, 1), a2 + hstepA, voffA);
            PG8_WAIT_V(8); PG8_WAIT_L(0); PG8_BAR; PG8_MMA(0, 0, At, B0); PG8_MMA(0, 1, At, B1); PG8_BAR; PG8_SCHED;
            PG8_LDA(At, 1, 1); PG8_STAGE(PG8_SB(1, 0), b3, voffB); PG8_STAGE(PG8_SB(1, 1), b3 + hstepB, voffB); PG8_STAGE(PG8_SA(1, 0), a3, voffA);
            PG8_WAIT_V(8); PG8_WAIT_L(0); PG8_BAR; PG8_MMA(1, 0, At, B0); PG8_MMA(1, 1, At, B1); PG8_BAR; PG8_SCHED;
            } else {
            PG8_LDB(B0, 0, 0); PG8_SCHED; PG8_LDA(At, 0, 0); PG8_STAGE(PG8_SA(1, 1), a1 + hstepA, voffA);
            PG8_WAIT_L(8); PG8_BAR; PG8_WAIT_L(0); PG8_MMA(0, 0, At, B0); PG8_BAR; PG8_SCHED;
            PG8_LDB(B1, 0, 1); PG8_STAGE(PG8_SB(0, 0), b2, voffB);
            PG8_BAR; PG8_WAIT_L(0); PG8_MMA(0, 1, At, B1); PG8_BAR;
            PG8_LDA(At, 0, 1); PG8_STAGE(PG8_SA(0, 0), a2, voffA);
            PG8_BAR; PG8_WAIT_L(0); PG8_MMA(1, 0, At, B0); PG8_BAR; PG8_SCHED;
            PG8_STAGE(PG8_SB(0, 1), b2 + hstepB, voffB);
            PG8_WAIT_V(6); PG8_BAR; PG8_MMA(1, 1, At, B1); PG8_BAR;
            PG8_LDB(B0, 1, 0); PG8_SCHED; PG8_LDA(At, 1, 0); PG8_STAGE(PG8_SA(0, 1), a2 + hstepA, voffA);
            PG8_WAIT_L(8); PG8_BAR; PG8_WAIT_L(0); PG8_MMA(0, 0, At, B0); PG8_BAR; PG8_SCHED;
            PG8_LDB(B1, 1, 1); PG8_STAGE(PG8_SB(1, 0), b3, voffB);
            PG8_BAR; PG8_WAIT_L(0); PG8_MMA(0, 1, At, B1); PG8_BAR;
            PG8_LDA(At, 1, 1); PG8_STAGE(PG8_SA(1, 0), a3, voffA);
            PG8_BAR; PG8_WAIT_L(0); PG8_MMA(1, 0, At, B0); PG8_BAR; PG8_SCHED;
            PG8_STAGE(PG8_SB(1, 1), b3 + hstepB, voffB);
            PG8_WAIT_V(6); PG8_BAR; PG8_MMA(1, 1, At, B1); PG8_BAR;
            }
        }
        if constexpr (ALIGN_EPI) { if (wr == 0) PG8_BAR; }
        if constexpr (!Epi::AFTER_DRAIN) { E(acc, cur, wr, wc, fr, fq); S.done(cur); }
        if (!has_next) break;
#pragma unroll
        for (int a = 0; a < 2; ++a)
#pragma unroll
            for (int b = 0; b < 2; ++b)
#pragma unroll
                for (int m = 0; m < 4; ++m)
#pragma unroll
                    for (int n = 0; n < 2; ++n) acc[a][b][m][n] = (f32x4){0.f, 0.f, 0.f, 0.f};
        cur = nxt; cA = nA; cB = nB; ++ui;
        if constexpr (ALIGN_EPI) { if (wr == 1) PG8_BAR; }
    }
    PG8_WAIT_V(0);
    if constexpr (!ALIGN_EPI) { if (wr == 0) PG8_BAR; }
    PG8_BAR;
    if constexpr (Epi::AFTER_DRAIN) { E.fused(acc, cur, wr, wc, fr, fq, lds, wid, lane); S.done(cur); }
#undef PG8_SA
#undef PG8_SB
#undef PG8_STAGE
#undef PG8_LDA
#undef PG8_LDB
#undef PG8_MMA
#undef PG8_WAIT_V
#undef PG8_WAIT_L
#undef PG8_BAR
#undef PG8_SCHED
}
}


template <class F> struct EpiAdapt {
  static constexpr bool PERM = false, AFTER_DRAIN = false; F f;
  __device__ __forceinline__ void operator()(const pg8::f32x4 (&acc)[2][2][4][2], const pg8::Unit& u, int wr, int wc, int fr, int fq) const {
#pragma unroll
    for (int ai = 0; ai < 2; ++ai)
#pragma unroll
      for (int m = 0; m < 4; ++m) { const int row = u.pm * 256 + 128 * ai + 64 * wr + 16 * m + fr;
#pragma unroll
        for (int bj = 0; bj < 2; ++bj)
#pragma unroll
          for (int n = 0; n < 2; ++n) f(row, u.pn * 256 + 128 * bj + 32 * wc + 16 * n + 4 * fq, acc[ai][bj][m][n]); }
  }
};
template <class F>
__device__ __forceinline__ void gemm_phase(char* smem, const bf16_t* A, int lda, const bf16_t* Bt, int ldb, int M, int N, int K, const F f) {
  (void)ldb;
  asm volatile("" : "+s"(K));
  pg8::Gemm g{A, Bt, M, N, K, lda}; pg8::StaticOrder S; S.init(M, N, (int)gridDim.x, (int)blockIdx.x);
  EpiAdapt<F> E{f};
  pg8::gemm_phase<EpiAdapt<F>, pg8::StaticOrder, true, true>((PG8_LAS unsigned char*)smem, g, S, E);
  __syncthreads();
}

__device__ __forceinline__ void phase_prep0(const Params& p) {
  const int tid = threadIdx.x, wid = tid >> 6, lane = tid & 63;
  const bf16_t* PROJ = (const bf16_t*)(p.ws + A_PROJ);
  bf16_t* GQKV[3] = {(bf16_t*)(p.ws + A_GQ), (bf16_t*)(p.ws + A_GK), (bf16_t*)(p.ws + A_GV)};
  float* GA = (float*)(p.ws + A_GA); float* GB = (float*)(p.ws + A_GB);
  bf16_t* QLAT = (bf16_t*)(p.ws + A_QLAT); bf16_t* KVLAT = (bf16_t*)(p.ws + A_KVLAT);
  const float* cw = p.in[6];
  const int gw = blockIdx.x * NW + wid, nw = gridDim.x * NW;
  f32x4 cwa[3][4], cwb[3][4];
#pragma unroll
  for (int part = 0; part < 3; ++part)
#pragma unroll
    for (int j = 0; j < 4; ++j) { cwa[part][j] = *(const f32x4*)(cw + j * 1536 + part * 512 + lane * 8); cwb[part][j] = *(const f32x4*)(cw + j * 1536 + part * 512 + lane * 8 + 4); }
  const f32x4 gq4 = *(const f32x4*)(p.in[10] + lane * 4);
  const f32x2 gkv2 = *(const f32x2*)(p.in[11] + lane * 2);
#pragma unroll 2
  for (int row = gw; row < MTOK; row += nw) {
    const int s = row & (SEQ - 1);
    const bf16_t* pr = PROJ + (size_t)row * PROJ_LD;
#pragma unroll
    for (int part = 0; part < 3; ++part) {
      const int col = part * 512 + lane * 8;
      float acc[8];
#pragma unroll
      for (int e = 0; e < 8; ++e) acc[e] = 0.f;
#pragma unroll
      for (int j = 0; j < 4; ++j) {
        const int ds = 3 - j;
        if (s - ds >= 0) {
          const u32x4 t = *(const u32x4*)(pr - (size_t)ds * PROJ_LD + col);
          const f32x4 w0 = cwa[part][j], w1 = cwb[part][j];
          acc[0] += w0[0] * bflo(t.x); acc[1] += w0[1] * bfhi(t.x); acc[2] += w0[2] * bflo(t.y); acc[3] += w0[3] * bfhi(t.y);
          acc[4] += w1[0] * bflo(t.z); acc[5] += w1[1] * bfhi(t.z); acc[6] += w1[2] * bflo(t.w); acc[7] += w1[3] * bfhi(t.w);
        }
      }
      float ss = 0.f;
#pragma unroll
      for (int e = 0; e < 8; ++e) { acc[e] = siluf_(acc[e]); ss += acc[e] * acc[e]; }
      if (part < 2) {
        ss = group_sum<8>(ss);
        const float r = rsqrtf(ss + 1e-12f);
#pragma unroll
        for (int e = 0; e < 8; ++e) acc[e] *= r;
      }
      u32x4 w = {pk2(acc[0], acc[1]), pk2(acc[2], acc[3]), pk2(acc[4], acc[5]), pk2(acc[6], acc[7])};
      *(u32x4*)(GQKV[part] + ((size_t)((row >> 14) * 8 + (lane >> 3)) * SEQ + s) * 64 + (lane & 7) * 8) = w;
    }
    if (lane < 8) {
      const float a = bf2f(pr[2048 + lane]), bb = bf2f(pr[2056 + lane]);
      const float g = -expf(p.in[7][lane]) * softplusf_(a + p.in[8][lane]);
      GA[(size_t)row * 8 + lane] = expf(g);
      ((float*)(p.ws + A_GG))[(size_t)row * 8 + lane] = g;
      GB[(size_t)row * 8 + lane] = sigmoidf_(bb);
    }
    {
      *(u32x4*)((bf16_t*)(p.ws + A_Z) + (size_t)row * 512 + lane * 8) = *(const u32x4*)(pr + 1536 + lane * 8);
      if (lane < 16) *(unsigned*)((bf16_t*)(p.ws + A_KR) + (size_t)row * 32 + lane * 2) = *(const unsigned*)(pr + 2448 + lane * 2);
    }
    {
      const u32x2 t = *(const u32x2*)(pr + 2064 + lane * 4);
      float v0 = bflo(t.x), v1 = bfhi(t.x), v2 = bflo(t.y), v3 = bfhi(t.y);
      float ss = wave_sum(v0 * v0 + v1 * v1 + v2 * v2 + v3 * v3);
      const float r = rsqrtf(ss * (1.f / 256.f) + 1e-6f);
      const f32x4 g = gq4;
      u32x2 w = {pk2(v0 * r * g[0], v1 * r * g[1]), pk2(v2 * r * g[2], v3 * r * g[3])};
      *(u32x2*)(QLAT + (size_t)row * 256 + lane * 4) = w;
    }
    {
      const unsigned t = *(const unsigned*)(pr + 2320 + lane * 2);
      float v0 = bflo(t), v1 = bfhi(t);
      float ss = wave_sum(v0 * v0 + v1 * v1);
      const float r = rsqrtf(ss * (1.f / 128.f) + 1e-6f);
      const f32x2 g = gkv2;
      *(unsigned*)(KVLAT + (size_t)row * 128 + lane * 2) = pk2(v0 * r * g[0], v1 * r * g[1]);
    }
  }
}

__device__ __forceinline__ void phase_qkrope(const Params& p) {
  const int tid = threadIdx.x, wid = tid >> 6, lane = tid & 63;
  const int h = lane >> 3, sub = lane & 7;
  bf16_t* QH = (bf16_t*)((char*)p.out + O_QH); bf16_t* KH = (bf16_t*)((char*)p.out + O_KH);
  const bf16_t* KN = (const bf16_t*)(p.ws + A_KN); const bf16_t* PROJ = (const bf16_t*)(p.ws + A_PROJ);
  const int* pos = (const int*)p.in[2];
  const float* qg = p.in[14]; const float* kg = p.in[15];
  float qgn[8], kgn[8], qg1[2], qg2[2], kg1[2], kg2[2];
#pragma unroll
  for (int e = 0; e < 8; ++e) { qgn[e] = qg[sub * 8 + e]; kgn[e] = kg[sub * 8 + e]; }
#pragma unroll
  for (int e = 0; e < 2; ++e) { qg1[e] = qg[64 + 2 * sub + e]; qg2[e] = qg[80 + 2 * sub + e]; kg1[e] = kg[64 + 2 * sub + e]; kg2[e] = kg[80 + 2 * sub + e]; }
  float invf[2];
#pragma unroll
  for (int e = 0; e < 2; ++e) invf[e] = powf(10000.0f, -(float)(2 * (2 * sub + e)) / 32.0f);
  const float qscale = 0.10206207261596577f * 1.4426950408889634f;
  const int gw = blockIdx.x * NW + wid, nw = gridDim.x * NW;
#pragma unroll 2
  for (int row = gw; row < MTOK; row += nw) {
    const float fp = (float)pos[row];
    float cs[2], sn[2];
#pragma unroll
    for (int e = 0; e < 2; ++e) {
      const float ang = fp * invf[e];
      const double rev = (double)ang * 0.15915494309189535;
      const float fr = (float)(rev - rint(rev));
      sn[e] = __builtin_amdgcn_sinf(fr); cs[e] = __builtin_amdgcn_cosf(fr);
    }
    {
      bf16_t* q = QH + (size_t)row * 768 + h * 96;
      const u32x4 t = *(const u32x4*)(q + sub * 8);
      const unsigned t1 = *(const unsigned*)(q + 64 + 2 * sub), t2 = *(const unsigned*)(q + 80 + 2 * sub);
      float v[8] = {bflo(t.x), bfhi(t.x), bflo(t.y), bfhi(t.y), bflo(t.z), bfhi(t.z), bflo(t.w), bfhi(t.w)};
      float x1[2] = {bflo(t1), bfhi(t1)}, x2[2] = {bflo(t2), bfhi(t2)};
      float ss = x1[0] * x1[0] + x1[1] * x1[1] + x2[0] * x2[0] + x2[1] * x2[1];
#pragma unroll
      for (int e = 0; e < 8; ++e) ss += v[e] * v[e];
      ss = group_sum<8>(ss);
      const float r = rsqrtf(ss * (1.f / 96.f) + 1e-6f) * qscale;
#pragma unroll
      for (int e = 0; e < 8; ++e) v[e] *= r * qgn[e];
      float o1[2], o2[2];
#pragma unroll
      for (int e = 0; e < 2; ++e) { const float a = x1[e] * r * qg1[e], b = x2[e] * r * qg2[e]; o1[e] = a * cs[e] - b * sn[e]; o2[e] = b * cs[e] + a * sn[e]; }
      u32x4 w = {pk2(v[0], v[1]), pk2(v[2], v[3]), pk2(v[4], v[5]), pk2(v[6], v[7])};
      *(u32x4*)(q + sub * 8) = w; *(unsigned*)(q + 64 + 2 * sub) = pk2(o1[0], o1[1]); *(unsigned*)(q + 80 + 2 * sub) = pk2(o2[0], o2[1]);
    }
    {
      const bf16_t* kn = KN + (size_t)row * 512 + h * 64; const bf16_t* kr = (const bf16_t*)(p.ws + A_KR) + (size_t)row * 32;
      bf16_t* k = KH + (size_t)row * 768 + h * 96;
      const u32x4 t = *(const u32x4*)(kn + sub * 8);
      const unsigned t1 = *(const unsigned*)(kr + 2 * sub), t2 = *(const unsigned*)(kr + 16 + 2 * sub);
      float v[8] = {bflo(t.x), bfhi(t.x), bflo(t.y), bfhi(t.y), bflo(t.z), bfhi(t.z), bflo(t.w), bfhi(t.w)};
      float x1[2] = {bflo(t1), bfhi(t1)}, x2[2] = {bflo(t2), bfhi(t2)};
      float ss = x1[0] * x1[0] + x1[1] * x1[1] + x2[0] * x2[0] + x2[1] * x2[1];
#pragma unroll
      for (int e = 0; e < 8; ++e) ss += v[e] * v[e];
      ss = group_sum<8>(ss);
      const float r = rsqrtf(ss * (1.f / 96.f) + 1e-6f);
#pragma unroll
      for (int e = 0; e < 8; ++e) v[e] *= r * kgn[e];
      float o1[2], o2[2];
#pragma unroll
      for (int e = 0; e < 2; ++e) { const float a = x1[e] * r * kg1[e], b = x2[e] * r * kg2[e]; o1[e] = a * cs[e] - b * sn[e]; o2[e] = b * cs[e] + a * sn[e]; }
      u32x4 w = {pk2(v[0], v[1]), pk2(v[2], v[3]), pk2(v[4], v[5]), pk2(v[6], v[7])};
      *(u32x4*)(k + sub * 8) = w; *(unsigned*)(k + 64 + 2 * sub) = pk2(o1[0], o1[1]); *(unsigned*)(k + 80 + 2 * sub) = pk2(o2[0], o2[1]);
    }
  }
}

__device__ __forceinline__ float row32_sum(float x) {
  x = row16_sum(x);
  auto rr = __builtin_amdgcn_permlane32_swap(__float_as_uint(x), __float_as_uint(x), false, false);
  return __uint_as_float(rr[0]) + __uint_as_float(rr[1]);
}
template <int MODE> __device__ __forceinline__ void scan_unit(char* smem, const Params& p, int unit) {
  constexpr int T = 16, STEPF = 328, NH = MODE == 0 ? 8 : 16;
  const bool producer = threadIdx.x >= 256;
  const int tid = threadIdx.x & 255, rowl = (tid >> 6) * 2 + ((tid >> 4) & 1), j = (tid & 15) + ((tid >> 5) & 1) * 16;
  const int st = tid >> 4, sj = tid & 15;
  const int bh = unit >> 3, row0 = (unit & 7) * 8;
  const int b = bh / NH, h = bh % NH;
  float* buf = (float*)smem;
  const bf16_t* GQ = (const bf16_t*)(p.ws + A_GQ); const bf16_t* GK = (const bf16_t*)(p.ws + A_GK); const bf16_t* GV = (const bf16_t*)(p.ws + A_GV);
  const float* GA = (const float*)(p.ws + A_GA); const float* GB = (const float*)(p.ws + A_GB);
  bf16_t* GO = (bf16_t*)(p.ws + A_GO);
  const bf16_t* RKV = (const bf16_t*)(p.ws + A_RKV); const bf16_t* EE = (const bf16_t*)(p.ws + A_WL); const bf16_t* AA = (const bf16_t*)(p.ws + A_AL);
  const float* INV = (const float*)(p.ws + A_INV);
  bf16_t* Y = (bf16_t*)(p.ws + WS_H);
  f32x4 ckk = {0.f, 0.f, 0.f, 0.f}, cka = {0.f, 0.f, 0.f, 0.f};
  if (MODE == 1) { ckk = *(const f32x4*)(p.in[30] + h * 64 + 4 * sj); cka = *(const f32x4*)(p.in[31] + h * 64 + 4 * sj); }
  u32x2 g0, g1, g2, g3; float gs0 = 0.f, gs1 = 0.f; bf16_t gv = 0;
  auto gload = [&](int chunk) {
    const size_t tok = (size_t)b * SEQ + (size_t)chunk * T + st;
    if (MODE == 0) {
      g0 = *(const u32x2*)(GQ + tok * 512 + h * 64 + 4 * sj); g1 = *(const u32x2*)(GK + tok * 512 + h * 64 + 4 * sj);
      gs0 = GA[tok * 8 + h]; gs1 = GB[tok * 8 + h]; if (sj < 8) gv = GV[tok * 512 + h * 64 + row0 + sj];
    } else {
      g0 = *(const u32x2*)(RKV + tok * 3072 + h * 64 + 4 * sj); g1 = *(const u32x2*)(RKV + tok * 3072 + 1024 + h * 64 + 4 * sj);
      g2 = *(const u32x2*)(EE + tok * 1024 + h * 64 + 4 * sj); g3 = *(const u32x2*)(AA + tok * 1024 + h * 64 + 4 * sj);
      gs0 = INV[tok * 16 + h]; if (sj < 8) gv = RKV[tok * 3072 + 2048 + h * 64 + row0 + sj];
    }
  };
  auto gstore = [&](float* dst) {
    float* d = dst + st * STEPF;
    f32x4 r, w, k, a, bb; float v;
    if (MODE == 0) {
      const f32x4 q = {bflo(g0.x), bfhi(g0.x), bflo(g0.y), bfhi(g0.y)};
      k = (f32x4){bflo(g1.x), bfhi(g1.x), bflo(g1.y), bfhi(g1.y)};
      const float al = gs0, be = gs1;
      r = q * 0.125f; w = (f32x4){al, al, al, al}; a = k * (-al * be); bb = k; v = be * bf2f(gv);
    } else {
      r = (f32x4){bflo(g0.x), bfhi(g0.x), bflo(g0.y), bfhi(g0.y)};
      const f32x4 k0 = {bflo(g1.x), bfhi(g1.x), bflo(g1.y), bfhi(g1.y)};
      const f32x4 e = {bflo(g2.x), bfhi(g2.x), bflo(g2.y), bfhi(g2.y)};
      const f32x4 av = {bflo(g3.x), bfhi(g3.x), bflo(g3.y), bfhi(g3.y)};
      const f32x4 kk = k0 * ckk * gs0;
      a = -kk; bb = kk * av; k = k0 * (1.f + (av - 1.f) * cka);
      w = (f32x4){__expf(-e[0]), __expf(-e[1]), __expf(-e[2]), __expf(-e[3])};
      v = bf2f(gv);
    }
    *(f32x4*)(d + 4 * sj) = r; *(f32x4*)(d + 64 + 4 * sj) = w; *(f32x4*)(d + 128 + 4 * sj) = k; *(f32x4*)(d + 192 + 4 * sj) = a; *(f32x4*)(d + 256 + 4 * sj) = bb;
    if (sj < 8) d[320 + sj] = v;
  };
  f32x2 s = {0.f, 0.f};
  constexpr int NCH = SEQ / T;
  if (producer) { gload(0); gstore(buf); gload(1); }
  __syncthreads();
  for (int c = 0; c < NCH; ++c) {
    const float* cur = buf + (c & 1) * (T * STEPF);
    float* nxt = buf + ((c + 1) & 1) * (T * STEPF);
    if (producer) {
      if (c + 1 < NCH) gstore(nxt);
      if (c + 2 < NCH) gload(c + 2);
    } else {
    float yp[T];
    f32x2 r = *(const f32x2*)(cur + 2 * j), w = *(const f32x2*)(cur + 64 + 2 * j), k = *(const f32x2*)(cur + 128 + 2 * j),
          a = *(const f32x2*)(cur + 192 + 2 * j), bb = *(const f32x2*)(cur + 256 + 2 * j);
    float v = cur[320 + rowl];
#pragma unroll
    for (int t = 0; t < T; ++t) {
      f32x2 nr = r, nw = w, nk = k, na = a, nb = bb; float nv = v;
      if (t + 1 < T) {
        const float* d = cur + (t + 1) * STEPF;
        nr = *(const f32x2*)(d + 2 * j); nw = *(const f32x2*)(d + 64 + 2 * j); nk = *(const f32x2*)(d + 128 + 2 * j);
        na = *(const f32x2*)(d + 192 + 2 * j); nb = *(const f32x2*)(d + 256 + 2 * j); nv = d[320 + rowl];
      }
      float pa = s[0] * a[0] + s[1] * a[1];
      const f32x2 tkw = s * w + k * v;
      pa = row32_sum(pa);
      s = tkw + bb * pa;
      yp[t] = s[0] * r[0] + s[1] * r[1];
      r = nr; w = nw; k = nk; a = na; bb = nb; v = nv;
    }
    {
      float z[8];
#pragma unroll
      for (int i = 0; i < 8; ++i) { auto rr = __builtin_amdgcn_permlane32_swap(__float_as_uint(yp[i]), __float_as_uint(yp[i + 8]), false, false);
        z[i] = __uint_as_float(rr[0]) + __uint_as_float(rr[1]); }
      const int ln = threadIdx.x & 63;
      const bool b3 = (ln & 8) != 0, b2 = (ln & 4) != 0, b1 = (ln & 2) != 0;
      float n4[4], n2[2];
#pragma unroll
      for (int i = 0; i < 4; ++i) { const float wv = b3 ? z[i + 4] : z[i], ov = b3 ? z[i] : z[i + 4];
        n4[i] = wv + __int_as_float(__builtin_amdgcn_update_dpp(0, __float_as_int(ov), 0x140, 0xf, 0xf, false)); }
#pragma unroll
      for (int i = 0; i < 2; ++i) { const float wv = b2 ? n4[i + 2] : n4[i], ov = b2 ? n4[i] : n4[i + 2];
        n2[i] = wv + __int_as_float(__builtin_amdgcn_update_dpp(0, __float_as_int(ov), 0x141, 0xf, 0xf, false)); }
      const float wv = b1 ? n2[1] : n2[0], ov = b1 ? n2[0] : n2[1];
      const float n1 = wv + __int_as_float(__builtin_amdgcn_update_dpp(0, __float_as_int(ov), 0x1B, 0xf, 0xf, false));
      const float yt = n1 + __int_as_float(__builtin_amdgcn_update_dpp(0, __float_as_int(n1), 0xB1, 0xf, 0xf, false));
      if ((ln & 1) == 0) {
        const int t = 8 * (ln >> 5) + ((ln >> 1) & 7);
        const size_t tok = (size_t)b * SEQ + (size_t)c * T + t;
        if (MODE == 0) GO[tok * 512 + h * 64 + row0 + rowl] = f2bf(yt);
        else Y[tok * 1024 + h * 64 + row0 + rowl] = f2bf(yt);
      }
    }
    }
    LDS_BARRIER();
  }
  __syncthreads();
}

__device__ __forceinline__ void attn_unit(char* smem, const Params& p, int b, int h, int qb) {
  const int tid = threadIdx.x, wid = tid >> 6, lane = tid & 63, r32 = lane & 31, hi = lane >> 5;
  const bf16_t* QH = (const bf16_t*)((const char*)p.out + O_QH); const bf16_t* KH = (const bf16_t*)((const char*)p.out + O_KH);
  const bf16_t* VT = (const bf16_t*)((const char*)p.out + O_VT);
  bf16_t* MIX = (bf16_t*)(p.ws + WS_H);
  const int q0 = qb * 256, qrow = q0 + wid * 32 + r32;
  const size_t tokq = (size_t)b * SEQ + qrow;
  bf16x8 qr[6];
#pragma unroll
  for (int ks = 0; ks < 6; ++ks) qr[ks] = *(const bf16x8*)(QH + tokq * 768 + h * 96 + ks * 16 + hi * 8);
  f32x16 o0 = {}, o1 = {};
  float m = -1e30f, l = 0.f;
  const int ntiles = (q0 + 256) / 64;
  const bf16_t* Kg = KH + ((size_t)b * SEQ) * 768 + h * 96;
  const bf16_t* Vg = VT + ((size_t)(b * 8 + h) * 64) * SEQ;
  int krow[2], kc[2];
#pragma unroll
  for (int i = 0; i < 2; ++i) { const int id = tid + 512 * i; krow[i] = id / 12; kc[i] = id % 12; }
  const bool k2 = tid < 256;
  const int vrow = tid >> 3, vc = tid & 7;
  u32x4 rk[2], rv;
  rk[1] = (u32x4){0u, 0u, 0u, 0u};
  constexpr int STG = 22528, KSZ = 13312;
  auto gload = [&](int t) {
    const int kv0 = t * 64;
    rk[0] = *(const u32x4*)(Kg + (size_t)(kv0 + krow[0]) * 768 + kc[0] * 8);
    if (k2) rk[1] = *(const u32x4*)(Kg + (size_t)(kv0 + krow[1]) * 768 + kc[1] * 8);
    rv = *(const u32x4*)(Vg + (size_t)vrow * SEQ + kv0 + vc * 8);
  };
  auto sstore = [&](char* st) {
    *(u32x4*)(st + krow[0] * 208 + kc[0] * 16) = rk[0];
    if (k2) *(u32x4*)(st + krow[1] * 208 + kc[1] * 16) = rk[1];
    { char* d = st + KSZ + vrow * 144 + (vc >> 1) * 32 + (vc & 1) * 8;
      *(u32x2*)d = (u32x2){rv.x, rv.y}; *(u32x2*)(d + 16) = (u32x2){rv.z, rv.w}; }
  };
  gload(0); sstore(smem);
  __syncthreads();
  for (int t = 0; t < ntiles; ++t) {
    char* cur = smem + (t & 1) * STG; char* nxt = smem + ((t + 1) & 1) * STG;
    const bool more = t + 1 < ntiles;
    if (more) gload(t + 1);
    const int kv0 = t * 64;
    const int wq0 = q0 + wid * 32;
    if (kv0 <= wq0 + 31) {
      f32x16 s0 = {}, s1 = {};
#pragma unroll
      for (int ks = 0; ks < 6; ++ks) {
        const bf16x8 k0 = *(const bf16x8*)(cur + r32 * 208 + ks * 32 + hi * 16);
        const bf16x8 k1 = *(const bf16x8*)(cur + (32 + r32) * 208 + ks * 32 + hi * 16);
        s0 = __builtin_amdgcn_mfma_f32_32x32x16_bf16(k0, qr[ks], s0, 0, 0, 0);
        s1 = __builtin_amdgcn_mfma_f32_32x32x16_bf16(k1, qr[ks], s1, 0, 0, 0);
      }
      if (kv0 + 63 > wq0) {
#pragma unroll
        for (int r = 0; r < 16; ++r) { const int kv = kv0 + (r & 3) + 8 * (r >> 2) + 4 * hi; if (kv > qrow) s0[r] = -INFINITY; if (kv + 32 > qrow) s1[r] = -INFINITY; }
      }
      float mx = fmaxf(s0[0], s1[0]);
#pragma unroll
      for (int r = 1; r < 16; ++r) mx = fmaxf(mx, fmaxf(s0[r], s1[r]));
      { auto rr = __builtin_amdgcn_permlane32_swap(__float_as_uint(mx), __float_as_uint(mx), false, false); mx = fmaxf(__uint_as_float(rr[0]), __uint_as_float(rr[1])); }
      const float mn = fmaxf(m, mx);
      if (__any(mn > m)) {
        const float f = __builtin_amdgcn_exp2f(m - mn);
        m = mn; l *= f;
#pragma unroll
        for (int r = 0; r < 16; ++r) { o0[r] *= f; o1[r] *= f; }
      }
      float ps = 0.f;
#pragma unroll
      for (int r = 0; r < 16; ++r) { s0[r] = __builtin_amdgcn_exp2f(s0[r] - mn); s1[r] = __builtin_amdgcn_exp2f(s1[r] - mn); ps += s0[r] + s1[r]; }
      l += ps;
      bf16x8 pf[4];
      { u32x4 w;
        w = (u32x4){pk2(s0[0], s0[1]), pk2(s0[2], s0[3]), pk2(s0[4], s0[5]), pk2(s0[6], s0[7])}; pf[0] = __builtin_bit_cast(bf16x8, w);
        w = (u32x4){pk2(s0[8], s0[9]), pk2(s0[10], s0[11]), pk2(s0[12], s0[13]), pk2(s0[14], s0[15])}; pf[1] = __builtin_bit_cast(bf16x8, w);
        w = (u32x4){pk2(s1[0], s1[1]), pk2(s1[2], s1[3]), pk2(s1[4], s1[5]), pk2(s1[6], s1[7])}; pf[2] = __builtin_bit_cast(bf16x8, w);
        w = (u32x4){pk2(s1[8], s1[9]), pk2(s1[10], s1[11]), pk2(s1[12], s1[13]), pk2(s1[14], s1[15])}; pf[3] = __builtin_bit_cast(bf16x8, w); }
#pragma unroll
      for (int ks = 0; ks < 4; ++ks) {
        const bf16x8 v0 = *(const bf16x8*)(cur + KSZ + r32 * 144 + ks * 32 + hi * 16);
        const bf16x8 v1 = *(const bf16x8*)(cur + KSZ + (32 + r32) * 144 + ks * 32 + hi * 16);
        o0 = __builtin_amdgcn_mfma_f32_32x32x16_bf16(v0, pf[ks], o0, 0, 0, 0);
        o1 = __builtin_amdgcn_mfma_f32_32x32x16_bf16(v1, pf[ks], o1, 0, 0, 0);
      }
    }
    if (more) sstore(nxt);
    __syncthreads();
  }
  { auto rr = __builtin_amdgcn_permlane32_swap(__float_as_uint(l), __float_as_uint(l), false, false); l = __uint_as_float(rr[0]) + __uint_as_float(rr[1]); }
  const float il = 1.f / l;
  bf16_t* orow = MIX + tokq * 1024 + 512 + h * 64;
#pragma unroll
  for (int g = 0; g < 4; ++g) {
    const int d = 8 * g + 4 * hi;
    u32x2 w0 = {pk2(o0[4 * g] * il, o0[4 * g + 1] * il), pk2(o0[4 * g + 2] * il, o0[4 * g + 3] * il)};
    u32x2 w1 = {pk2(o1[4 * g] * il, o1[4 * g + 1] * il), pk2(o1[4 * g + 2] * il, o1[4 * g + 3] * il)};
    *(u32x2*)(orow + d) = w0; *(u32x2*)(orow + 32 + d) = w1;
  }
}

__device__ __forceinline__ void phase_gdnchunk(char* smem, const Params& p) {
  const int tid = threadIdx.x, wid = tid >> 6, lane = tid & 63, r32 = lane & 31, hi = lane >> 5;
  if (wid >= 2) return;
  char* wl = smem + wid * 65536;
  float* At = (float*)wl;
  float* XU = (float*)(wl + 16384);
  float* XW = (float*)(wl + 32768);
  bf16_t* T1 = (bf16_t*)(wl + 49152);
  bf16_t* T2 = (bf16_t*)(wl + 57344);
  float* tab = (float*)(smem + CTLW + 256 + wid * 512);
  const bf16_t* GQ = (const bf16_t*)(p.ws + A_GQ); const bf16_t* GK = (const bf16_t*)(p.ws + A_GK); const bf16_t* GV = (const bf16_t*)(p.ws + A_GV);
  const float* GG = (const float*)(p.ws + A_GG); const float* GB = (const float*)(p.ws + A_GB);
  bf16_t* CW = (bf16_t*)(p.ws + A_CW); bf16_t* CU = (bf16_t*)(p.ws + A_CU); bf16_t* CQK = (bf16_t*)(p.ws + A_CQK);
  bf16_t* CKD = (bf16_t*)(p.ws + A_CKD); bf16_t* CQD = (bf16_t*)(p.ws + A_CQD); float* GL = (float*)(p.ws + A_GL);
  const int crw = lane >> 3, cch = lane & 7;
  const int c = lane;
#define LWAIT() asm volatile("s_waitcnt lgkmcnt(0)" ::: "memory")
#pragma unroll 1
  for (int unit = blockIdx.x * 2 + wid; unit < 4096; unit += gridDim.x * 2) {
    const int bh = unit >> 8, n = unit & 255, b = bh >> 3, h = bh & 7;
    const size_t tok0 = (size_t)b * SEQ + (size_t)n * 64;
    const size_t hoff = ((size_t)bh * SEQ + (size_t)n * 64) * 64;
    const bf16_t* kbase = GK + hoff; const bf16_t* qbase = GQ + hoff; const bf16_t* vbase = GV + hoff;
    float gc = GG[(tok0 + lane) * 8 + h]; const float be = GB[(tok0 + lane) * 8 + h];
#pragma unroll
    for (int o = 1; o < 64; o <<= 1) { const float t = __shfl_up(gc, o); if (lane >= o) gc += t; }
    tab[lane] = gc; tab[64 + lane] = be;
    const float gl = __shfl(gc, 63);
    LWAIT();
#pragma unroll 1
    for (int pass = 0; pass < 2; ++pass) {
      const bf16_t* abase = pass == 0 ? kbase : qbase;
      f32x16 acc[2][2];
#pragma unroll
      for (int i = 0; i < 2; ++i)
#pragma unroll
        for (int jj = 0; jj < 2; ++jj) acc[i][jj] = (f32x16){};
#pragma unroll
      for (int ks = 0; ks < 4; ++ks) {
        bf16x8 ka[2], aa[2];
#pragma unroll
        for (int ib = 0; ib < 2; ++ib) {
          ka[ib] = *(const bf16x8*)(kbase + (size_t)(ib * 32 + r32) * 64 + ks * 16 + hi * 8);
          aa[ib] = *(const bf16x8*)(abase + (size_t)(ib * 32 + r32) * 64 + ks * 16 + hi * 8);
        }
#pragma unroll
        for (int ib = 0; ib < 2; ++ib)
#pragma unroll
          for (int jb = 0; jb < 2; ++jb) acc[ib][jb] = __builtin_amdgcn_mfma_f32_32x32x16_bf16(aa[ib], ka[jb], acc[ib][jb], 0, 0, 0);
      }
#pragma unroll
      for (int ib = 0; ib < 2; ++ib)
#pragma unroll
        for (int jb = 0; jb < 2; ++jb) {
          const int j = jb * 32 + r32; const float gcj = tab[j];
#pragma unroll
          for (int r = 0; r < 16; ++r) {
            const int i = ib * 32 + (r & 3) + 8 * (r >> 2) + 4 * hi;
            const float dec = __expf(fminf(tab[i] - gcj, 0.f));
            if (pass == 0) At[j * 64 + i] = (i > j) ? tab[64 + i] * acc[ib][jb][r] * dec : 0.f;
            else T2[i * 64 + j] = f2bf((i >= j) ? acc[ib][jb][r] * 0.125f * dec : 0.f);
          }
        }
      LWAIT();
    }
#pragma unroll
    for (int it = 0; it < 8; ++it) {
      const int row = it * 8 + crw;
      *(u32x4*)(CQK + (size_t)unit * 4096 + row * 64 + cch * 8) = *(const u32x4*)(T2 + row * 64 + cch * 8);
      *(u32x4*)(T1 + row * 64 + cch * 8) = *(const u32x4*)(kbase + (size_t)row * 64 + cch * 8);
    }
    LWAIT();
#pragma unroll
    for (int it = 0; it < 8; ++it) { const int row = it * 8 + crw; *(u32x4*)(T2 + row * 64 + cch * 8) = *(const u32x4*)(vbase + (size_t)row * 64 + cch * 8); }
    LWAIT();
#pragma unroll 1
    for (int i0 = 0; i0 < 64; i0 += 8) {
      float kd[8];
#pragma unroll
      for (int q = 0; q < 8; ++q) {
        const int i = i0 + q; const float kv = bf2f(T1[i * 64 + c]), gci = tab[i], bi = tab[64 + i];
        kd[q] = kv * __expf(fminf(gl - gci, 0.f));
        XU[i * 64 + c] = bi * bf2f(T2[i * 64 + c]);
        XW[i * 64 + c] = bi * __expf(gci) * kv;
      }
      u32x4 w = {pk2(kd[0], kd[1]), pk2(kd[2], kd[3]), pk2(kd[4], kd[5]), pk2(kd[6], kd[7])};
      *(u32x4*)(CKD + (size_t)unit * 4096 + c * 64 + i0) = w;
    }
    LWAIT();
#pragma unroll 1
    for (int I = 0; I < 4; ++I) {
      const int i0 = 16 * I;
      float xu[16], xw[16];
#pragma unroll
      for (int ii = 0; ii < 16; ++ii) { xu[ii] = XU[(i0 + ii) * 64 + c]; xw[ii] = XW[(i0 + ii) * 64 + c]; }
#pragma unroll 2
      for (int j = 0; j < i0; ++j) {
        const float uj = XU[j * 64 + c], wj = XW[j * 64 + c];
        const f32x4 a0 = *(const f32x4*)(At + j * 64 + i0), a1 = *(const f32x4*)(At + j * 64 + i0 + 4),
                    a2 = *(const f32x4*)(At + j * 64 + i0 + 8), a3 = *(const f32x4*)(At + j * 64 + i0 + 12);
#pragma unroll
        for (int q = 0; q < 4; ++q) {
          xu[q] -= a0[q] * uj; xw[q] -= a0[q] * wj; xu[4 + q] -= a1[q] * uj; xw[4 + q] -= a1[q] * wj;
          xu[8 + q] -= a2[q] * uj; xw[8 + q] -= a2[q] * wj; xu[12 + q] -= a3[q] * uj; xw[12 + q] -= a3[q] * wj;
        }
      }
#pragma unroll
      for (int jj = 0; jj < 15; ++jj) {
        const float* ar = At + (i0 + jj) * 64 + i0;
#pragma unroll
        for (int ii = jj + 1; ii < 16; ++ii) { const float av = ar[ii]; xu[ii] -= av * xu[jj]; xw[ii] -= av * xw[jj]; }
      }
#pragma unroll
      for (int ii = 0; ii < 16; ++ii) { XU[(i0 + ii) * 64 + c] = xu[ii]; XW[(i0 + ii) * 64 + c] = xw[ii]; }
      LWAIT();
    }
#pragma unroll 8
    for (int i = 0; i < 64; ++i) { T2[i * 64 + c] = f2bf(XU[i * 64 + c]); T1[i * 64 + c] = f2bf(XW[i * 64 + c]); }
    LWAIT();
#pragma unroll
    for (int it = 0; it < 8; ++it) {
      const int row = it * 8 + crw;
      *(u32x4*)(CU + (size_t)unit * 4096 + row * 64 + cch * 8) = *(const u32x4*)(T2 + row * 64 + cch * 8);
      *(u32x4*)(CW + (size_t)unit * 4096 + row * 64 + cch * 8) = *(const u32x4*)(T1 + row * 64 + cch * 8);
      const u32x4 qv = *(const u32x4*)(qbase + (size_t)row * 64 + cch * 8);
      const float sc = 0.125f * __expf(tab[row]);
      u32x4 qo = {pk2(bflo(qv.x) * sc, bfhi(qv.x) * sc), pk2(bflo(qv.y) * sc, bfhi(qv.y) * sc), pk2(bflo(qv.z) * sc, bfhi(qv.z) * sc), pk2(bflo(qv.w) * sc, bfhi(qv.w) * sc)};
      *(u32x4*)(CQD + (size_t)unit * 4096 + row * 64 + cch * 8) = qo;
    }
    if (lane == 0) GL[unit] = __expf(gl);
    LWAIT();
  }
#undef LWAIT
}

__device__ __forceinline__ void gdn_chunk_scan(char* smem, const Params& p, int bh) {
  constexpr int TB = 9216, IMG = 5 * TB;
  const int tid = threadIdx.x, wid = tid >> 6, lane = tid & 63, r32 = lane & 31, hi = lane >> 5;
  const int sg = (r32 & ~12) | ((r32 & 4) << 1) | ((r32 & 8) >> 1);
  const int b = bh >> 3, h = bh & 7;
  const bf16_t* SRC[5] = {(const bf16_t*)(p.ws + A_CW), (const bf16_t*)(p.ws + A_CQD), (const bf16_t*)(p.ws + A_CQK), (const bf16_t*)(p.ws + A_CKD), (const bf16_t*)(p.ws + A_CU)};
  const float* GL = (const float*)(p.ws + A_GL);
  bf16_t* GO = (bf16_t*)(p.ws + A_GO);
  const bool loader = wid >= 2;
  const int ltid = tid - 128;
  u32x4 lr[7];
#pragma unroll
  for (int i = 0; i < 7; ++i) lr[i] = (u32x4){0u, 0u, 0u, 0u};
  auto lload = [&](int n) {
    const size_t ub = ((size_t)bh * 256 + n) * 4096;
#pragma unroll
    for (int i = 0; i < 7; ++i) { const int id = ltid + 384 * i;
      if (id < 2560) { const int tile = id >> 9, w = id & 511; const bf16_t* src = tile == 0 ? SRC[0] : tile == 1 ? SRC[1] : tile == 2 ? SRC[2] : tile == 3 ? SRC[3] : SRC[4];
        lr[i] = *(const u32x4*)(src + ub + (w >> 3) * 64 + (w & 7) * 8); } }
  };
  auto lstore = [&](char* img) {
#pragma unroll
    for (int i = 0; i < 7; ++i) { const int id = ltid + 384 * i;
      if (id < 2560) { const int tile = id >> 9, w = id & 511; *(u32x4*)(img + tile * TB + (w >> 3) * 144 + (w & 7) * 16) = lr[i]; } }
  };
  f32x16 S[2]; S[0] = (f32x16){}; S[1] = (f32x16){};
  const int dv = wid * 32 + r32;
  if (loader) { lload(0); lstore(smem); lload(1); }
  __syncthreads();
  float egl = loader ? 0.f : GL[bh * 256];
  for (int n = 0; n < 256; ++n) {
    const char* cur = smem + (n & 1) * IMG; char* nxt = smem + ((n + 1) & 1) * IMG;
    if (loader) {
      if (n + 1 < 256) lstore(nxt);
      if (n + 2 < 256) lload(n + 2);
    } else {
      const float egl_n = egl;
      if (n + 1 < 256) egl = GL[bh * 256 + n + 1];
      const size_t tok0 = (size_t)b * SEQ + (size_t)n * 64;
      bf16x8 sb[4];
#pragma unroll
      for (int ks = 0; ks < 4; ++ks) { const f32x16& q = S[ks >> 1]; const int o = 8 * (ks & 1);
        u32x4 w = {pk2(q[o], q[o + 1]), pk2(q[o + 2], q[o + 3]), pk2(q[o + 4], q[o + 5]), pk2(q[o + 6], q[o + 7])}; sb[ks] = __builtin_bit_cast(bf16x8, w); }
      f32x16 vn[2]; vn[0] = (f32x16){}; vn[1] = (f32x16){};
      f32x16 o[2]; o[0] = (f32x16){}; o[1] = (f32x16){};
#pragma unroll
      for (int tb = 0; tb < 2; ++tb)
#pragma unroll
        for (int ks = 0; ks < 4; ++ks) {
          const bf16x8 wf = *(const bf16x8*)(cur + 0 * TB + (tb * 32 + sg) * 144 + ks * 32 + hi * 16);
          const bf16x8 qf = *(const bf16x8*)(cur + 1 * TB + (tb * 32 + r32) * 144 + ks * 32 + hi * 16);
          vn[tb] = __builtin_amdgcn_mfma_f32_32x32x16_bf16(wf, sb[ks], vn[tb], 0, 0, 0);
          o[tb] = __builtin_amdgcn_mfma_f32_32x32x16_bf16(qf, sb[ks], o[tb], 0, 0, 0);
        }
#pragma unroll
      for (int tb = 0; tb < 2; ++tb)
#pragma unroll
        for (int r = 0; r < 16; ++r) { const int t = tb * 32 + 16 * (r >> 3) + 8 * hi + (r & 7);
          vn[tb][r] = bf2f(*(const bf16_t*)(cur + 4 * TB + t * 144 + dv * 2)) - vn[tb][r]; }
      bf16x8 vb[4];
#pragma unroll
      for (int ks = 0; ks < 4; ++ks) { const f32x16& q = vn[ks >> 1]; const int o8 = 8 * (ks & 1);
        u32x4 w = {pk2(q[o8], q[o8 + 1]), pk2(q[o8 + 2], q[o8 + 3]), pk2(q[o8 + 4], q[o8 + 5]), pk2(q[o8 + 6], q[o8 + 7])}; vb[ks] = __builtin_bit_cast(bf16x8, w); }
#pragma unroll
      for (int r = 0; r < 16; ++r) { S[0][r] *= egl_n; S[1][r] *= egl_n; }
#pragma unroll
      for (int tb = 0; tb < 2; ++tb)
#pragma unroll
        for (int ks = 0; ks < 4; ++ks) {
          const bf16x8 af = *(const bf16x8*)(cur + 2 * TB + (tb * 32 + r32) * 144 + ks * 32 + hi * 16);
          const bf16x8 kf = *(const bf16x8*)(cur + 3 * TB + (tb * 32 + sg) * 144 + ks * 32 + hi * 16);
          o[tb] = __builtin_amdgcn_mfma_f32_32x32x16_bf16(af, vb[ks], o[tb], 0, 0, 0);
          S[tb] = __builtin_amdgcn_mfma_f32_32x32x16_bf16(kf, vb[ks], S[tb], 0, 0, 0);
        }
#pragma unroll
      for (int tb = 0; tb < 2; ++tb)
#pragma unroll
        for (int r = 0; r < 16; ++r) { const int t = tb * 32 + (r & 3) + 8 * (r >> 2) + 4 * hi; GO[(tok0 + t) * 512 + h * 64 + dv] = f2bf(o[tb][r]); }
    }
    LDS_BARRIER();
  }
  __syncthreads();
}

__device__ __forceinline__ void phase_mix0(char* smem, const Params& p, int rep) {
  if (rep == 0 && blockIdx.x < 16) gdn_chunk_scan(smem, p, blockIdx.x);
  __syncthreads();
  unsigned* ctr = (unsigned*)(p.ws + WS_CTL) + rep;
  volatile int* sh = (volatile int*)(smem + CTLW);
  for (;;) {
    if (threadIdx.x == 0) sh[0] = (int)atomicAdd(ctr, 1u);
    __syncthreads();
    const int u = sh[0];
    __syncthreads();
    if (u >= 1024) break;
    attn_unit(smem, p, (u & 15) >> 3, u & 7, 63 - (u >> 4));
  }
}

__device__ __forceinline__ void phase_gdnpost(const Params& p) {
  const int tid = threadIdx.x, wid = tid >> 6, lane = tid & 63;
  const bf16_t* GO = (const bf16_t*)(p.ws + A_GO); const bf16_t* PROJ = (const bf16_t*)(p.ws + A_PROJ);
  bf16_t* MIX = (bf16_t*)(p.ws + WS_H);
  const int sub = lane & 7;
  float gn[8];
#pragma unroll
  for (int e = 0; e < 8; ++e) gn[e] = p.in[9][sub * 8 + e];
  const int gw = blockIdx.x * NW + wid, nw = gridDim.x * NW;
#pragma unroll 2
  for (int row = gw; row < MTOK; row += nw) {
    const u32x4 t = *(const u32x4*)(GO + (size_t)row * 512 + lane * 8);
    const u32x4 z = *(const u32x4*)((const bf16_t*)(p.ws + A_Z) + (size_t)row * 512 + lane * 8);
    float v[8] = {bflo(t.x), bfhi(t.x), bflo(t.y), bfhi(t.y), bflo(t.z), bfhi(t.z), bflo(t.w), bfhi(t.w)};
    float zz[8] = {bflo(z.x), bfhi(z.x), bflo(z.y), bfhi(z.y), bflo(z.z), bfhi(z.z), bflo(z.w), bfhi(z.w)};
    float ss = 0.f;
#pragma unroll
    for (int e = 0; e < 8; ++e) ss += v[e] * v[e];
    ss = group_sum<8>(ss);
    const float r = rsqrtf(ss * (1.f / 64.f) + 1e-6f);
#pragma unroll
    for (int e = 0; e < 8; ++e) v[e] = v[e] * r * gn[e] * siluf_(zz[e]);
    u32x4 w = {pk2(v[0], v[1]), pk2(v[2], v[3]), pk2(v[4], v[5]), pk2(v[6], v[7])};
    *(u32x4*)(MIX + (size_t)row * 1024 + lane * 8) = w;
  }
}

__device__ __forceinline__ void phase_prep1(const Params& p) {
  const int tid = threadIdx.x, wid = tid >> 6, lane = tid & 63;
  bf16_t* WL = (bf16_t*)(p.ws + A_WL); bf16_t* AL = (bf16_t*)(p.ws + A_AL);
  const bf16_t* RKV = (const bf16_t*)(p.ws + A_RKV);
  float* INV = (float*)(p.ws + A_INV); float* SB = (float*)(p.ws + A_SB);
  const int col = lane * 16, h = lane >> 2;
  const int gw = blockIdx.x * NW + wid, nw = gridDim.x * NW;
  float cw0[16], ca0[16], ckk[16], cka[16], crk[16];
#pragma unroll
  for (int e = 0; e < 16; ++e) { cw0[e] = p.in[22][col + e]; ca0[e] = p.in[25][col + e]; ckk[e] = p.in[30][col + e]; cka[e] = p.in[31][col + e]; crk[e] = p.in[32][col + e]; }
#pragma unroll 2
  for (int row = gw; row < MTOK; row += nw) {
    float ssk = 0.f, sb = 0.f;
#pragma unroll
    for (int half = 0; half < 2; ++half) {
      const int c0 = col + half * 8;
      const u32x4 tw = *(const u32x4*)(WL + (size_t)row * 1024 + c0), ta = *(const u32x4*)(AL + (size_t)row * 1024 + c0);
      const u32x4 tr = *(const u32x4*)(RKV + (size_t)row * 3072 + c0), tk = *(const u32x4*)(RKV + (size_t)row * 3072 + 1024 + c0);
      float wl[8] = {bflo(tw.x), bfhi(tw.x), bflo(tw.y), bfhi(tw.y), bflo(tw.z), bfhi(tw.z), bflo(tw.w), bfhi(tw.w)};
      float al[8] = {bflo(ta.x), bfhi(ta.x), bflo(ta.y), bfhi(ta.y), bflo(ta.z), bfhi(ta.z), bflo(ta.w), bfhi(ta.w)};
      float rr[8] = {bflo(tr.x), bfhi(tr.x), bflo(tr.y), bfhi(tr.y), bflo(tr.z), bfhi(tr.z), bflo(tr.w), bfhi(tr.w)};
      float kk[8] = {bflo(tk.x), bfhi(tk.x), bflo(tk.y), bfhi(tk.y), bflo(tk.z), bfhi(tk.z), bflo(tk.w), bfhi(tk.w)};
      float eo[8], ao[8];
#pragma unroll
      for (int e = 0; e < 8; ++e) {
        const int c = c0 + e;
        const float wlog = -softplusf_(-(cw0[half * 8 + e] + wl[e])) - 0.5f;
        eo[e] = expf(wlog);
        const float a = sigmoidf_(ca0[half * 8 + e] + al[e]);
        const unsigned ab = pk2(a, 0.f); const float ar = bflo(ab);
        ao[e] = a;
        const float kkv = kk[e] * ckk[half * 8 + e]; ssk += kkv * kkv;
        const float kp = kk[e] * (1.f + (ar - 1.f) * cka[half * 8 + e]);
        sb += rr[e] * kp * crk[half * 8 + e];
      }
      u32x4 we = {pk2(eo[0], eo[1]), pk2(eo[2], eo[3]), pk2(eo[4], eo[5]), pk2(eo[6], eo[7])};
      u32x4 wa = {pk2(ao[0], ao[1]), pk2(ao[2], ao[3]), pk2(ao[4], ao[5]), pk2(ao[6], ao[7])};
      *(u32x4*)(WL + (size_t)row * 1024 + c0) = we; *(u32x4*)(AL + (size_t)row * 1024 + c0) = wa;
    }
    ssk = group_sum<4>(ssk); sb = group_sum<4>(sb);
    if ((lane & 3) == 0) { INV[(size_t)row * 16 + h] = rsqrtf(ssk + 1e-12f); SB[(size_t)row * 16 + h] = sb; }
  }
}

__device__ __forceinline__ void phase_post1(const Params& p) {
  const int tid = threadIdx.x, wid = tid >> 6, lane = tid & 63;
  const bf16_t* Y = (const bf16_t*)(p.ws + WS_H); const bf16_t* G = (const bf16_t*)(p.ws + A_WL);
  const bf16_t* RKV = (const bf16_t*)(p.ws + A_RKV); const float* SB = (const float*)(p.ws + A_SB);
  bf16_t* YG = (bf16_t*)(p.ws + A_AL);
  const int col = lane * 16, h = lane >> 2;
  const int gw = blockIdx.x * NW + wid, nw = gridDim.x * NW;
  float lng[16], lnb[16];
#pragma unroll
  for (int e = 0; e < 16; ++e) { lng[e] = p.in[33][col + e]; lnb[e] = p.in[34][col + e]; }
#pragma unroll 2
  for (int row = gw; row < MTOK; row += nw) {
    float y[16]; float sm = 0.f;
#pragma unroll
    for (int half = 0; half < 2; ++half) {
      const u32x4 t = *(const u32x4*)(Y + (size_t)row * 1024 + col + half * 8);
      float* d = y + half * 8;
      d[0] = bflo(t.x); d[1] = bfhi(t.x); d[2] = bflo(t.y); d[3] = bfhi(t.y); d[4] = bflo(t.z); d[5] = bfhi(t.z); d[6] = bflo(t.w); d[7] = bfhi(t.w);
    }
#pragma unroll
    for (int e = 0; e < 16; ++e) sm += y[e];
    sm = group_sum<4>(sm);
    const float mean = sm * (1.f / 64.f);
    float vs = 0.f;
#pragma unroll
    for (int e = 0; e < 16; ++e) { const float dlt = y[e] - mean; vs += dlt * dlt; }
    vs = group_sum<4>(vs);
    const float rstd = rsqrtf(vs * (1.f / 64.f) + 64e-5f);
    const float sb = SB[(size_t)row * 16 + h];
#pragma unroll
    for (int half = 0; half < 2; ++half) {
      const int c0 = col + half * 8;
      const u32x4 tv = *(const u32x4*)(RKV + (size_t)row * 3072 + 2048 + c0), tg = *(const u32x4*)(G + (size_t)row * 1024 + c0);
      float vv[8] = {bflo(tv.x), bfhi(tv.x), bflo(tv.y), bfhi(tv.y), bflo(tv.z), bfhi(tv.z), bflo(tv.w), bfhi(tv.w)};
      float gg[8] = {bflo(tg.x), bfhi(tg.x), bflo(tg.y), bfhi(tg.y), bflo(tg.z), bfhi(tg.z), bflo(tg.w), bfhi(tg.w)};
      float o[8];
#pragma unroll
      for (int e = 0; e < 8; ++e) { const int c = c0 + e; o[e] = ((y[half * 8 + e] - mean) * rstd * lng[half * 8 + e] + lnb[half * 8 + e] + sb * vv[e]) * gg[e]; }
      u32x4 w = {pk2(o[0], o[1]), pk2(o[2], o[3]), pk2(o[4], o[5]), pk2(o[6], o[7])};
      *(u32x4*)(YG + (size_t)row * 1024 + c0) = w;
    }
  }
}

constexpr int NPHASE = 22;
__device__ __forceinline__ void run_phase(int ph, char* smem, const Params& p, int rep = 0) {
  bf16_t* WT = (bf16_t*)(p.ws + WS_WT);
  bf16_t* H = (bf16_t*)(p.ws + WS_H);
  const float* MOD = (const float*)(p.ws + WS_MOD);
  switch (ONLY >= 0 ? ONLY : ph) {
    case 0: phase_prologue(smem, p); break;
    case 1: phase_adaln<0>(p, p.in[0], 0, 0, H); break;
    case 2: gemm_phase(smem, H, 1024, WT + W_IN, 1024, MTOK, 2560, 1024, EpiStore{(bf16_t*)(p.ws + A_PROJ), PROJ_LD}); break;
    case 3: phase_prep0(p); break;
    case 4: gemm_phase(smem, (const bf16_t*)(p.ws + A_QLAT), 256, WT + W_UQ, 256, MTOK, 768, 256, EpiStore{(bf16_t*)((char*)p.out + O_QH), 768}); break;
    case 5: gemm_phase(smem, (const bf16_t*)(p.ws + A_KVLAT), 128, WT + W_UKV, 128, MTOK, 1024, 128, EpiKV{(bf16_t*)(p.ws + A_KN), (bf16_t*)((char*)p.out + O_VT)}); break;
    case 6: phase_qkrope(p); phase_gdnchunk(smem, p); break;
    case 7: phase_mix0(smem, p, rep); break;
    case 8: phase_gdnpost(p); break;
    case 9: gemm_phase(smem, H, 1024, WT + W_OUT, 1024, MTOK, 1024, 1024, EpiResid{p.in[0], p.out, MOD + 2048}); break;
    case 10: phase_adaln<0>(p, p.out, 0, 1, H); break;
    case 11: gemm_phase(smem, H, 1024, WT + W_UP0, 1024, MTOK, 4096, 1024, EpiUp{(bf16_t*)(p.ws + A_U)}); break;
    case 12: gemm_phase(smem, (const bf16_t*)(p.ws + A_U), 4096, WT + W_DN0, 4096, MTOK, 1024, 4096, EpiResid{p.out, p.out, MOD + 5120}); break;
    case 13: phase_adaln<1>(p, p.out, 1, 0, (bf16_t*)(p.ws + A_A2)); break;
    case 14: gemm_phase(smem, (const bf16_t*)(p.ws + A_A2), 2048, WT + W_RKV, 2048, MTOK, 3584, 2048, EpiRkv{(bf16_t*)(p.ws + A_RKV), (bf16_t*)(p.ws + A_LORA)}); break;
    case 15: gemm_phase(smem, (const bf16_t*)(p.ws + A_LORA), 384, WT + W_W2, 128, MTOK, 1024, 128, EpiStore{(bf16_t*)(p.ws + A_WL), 1024}); break;
    case 16: gemm_phase(smem, (const bf16_t*)(p.ws + A_LORA) + 64, 384, WT + W_A2, 128, MTOK, 1024, 128, EpiStore{(bf16_t*)(p.ws + A_AL), 1024}); break;
    case 17: phase_prep1(p); break;
    case 18: if (blockIdx.x < 256) { const int i = blockIdx.x, x = i & 7, sl = i >> 3; scan_unit<1>(smem, p, ((x * 4 + (sl >> 3)) << 3) | (sl & 7)); } break;
    case 19: gemm_phase(smem, (const bf16_t*)(p.ws + A_LORA) + 128, 384, WT + W_G2, 256, MTOK, 1024, 256, EpiStore{(bf16_t*)(p.ws + A_WL), 1024}); break;
    case 20: phase_post1(p); break;
    case 21: gemm_phase(smem, (const bf16_t*)(p.ws + A_AL), 1024, WT + W_O, 1024, MTOK, 1024, 1024, EpiResid{p.out, p.out, MOD + 2 * 6144 + 2048}); break;
    case 22: phase_adaln<0>(p, p.out, 1, 1, H); break;
    case 23: gemm_phase(smem, H, 1024, WT + W_UP1, 1024, MTOK, 4096, 1024, EpiUp{(bf16_t*)(p.ws + A_U)}); break;
    case 24: gemm_phase(smem, (const bf16_t*)(p.ws + A_U), 4096, WT + W_DN1, 4096, MTOK, 1024, 4096, EpiResid{p.out, p.out, MOD + 2 * 6144 + 5120}); break;
  }
}

__device__ __forceinline__ constexpr bool sync_after(int ph) { return !(ph == 4 || ph == 15); }
__device__ __forceinline__ void grid_barrier(const Params& p, unsigned& nbar) {
  __syncthreads();
  if (threadIdx.x == 0) {
    unsigned* ctr = (unsigned*)(p.ws + WS_CTL) + 32;
    nbar += gridDim.x;
    __builtin_amdgcn_fence(__ATOMIC_RELEASE, "agent");
    __hip_atomic_fetch_add(ctr, 1u, __ATOMIC_RELAXED, __HIP_MEMORY_SCOPE_AGENT);
    while (__hip_atomic_load(ctr, __ATOMIC_RELAXED, __HIP_MEMORY_SCOPE_AGENT) < nbar) __builtin_amdgcn_s_sleep(2);
    __builtin_amdgcn_fence(__ATOMIC_ACQUIRE, "agent");
  }
  __syncthreads();
}
template <int PH> __device__ __forceinline__ void do_phase(char* smem, const Params& p, int lo, int hi, unsigned& nbar) {
  if (lo <= PH && PH < hi) {
    if ((PROBE_MASK >> PH) & 1u) { run_phase(PH, smem, p, 1); grid_barrier(p, nbar); }
    run_phase(PH, smem, p);
    if (PH + 1 < hi && sync_after(PH)) { if (PH == 0) { __syncthreads(); cg::this_grid().sync(); } else grid_barrier(p, nbar); } else __syncthreads();
  }
}
__global__ void __launch_bounds__(NT, 2) fwd_kernel(Params p, int lo, int hi) {
  extern __shared__ __attribute__((aligned(16))) char smem[];
  unsigned nbar = 0u;
  do_phase<0>(smem, p, lo, hi, nbar); do_phase<1>(smem, p, lo, hi, nbar); do_phase<2>(smem, p, lo, hi, nbar); do_phase<3>(smem, p, lo, hi, nbar); do_phase<4>(smem, p, lo, hi, nbar); do_phase<5>(smem, p, lo, hi, nbar); do_phase<6>(smem, p, lo, hi, nbar); do_phase<7>(smem, p, lo, hi, nbar); do_phase<8>(smem, p, lo, hi, nbar); do_phase<9>(smem, p, lo, hi, nbar); do_phase<10>(smem, p, lo, hi, nbar); do_phase<11>(smem, p, lo, hi, nbar); do_phase<12>(smem, p, lo, hi, nbar); do_phase<13>(smem, p, lo, hi, nbar); do_phase<14>(smem, p, lo, hi, nbar); do_phase<15>(smem, p, lo, hi, nbar); do_phase<16>(smem, p, lo, hi, nbar); do_phase<17>(smem, p, lo, hi, nbar); do_phase<18>(smem, p, lo, hi, nbar); do_phase<19>(smem, p, lo, hi, nbar); do_phase<20>(smem, p, lo, hi, nbar); do_phase<21>(smem, p, lo, hi, nbar); do_phase<22>(smem, p, lo, hi, nbar); do_phase<23>(smem, p, lo, hi, nbar); do_phase<24>(smem, p, lo, hi, nbar);
}

extern "C" void kernel_launch(void* const* d_in, const int* in_sizes, int n_in, void* d_out, int out_size, void* d_ws, size_t ws_size, hipStream_t stream) {
  constexpr size_t kDynLds = CTLW + 256 + 4096;
  static int grid_blocks = 0;
  if (!grid_blocks) {
    int dev = 0, cus = 0, per_cu = 0;
    hipGetDevice(&dev);
    hipDeviceGetAttribute(&cus, hipDeviceAttributeMultiprocessorCount, dev);
    hipFuncSetAttribute((const void*)fwd_kernel, hipFuncAttributeMaxDynamicSharedMemorySize, (int)kDynLds);
    hipOccupancyMaxActiveBlocksPerMultiprocessor(&per_cu, fwd_kernel, NT, kDynLds);
    if (per_cu > 1) per_cu = 1;
    if (per_cu < 1) per_cu = 1;
    grid_blocks = cus * per_cu;
  }
  if (ws_size < WS_NEED) { fprintf(stderr, "workspace too small: %zu\n", ws_size); return; }
  Params p{};
  for (int i = 0; i < 37; ++i) p.in[i] = (const float*)d_in[i];
  p.out = (float*)d_out; p.ws = (char*)d_ws;
  constexpr int NPH = 25;
  (void)hipMemsetAsync((char*)d_ws + WS_CTL, 0, 256, stream);
#if COOP
  int lo = 0, hi = NPH;
  void* args[] = {&p, &lo, &hi};
  hipError_t e = hipLaunchCooperativeKernel((void*)fwd_kernel, dim3(grid_blocks), dim3(NT), args, kDynLds, stream);
  if (e != hipSuccess) fprintf(stderr, "cooperative launch failed: %s (grid %d)\n", hipGetErrorString(e), grid_blocks);
#else
  for (int ph = 0; ph < NPH; ++ph) fwd_kernel<<<grid_blocks, NT, kDynLds, stream>>>(p, ph, ph + 1);
#endif
}
```

```cpp
#include <hip/hip_runtime.h>
#include <hip/hip_cooperative_groups.h>
#include <cstdint>
#include <cstdio>
namespace cg = cooperative_groups;

#ifndef ONLY
#define ONLY -1
#endif
#ifndef PROBE_MASK
#define PROBE_MASK 0u
#endif
#ifndef COOP
#define COOP 1
#endif

typedef unsigned short bf16_t;
typedef short bf16x8 __attribute__((ext_vector_type(8)));
typedef float f32x4 __attribute__((ext_vector_type(4)));
typedef float f32x2 __attribute__((ext_vector_type(2)));
typedef float f32x16 __attribute__((ext_vector_type(16)));
typedef unsigned u32x4 __attribute__((ext_vector_type(4)));
typedef unsigned u32x2 __attribute__((ext_vector_type(2)));
typedef __bf16 bf16x2_t __attribute__((ext_vector_type(2)));

constexpr int NW = 8, NT = NW * 64, CTLW = 131072;
constexpr int SEQ = 16384, NBATCH = 2, MTOK = NBATCH * SEQ, DM = 1024, DFF = 4096;
constexpr int PROJ_LD = 2560;
constexpr size_t MiB = 1u << 20;
constexpr size_t WS_CTL = 0;
constexpr size_t WS_MOD = 64 * 1024;
constexpr size_t WS_WT = 1 * MiB;
constexpr size_t WS_H = 64 * MiB;
constexpr size_t WS_AR = 128 * MiB;
constexpr size_t W_IN = 0;
constexpr size_t W_UQ = W_IN + (size_t)2560 * 1024;
constexpr size_t W_UKV = W_UQ + (size_t)768 * 256;
constexpr size_t W_OUT = W_UKV + (size_t)1024 * 128;
constexpr size_t W_RKV = W_OUT + (size_t)1024 * 1024;
constexpr size_t W_W2 = W_RKV + (size_t)3584 * 2048;
constexpr size_t W_A2 = W_W2 + (size_t)1024 * 128;
constexpr size_t W_G2 = W_A2 + (size_t)1024 * 128;
constexpr size_t W_O = W_G2 + (size_t)1024 * 256;
constexpr size_t W_UP0 = W_O + (size_t)1024 * 1024;
constexpr size_t W_UP1 = W_UP0 + (size_t)4096 * 1024;
constexpr size_t W_DN0 = W_UP1 + (size_t)4096 * 1024;
constexpr size_t W_DN1 = W_DN0 + (size_t)4096 * 1024;
constexpr size_t W_END = W_DN1 + (size_t)4096 * 1024;
static_assert(W_END * 2 <= 63 * MiB, "weights fit");
constexpr size_t A_PROJ = WS_AR;
constexpr size_t A_GQ = WS_AR + 160 * MiB;
constexpr size_t A_GK = A_GQ + 32 * MiB;
constexpr size_t A_GV = A_GK + 32 * MiB;
constexpr size_t A_KN = WS_AR + 256 * MiB;
constexpr size_t A_QLAT = WS_AR + 320 * MiB;
constexpr size_t A_KVLAT = WS_AR + 336 * MiB;
constexpr size_t A_GA = WS_AR + 344 * MiB;
constexpr size_t A_GB = WS_AR + 345 * MiB;
constexpr size_t A_GO = WS_AR + 346 * MiB;
constexpr size_t A_Z = WS_AR + 288 * MiB;
constexpr size_t A_KR = WS_AR + 378 * MiB;
constexpr size_t A_GL = WS_AR + 380 * MiB;
constexpr size_t A_GG = WS_AR + 381 * MiB;
constexpr size_t A_CW = WS_AR + 0 * MiB, A_CU = WS_AR + 32 * MiB, A_CQK = WS_AR + 64 * MiB, A_CKD = WS_AR + 96 * MiB, A_CQD = WS_AR + 128 * MiB;
constexpr size_t O_QH = 0;
constexpr size_t O_KH = 48 * MiB;
constexpr size_t O_VT = 96 * MiB;
constexpr size_t A_U = WS_AR;
constexpr size_t A_A2 = WS_AR;
constexpr size_t A_WL = WS_AR;
constexpr size_t A_AL = WS_AR + 64 * MiB;
constexpr size_t A_RKV = WS_AR + 128 * MiB;
constexpr size_t A_LORA = WS_AR + 320 * MiB;
constexpr size_t A_INV = WS_AR + 344 * MiB;
constexpr size_t A_SB = WS_AR + 346 * MiB;
constexpr size_t WS_NEED = 512 * MiB;

struct Params { const float* in[37]; float* out; char* ws; };

__device__ __forceinline__ float bf2f(bf16_t h) { return __uint_as_float(((unsigned)h) << 16); }
__device__ __forceinline__ float bflo(unsigned u) { return __uint_as_float(u << 16); }
__device__ __forceinline__ float bfhi(unsigned u) { return __uint_as_float(u & 0xffff0000u); }
__device__ __forceinline__ unsigned pk2(float lo, float hi) { f32x2 v = {lo, hi}; bf16x2_t b = __builtin_convertvector(v, bf16x2_t); return __builtin_bit_cast(unsigned, b); }
__device__ __forceinline__ bf16_t f2bf(float f) { return (bf16_t)(pk2(f, 0.f) & 0xffffu); }
__device__ __forceinline__ float wave_sum(float v) {
#pragma unroll
  for (int o = 32; o; o >>= 1) v += __shfl_xor(v, o);
  return v;
}
template <int W> __device__ __forceinline__ float group_sum(float v) {
#pragma unroll
  for (int o = W / 2; o; o >>= 1) v += __shfl_xor(v, o);
  return v;
}
__device__ __forceinline__ float sigmoidf_(float x) { return 1.f / (1.f + __expf(-x)); }
__device__ __forceinline__ float siluf_(float x) { return x / (1.f + __expf(-x)); }
__device__ __forceinline__ float softplusf_(float x) { return x > 20.f ? x : log1pf(expf(x)); }
#define LDS_BARRIER() do { asm volatile("s_waitcnt lgkmcnt(0)" ::: "memory"); __builtin_amdgcn_s_barrier(); asm volatile("" ::: "memory"); } while (0)
template <int CTRL> __device__ __forceinline__ float dpp_add(float x) {
  return x + __int_as_float(__builtin_amdgcn_update_dpp(0, __float_as_int(x), CTRL, 0xf, 0xf, false));
}
__device__ __forceinline__ float row16_sum(float x) {
  x = dpp_add<0x128>(x); x = dpp_add<0x124>(x); x = dpp_add<0x122>(x); x = dpp_add<0x121>(x);
  return x;
}

__device__ __forceinline__ void conv_job(char* smem, const float* __restrict__ src, int K, int N, bf16_t* dst, int ldd, int koff, int Kp, int Np,
                         const float* mu, int mode, int& tbase) {
  const int half = threadIdx.x >> 8, tid = threadIdx.x & 255;
  bf16_t* tile = (bf16_t*)smem + half * (64 * 72);
  const int VG = gridDim.x * 2, vb = blockIdx.x * 2 + half;
  const int tk = Kp / 64, tn = Np / 64, nt = tk * tn;
  const int first = (vb - (tbase % VG) + VG) % VG;
  for (int base = 0; base < nt; base += VG) {
    const int t = base + first;
    const bool act = t < nt;
    const int k0 = (t % tk) * 64, n0 = (t / tk) * 64;
    const int nl = tid & 63, kq = tid >> 6;
    if (act) {
#pragma unroll 4
      for (int i = 0; i < 16; ++i) {
        const int kl = kq + 4 * i, k = k0 + kl, n = n0 + nl;
        float v = 0.f;
        if (k < K && n < N) { v = src[(size_t)k * N + n]; if (mode == 1) v *= mu[k]; else if (mode == 2) v *= (1.f - mu[k]); }
        tile[nl * 72 + kl] = f2bf(v);
      }
    }
    __syncthreads();
    if (act) {
      const int n = tid >> 2, seg = (tid & 3) * 16;
      const u32x4 a = *(const u32x4*)(tile + n * 72 + seg), b = *(const u32x4*)(tile + n * 72 + seg + 8);
      bf16_t* d = dst + (size_t)(n0 + n) * ldd + koff + k0 + seg;
      *(u32x4*)d = a; *(u32x4*)(d + 8) = b;
    }
    __syncthreads();
  }
  tbase += nt;
}

__device__ __forceinline__ void phase_prologue(char* smem, const Params& p) {
  const int tid = threadIdx.x, wid = tid >> 6, lane = tid & 63;
  if (blockIdx.x == 0 && tid < 64) ((unsigned*)(p.ws + WS_CTL))[tid] = 0u;
  {
    float* sc = (float*)smem;
    float* red = sc + 2048;
    const float* c = p.in[1];
    for (int i = tid; i < 2048; i += NT) sc[i] = siluf_(c[i]);
    __syncthreads();
    float* MOD = (float*)(p.ws + WS_MOD);
    for (int item = blockIdx.x; item < 192; item += gridDim.x) {
      const int l = item / 96, jg = item % 96, col = jg * 64 + lane;
      const float* w = p.in[3] + (size_t)l * 1024 * 6144 + col;
      float a0 = 0.f, a1 = 0.f;
      const int kb = wid * 128;
#pragma unroll 8
      for (int k = 0; k < 128; ++k) { const float wv = w[(size_t)(kb + k) * 6144]; a0 += sc[kb + k] * wv; a1 += sc[1024 + kb + k] * wv; }
      red[(wid * 2 + 0) * 64 + lane] = a0; red[(wid * 2 + 1) * 64 + lane] = a1;
      __syncthreads();
      if (wid < 2) {
        float s = 0.f;
#pragma unroll
        for (int ww = 0; ww < NW; ++ww) s += red[(ww * 2 + wid) * 64 + lane];
        MOD[(size_t)(l * 2 + wid) * 6144 + col] = s + p.in[4][l * 6144 + col];
      }
      __syncthreads();
    }
    __syncthreads();
  }
  bf16_t* WT = (bf16_t*)(p.ws + WS_WT);
  const float* mu = p.in[17];
  int tb = 0;
  for (int job = 0; job < 24; ++job) {
    const float* src; int K, N; bf16_t* dst; int ldd, koff, Kp, Np; const float* mup; int mode;
    switch (job) {
      case 0: src = p.in[5]; K = 1024; N = 2480; dst = WT + W_IN; ldd = 1024; koff = 0; Kp = 1024; Np = 2560; mup = nullptr; mode = 0; break;
      case 1: src = p.in[12]; K = 256; N = 768; dst = WT + W_UQ; ldd = 256; koff = 0; Kp = 256; Np = 768; mup = nullptr; mode = 0; break;
      case 2: src = p.in[13]; K = 128; N = 1024; dst = WT + W_UKV; ldd = 128; koff = 0; Kp = 128; Np = 1024; mup = nullptr; mode = 0; break;
      case 3: src = p.in[16]; K = 1024; N = 1024; dst = WT + W_OUT; ldd = 1024; koff = 0; Kp = 1024; Np = 1024; mup = nullptr; mode = 0; break;
      case 4: src = p.in[18]; K = 1024; N = 1024; dst = WT + W_RKV + (size_t)0 * 2048; ldd = 2048; koff = 0; Kp = 1024; Np = 1024; mup = mu + 0 * 1024; mode = 2; break;
      case 5: src = p.in[18]; K = 1024; N = 1024; dst = WT + W_RKV + (size_t)0 * 2048; ldd = 2048; koff = 1024; Kp = 1024; Np = 1024; mup = mu + 0 * 1024; mode = 1; break;
      case 6: src = p.in[19]; K = 1024; N = 1024; dst = WT + W_RKV + (size_t)1024 * 2048; ldd = 2048; koff = 0; Kp = 1024; Np = 1024; mup = mu + 2 * 1024; mode = 2; break;
      case 7: src = p.in[19]; K = 1024; N = 1024; dst = WT + W_RKV + (size_t)1024 * 2048; ldd = 2048; koff = 1024; Kp = 1024; Np = 1024; mup = mu + 2 * 1024; mode = 1; break;
      case 8: src = p.in[20]; K = 1024; N = 1024; dst = WT + W_RKV + (size_t)2048 * 2048; ldd = 2048; koff = 0; Kp = 1024; Np = 1024; mup = mu + 3 * 1024; mode = 2; break;
      case 9: src = p.in[20]; K = 1024; N = 1024; dst = WT + W_RKV + (size_t)2048 * 2048; ldd = 2048; koff = 1024; Kp = 1024; Np = 1024; mup = mu + 3 * 1024; mode = 1; break;
      case 10: src = p.in[23]; K = 1024; N = 64; dst = WT + W_RKV + (size_t)3072 * 2048; ldd = 2048; koff = 0; Kp = 1024; Np = 64; mup = mu + 1 * 1024; mode = 2; break;
      case 11: src = p.in[23]; K = 1024; N = 64; dst = WT + W_RKV + (size_t)3072 * 2048; ldd = 2048; koff = 1024; Kp = 1024; Np = 64; mup = mu + 1 * 1024; mode = 1; break;
      case 12: src = p.in[26]; K = 1024; N = 64; dst = WT + W_RKV + (size_t)3136 * 2048; ldd = 2048; koff = 0; Kp = 1024; Np = 64; mup = mu + 4 * 1024; mode = 2; break;
      case 13: src = p.in[26]; K = 1024; N = 64; dst = WT + W_RKV + (size_t)3136 * 2048; ldd = 2048; koff = 1024; Kp = 1024; Np = 64; mup = mu + 4 * 1024; mode = 1; break;
      case 14: src = p.in[28]; K = 1024; N = 160; dst = WT + W_RKV + (size_t)3200 * 2048; ldd = 2048; koff = 0; Kp = 1024; Np = 384; mup = mu + 5 * 1024; mode = 2; break;
      case 15: src = p.in[28]; K = 1024; N = 160; dst = WT + W_RKV + (size_t)3200 * 2048; ldd = 2048; koff = 1024; Kp = 1024; Np = 384; mup = mu + 5 * 1024; mode = 1; break;
      case 16: src = p.in[24]; K = 64; N = 1024; dst = WT + W_W2; ldd = 128; koff = 0; Kp = 128; Np = 1024; mup = nullptr; mode = 0; break;
      case 17: src = p.in[27]; K = 64; N = 1024; dst = WT + W_A2; ldd = 128; koff = 0; Kp = 128; Np = 1024; mup = nullptr; mode = 0; break;
      case 18: src = p.in[29]; K = 160; N = 1024; dst = WT + W_G2; ldd = 256; koff = 0; Kp = 256; Np = 1024; mup = nullptr; mode = 0; break;
      case 19: src = p.in[21]; K = 1024; N = 1024; dst = WT + W_O; ldd = 1024; koff = 0; Kp = 1024; Np = 1024; mup = nullptr; mode = 0; break;
      case 20: src = p.in[35]; K = 1024; N = 4096; dst = WT + W_UP0; ldd = 1024; koff = 0; Kp = 1024; Np = 4096; mup = nullptr; mode = 0; break;
      case 21: src = p.in[35] + (size_t)1024 * 4096; K = 1024; N = 4096; dst = WT + W_UP1; ldd = 1024; koff = 0; Kp = 1024; Np = 4096; mup = nullptr; mode = 0; break;
      case 22: src = p.in[36]; K = 4096; N = 1024; dst = WT + W_DN0; ldd = 4096; koff = 0; Kp = 4096; Np = 1024; mup = nullptr; mode = 0; break;
      default: src = p.in[36] + (size_t)4096 * 1024; K = 4096; N = 1024; dst = WT + W_DN1; ldd = 4096; koff = 0; Kp = 4096; Np = 1024; mup = nullptr; mode = 0; break;
    }
    conv_job(smem, src, K, N, dst, ldd, koff, Kp, Np, mup, mode, tb);
  }
}

template <int MODE> __device__ __forceinline__ void phase_adaln(const Params& p, const float* src, int layer, int which, bf16_t* dst) {
  const int tid = threadIdx.x, wid = tid >> 6, lane = tid & 63;
  const float* MOD = (const float*)(p.ws + WS_MOD);
  const int gw = blockIdx.x * NW + wid, nw = gridDim.x * NW;
  for (int row0 = gw; row0 < MTOK; row0 += 4 * nw) {
    f32x4 v[4][4];
#pragma unroll
    for (int u = 0; u < 4; ++u) {
      const int rowc = (row0 + u * nw < MTOK) ? row0 + u * nw : MTOK - 1;
      const float* xr = src + (size_t)rowc * DM;
#pragma unroll
      for (int i = 0; i < 4; ++i) v[u][i] = *(const f32x4*)(xr + i * 256 + lane * 4);
    }
#pragma unroll
    for (int u = 0; u < 4; ++u) {
      const int row = row0 + u * nw;
      if (row < MTOK) {
        const int b = row >> 14, s = row & (SEQ - 1);
        const float* shift = MOD + (size_t)(layer * 2 + b) * 6144 + which * 3072;
        const float* scale = shift + 1024;
        float ss = 0.f;
#pragma unroll
        for (int i = 0; i < 4; ++i) ss += v[u][i][0] * v[u][i][0] + v[u][i][1] * v[u][i][1] + v[u][i][2] * v[u][i][2] + v[u][i][3] * v[u][i][3];
        ss = wave_sum(ss);
        const float r = rsqrtf(ss * (1.f / 1024.f) + 1e-6f);
#pragma unroll
        for (int i = 0; i < 4; ++i) {
          const int col = i * 256 + lane * 4;
          const f32x4 sc = *(const f32x4*)(scale + col), sh = *(const f32x4*)(shift + col);
          u32x2 w;
          w.x = pk2(v[u][i][0] * r * (1.f + sc[0]) + sh[0], v[u][i][1] * r * (1.f + sc[1]) + sh[1]);
          w.y = pk2(v[u][i][2] * r * (1.f + sc[2]) + sh[2], v[u][i][3] * r * (1.f + sc[3]) + sh[3]);
          if (MODE == 0) { *(u32x2*)(dst + (size_t)row * 1024 + col) = w; }
          else {
            *(u32x2*)(dst + (size_t)row * 2048 + col) = w;
            if (s + 1 < SEQ) *(u32x2*)(dst + (size_t)(row + 1) * 2048 + 1024 + col) = w;
            if (s == 0) { u32x2 z = {0u, 0u}; *(u32x2*)(dst + (size_t)row * 2048 + 1024 + col) = z; }
          }
        }
      }
    }
  }
}

struct EpiStore { bf16_t* C; int ldc;
  __device__ __forceinline__ void operator()(int row, int col, f32x4 v) const { u32x2 w = {pk2(v[0], v[1]), pk2(v[2], v[3])}; *(u32x2*)(C + (size_t)row * ldc + col) = w; } };
struct EpiKV { bf16_t* KN; bf16_t* Vt;
  __device__ __forceinline__ void operator()(int row, int col, f32x4 v) const {
    const int h = col >> 7, c = col & 127;
    if (c < 64) { u32x2 w = {pk2(v[0], v[1]), pk2(v[2], v[3])}; *(u32x2*)(KN + (size_t)row * 512 + h * 64 + c) = w; }
    else { const int b = row >> 14, s = row & (SEQ - 1); bf16_t* d = Vt + ((size_t)((b * 8 + h) * 64 + (c - 64))) * SEQ + s;
#pragma unroll
      for (int j = 0; j < 4; ++j) d[(size_t)j * SEQ] = f2bf(v[j]); }
  } };
struct EpiResid { const float* base; float* out; const float* gate;
  __device__ __forceinline__ void operator()(int row, int col, f32x4 v) const {
    const int b = row >> 14; const f32x4 g = *(const f32x4*)(gate + (size_t)b * 6144 + col);
    const f32x4 x = *(const f32x4*)(base + (size_t)row * DM + col);
    *(f32x4*)(out + (size_t)row * DM + col) = x + g * v; } };
struct EpiUp { bf16_t* U;
  __device__ __forceinline__ void operator()(int row, int col, f32x4 v) const {
    f32x4 r;
#pragma unroll
    for (int j = 0; j < 4; ++j) { const float t = v[j] > 0.f ? v[j] : 0.f; r[j] = t * t; }
    u32x2 w = {pk2(r[0], r[1]), pk2(r[2], r[3])}; *(u32x2*)(U + (size_t)row * DFF + col) = w; } };
struct EpiRkv { bf16_t* RKV; bf16_t* LORA;
  __device__ __forceinline__ void operator()(int row, int col, f32x4 v) const {
    if (col < 3072) { u32x2 w = {pk2(v[0], v[1]), pk2(v[2], v[3])}; *(u32x2*)(RKV + (size_t)row * 3072 + col) = w; }
    else { const int c = col - 3072; f32x4 r;
      if (c < 64) { for (int j = 0; j < 4; ++j) r[j] = tanhf(v[j]); }
      else if (c < 128) r = v;
      else if (c < 288) { for (int j = 0; j < 4; ++j) r[j] = sigmoidf_(v[j]); }
      else r = (f32x4){0.f, 0.f, 0.f, 0.f};
      if (c < 384) { u32x2 w = {pk2(r[0], r[1]), pk2(r[2], r[3])}; *(u32x2*)(LORA + (size_t)row * 384 + c) = w; } }
  } };

namespace pg8 {
#define PG8_LAS __attribute__((address_space(3)))
typedef unsigned short bf16_t;
typedef short bf16x8 __attribute__((ext_vector_type(8)));
typedef float f32x4 __attribute__((ext_vector_type(4)));
typedef unsigned u32x4 __attribute__((ext_vector_type(4)));
constexpr int BM = 256, BK = 64, HALF = 128, HTB = HALF * BK * 2  , STAGE_BYTES = 8 * HTB, NXCD = 8, WGM = 8;

__host__ __device__ __forceinline__ int lds_byte(int r, int c) { const int st = (r >> 4) * 2 + (c >> 5), rr = r & 15, cc = c & 31, ob = rr * 64 + cc * 2; return st * 1024 + (ob ^ (((ob >> 9) & 1) << 5)); }
__host__ __device__ __forceinline__ void stage_rc(int b, int& R, int& C) { const int st = b / 1024, sb = b % 1024, swz = sb ^ (((sb >> 9) & 1) << 5); R = (st >> 1) * 16 + swz / 64; C = (st & 1) * 32 + (swz % 64) / 2; }
__host__ __device__ __forceinline__ int perm32(int rho) { const int n = rho >> 4, i = rho & 15; return 8 * (i >> 2) + 4 * n + (i & 3); }

struct Unit { int pm, pn; };
struct Gemm { const bf16_t* A; const bf16_t* Bt; int M, N, K, lda; };

struct StaticOrder {
    int nM, nN, nwg, G, c;
    __host__ __device__ void init(int M, int N, int G_, int c_) { nM = M / BM; nN = N / BM; nwg = nM * nN; G = G_; c = c_; }
    __host__ __device__ bool next(int i, Unit& u) const {
        const long L = (long)i * G + c; if (L >= nwg) return false;
        int wgid = (int)L; { const int q = nwg / NXCD, r = nwg % NXCD, xcd = wgid % NXCD, off = wgid / NXCD; wgid = (xcd < r ? xcd * (q + 1) : r * (q + 1) + (xcd - r) * q) + off; }
        const int nig = WGM * nN, gid = wgid / nig, fm = gid * WGM, gsz = (nM - fm) < WGM ? (nM - fm) : WGM;
        u.pm = fm + ((wgid % nig) % gsz); u.pn = (wgid % nig) / gsz; return true;
    }
    __device__ __forceinline__ void a_ready(const Unit&) const {}
    __device__ __forceinline__ void done(const Unit&) const {}
};


template <class Epi, class Sched, bool ALIGN_EPI = false, bool SP2 = false>
__device__ __forceinline__ void gemm_phase(PG8_LAS unsigned char* lds, const Gemm g, const Sched& S, const Epi& E) {
    const int tid = threadIdx.x, wid = __builtin_amdgcn_readfirstlane(tid >> 6), lane = tid & 63, wr = wid >> 2, wc = wid & 3, fr = lane & 15, fq = lane >> 4;
    const int K = g.K, nt = K / BK;
    unsigned voffA[2], voffB[2];
#pragma unroll
    for (int i = 0; i < 2; ++i) { int R, C; stage_rc(tid * 16 + i * 8192, R, C); const int Rb = Epi::PERM ? ((R & ~31) + perm32(R & 31)) : R;
        voffA[i] = (unsigned)(R * g.lda + C) * 2u; voffB[i] = (unsigned)(Rb * K + C) * 2u; }
    const size_t kstep = (size_t)(BK * 2);
    const size_t hstepA = (size_t)HALF * g.lda * 2, hstepB = (size_t)HALF * K * 2;
    const size_t tstepA = 2 * hstepA, tstepB = 2 * hstepB;
    const unsigned ldsw = (unsigned)wid * 1024u;
    const int aoff = lds_byte(wr * 64 + fr, fq * 8), boff = lds_byte(wc * 32 + fr, fq * 8);
#define PG8_SA(b, h) (((b) * 2 + (h)) * HTB)
#define PG8_SB(b, h) ((4 + (b) * 2 + (h)) * HTB)
#define PG8_STAGE(bufoff, gbase, voff) do { _Pragma("unroll") for (int _i = 0; _i < 2; ++_i) \
        __builtin_amdgcn_global_load_lds((const unsigned*)((const char*)(gbase) + (voff)[_i]), (PG8_LAS unsigned*)(lds + (bufoff) + ldsw + _i * 8192), 16, 0, 0); } while (0)
#define PG8_LDA(dst, b, h) do { _Pragma("unroll") for (int m = 0; m < 4; ++m) _Pragma("unroll") for (int k = 0; k < 2; ++k) dst[m][k] = *(const PG8_LAS bf16x8*)(lds + PG8_SA(b, h) + aoff + m * 2048 + k * 1024); } while (0)
#define PG8_LDB(dst, b, h) do { _Pragma("unroll") for (int n = 0; n < 2; ++n) _Pragma("unroll") for (int k = 0; k < 2; ++k) dst[n][k] = *(const PG8_LAS bf16x8*)(lds + PG8_SB(b, h) + boff + n * 2048 + k * 1024); } while (0)
#define PG8_MMA(ai, bj, At, Bt) do { __builtin_amdgcn_s_setprio(1); _Pragma("unroll") for (int m = 0; m < 4; ++m) _Pragma("unroll") for (int n = 0; n < 2; ++n) _Pragma("unroll") for (int k = 0; k < 2; ++k) \
        acc[ai][bj][m][n] = __builtin_amdgcn_mfma_f32_16x16x32_bf16(Bt[n][k], At[m][k], acc[ai][bj][m][n], 0, 0, 0); __builtin_amdgcn_s_setprio(0); } while (0)
#define PG8_WAIT_V(n) asm volatile("s_waitcnt vmcnt(" #n ")" ::: "memory")
#define PG8_WAIT_L(n) asm volatile("s_waitcnt lgkmcnt(" #n ")" ::: "memory")
#define PG8_BAR __builtin_amdgcn_s_barrier()
#define PG8_SCHED __builtin_amdgcn_sched_barrier(0)
    Unit cur, nxt; int ui = 0;
    if (!S.next(0, cur)) return;
    f32x4 acc[2][2][4][2];
#pragma unroll
    for (int a = 0; a < 2; ++a)
#pragma unroll
        for (int b = 0; b < 2; ++b)
#pragma unroll
            for (int m = 0; m < 4; ++m)
#pragma unroll
                for (int n = 0; n < 2; ++n) acc[a][b][m][n] = (f32x4){0.f, 0.f, 0.f, 0.f};
    bf16x8 At[4][2], B0[2][2], B1[2][2];
    const char* cA = (const char*)g.A + (size_t)cur.pm * tstepA; const char* cB = (const char*)g.Bt + (size_t)cur.pn * tstepB;
    S.a_ready(cur);
    if constexpr (SP2) {
        PG8_STAGE(PG8_SB(0, 0), cB, voffB); PG8_STAGE(PG8_SB(0, 1), cB + hstepB, voffB); PG8_STAGE(PG8_SA(0, 0), cA, voffA); PG8_STAGE(PG8_SA(0, 1), cA + hstepA, voffA);
        if (wr == 1) PG8_BAR;
        PG8_WAIT_V(2); PG8_BAR;
        PG8_STAGE(PG8_SB(1, 0), cB + kstep, voffB); PG8_STAGE(PG8_SA(1, 0), cA + kstep, voffA); PG8_STAGE(PG8_SB(1, 1), cB + hstepB + kstep, voffB);
        PG8_WAIT_V(6); PG8_BAR;
    } else {
        PG8_STAGE(PG8_SB(0, 0), cB, voffB); PG8_STAGE(PG8_SA(0, 0), cA, voffA); PG8_STAGE(PG8_SB(0, 1), cB + hstepB, voffB); PG8_STAGE(PG8_SA(0, 1), cA + hstepA, voffA);
        if (wr == 1) PG8_BAR;
        PG8_WAIT_V(4); PG8_BAR;
        PG8_STAGE(PG8_SB(1, 0), cB + kstep, voffB); PG8_STAGE(PG8_SA(1, 0), cA + kstep, voffA); PG8_STAGE(PG8_SB(1, 1), cB + hstepB + kstep, voffB);
        PG8_WAIT_V(6); PG8_BAR;
    }
    for (;;) {
        const bool has_next = S.next(ui + 1, nxt);
        const char* nA = has_next ? (const char*)g.A + (size_t)nxt.pm * tstepA : cA; const char* nB = has_next ? (const char*)g.Bt + (size_t)nxt.pn * tstepB : cB;
#pragma unroll 1
        for (int t = 0; t < nt; t += 2) {
            const bool last = (t == nt - 2);
            const char* a1 = cA + (size_t)(t + 1) * kstep;
            const char* a2 = last ? nA : cA + (size_t)(t + 2) * kstep; const char* b2 = last ? nB : cB + (size_t)(t + 2) * kstep;
            const char* a3 = a2 + kstep; const char* b3 = b2 + kstep;
            if (last && has_next) S.a_ready(nxt);
            if constexpr (SP2) {
            PG8_LDB(B0, 0, 0); PG8_LDB(B1, 0, 1); PG8_SCHED; PG8_LDA(At, 0, 0); PG8_STAGE(PG8_SA(1, 1), a1 + hstepA, voffA);
            PG8_WAIT_V(8); PG8_WAIT_L(0); PG8_BAR; PG8_MMA(0, 0, At, B0); PG8_MMA(0, 1, At, B1); PG8_BAR; PG8_SCHED;
            PG8_LDA(At, 0, 1); PG8_STAGE(PG8_SB(0, 0), b2, voffB); PG8_STAGE(PG8_SB(0, 1), b2 + hstepB, voffB); PG8_STAGE(PG8_SA(0, 0), a2, voffA);
            PG8_WAIT_V(8); PG8_WAIT_L(0); PG8_BAR; PG8_MMA(1, 0, At, B0); PG8_MMA(1, 1, At, B1); PG8_BAR; PG8_SCHED;
            PG8_LDB(B0, 1, 0); PG8_LDB(B1, 1, 1); PG8_SCHED; PG8_LDA(At, 1, 0); PG8_STAGE(PG8_SA(0, 1), a2 + hstepA, voffA);
            PG8_WAIT_V(8); PG8_WAIT_L(0); PG8_BAR; PG8_MMA(0, 0, At, B0); PG8_MMA(0, 1, At, B1); PG8_BAR; PG8_SCHED;
            PG8_LDA(At, 1, 1); PG8_STAGE(PG8_SB(1, 0), b3, voffB); PG8_STAGE(PG8_SB(1, 1), b3 + hstepB, voffB); PG8_STAGE(PG8_SA(1, 0), a3, voffA);
            PG8_WAIT_V(8); PG8_WAIT_L(0); PG8_BAR; PG8_MMA(1, 0, At, B0); PG8_MMA(1, 1, At, B1); PG8_BAR; PG8_SCHED;
            } else {
            PG8_LDB(B0, 0, 0); PG8_SCHED; PG8_LDA(At, 0, 0); PG8_STAGE(PG8_SA(1, 1), a1 + hstepA, voffA);
            PG8_WAIT_L(8); PG8_BAR; PG8_WAIT_L(0); PG8_MMA(0, 0, At, B0); PG8_BAR; PG8_SCHED;
            PG8_LDB(B1, 0, 1); PG8_STAGE(PG8_SB(0, 0), b2, voffB);
            PG8_BAR; PG8_WAIT_L(0); PG8_MMA(0, 1, At, B1); PG8_BAR;
            PG8_LDA(At, 0, 1); PG8_STAGE(PG8_SA(0, 0), a2, voffA);
            PG8_BAR; PG8_WAIT_L(0); PG8_MMA(1, 0, At, B0); PG8_BAR; PG8_SCHED;
            PG8_STAGE(PG8_SB(0, 1), b2 + hstepB, voffB);
            PG8_WAIT_V(6); PG8_BAR; PG8_MMA(1, 1, At, B1); PG8_BAR;
            PG8_LDB(B0, 1, 0); PG8_SCHED; PG8_LDA(At, 1, 0); PG8_STAGE(PG8_SA(0, 1), a2 + hstepA, voffA);
            PG8_WAIT_L(8); PG8_BAR; PG8_WAIT_L(0); PG8_MMA(0, 0, At, B0); PG8_BAR; PG8_SCHED;
            PG8_LDB(B1, 1, 1); PG8_STAGE(PG8_SB(1, 0), b3, voffB);
            PG8_BAR; PG8_WAIT_L(0); PG8_MMA(0, 1, At, B1); PG8_BAR;
            PG8_LDA(At, 1, 1); PG8_STAGE(PG8_SA(1, 0), a3, voffA);
            PG8_BAR; PG8_WAIT_L(0); PG8_MMA(1, 0, At, B0); PG8_BAR; PG8_SCHED;
            PG8_STAGE(PG8_SB(1, 1), b3 + hstepB, voffB);
            PG8_WAIT_V(6); PG8_BAR; PG8_MMA(1, 1, At, B1); PG8_BAR;
            }
        }
        if constexpr (ALIGN_EPI) { if (wr == 0) PG8_BAR; }
        if constexpr (!Epi::AFTER_DRAIN) { E(acc, cur, wr, wc, fr, fq); S.done(cur); }
        if (!has_next) break;
#pragma unroll
        for (int a = 0; a < 2; ++a)
#pragma unroll
            for (int b = 0; b < 2; ++b)
#pragma unroll
                for (int m = 0; m < 4; ++m)
#pragma unroll
                    for (int n = 0; n < 2; ++n) acc[a][b][m][n] = (f32x4){0.f, 0.f, 0.f, 0.f};
        cur = nxt; cA = nA; cB = nB; ++ui;
        if constexpr (ALIGN_EPI) { if (wr == 1) PG8_BAR; }
    }
    PG8_WAIT_V(0);
    if constexpr (!ALIGN_EPI) { if (wr == 0) PG8_BAR; }
    PG8_BAR;
    if constexpr (Epi::AFTER_DRAIN) { E.fused(acc, cur, wr, wc, fr, fq, lds, wid, lane); S.done(cur); }
#undef PG8_SA
#undef PG8_SB
#undef PG8_STAGE
#undef PG8_LDA
#undef PG8_LDB
#undef PG8_MMA
#undef PG8_WAIT_V
#undef PG8_WAIT_L
#undef PG8_BAR
#undef PG8_SCHED
}
}


template <class F> struct EpiAdapt {
  static constexpr bool PERM = false, AFTER_DRAIN = false; F f;
  __device__ __forceinline__ void operator()(const pg8::f32x4 (&acc)[2][2][4][2], const pg8::Unit& u, int wr, int wc, int fr, int fq) const {
#pragma unroll
    for (int ai = 0; ai < 2; ++ai)
#pragma unroll
      for (int m = 0; m < 4; ++m) { const int row = u.pm * 256 + 128 * ai + 64 * wr + 16 * m + fr;
#pragma unroll
        for (int bj = 0; bj < 2; ++bj)
#pragma unroll
          for (int n = 0; n < 2; ++n) f(row, u.pn * 256 + 128 * bj + 32 * wc + 16 * n + 4 * fq, acc[ai][bj][m][n]); }
  }
};
template <class F>
__device__ __forceinline__ void gemm_phase(char* smem, const bf16_t* A, int lda, const bf16_t* Bt, int ldb, int M, int N, int K, const F f) {
  (void)ldb;
  asm volatile("" : "+s"(K));
  pg8::Gemm g{A, Bt, M, N, K, lda}; pg8::StaticOrder S; S.init(M, N, (int)gridDim.x, (int)blockIdx.x);
  EpiAdapt<F> E{f};
  pg8::gemm_phase<EpiAdapt<F>, pg8::StaticOrder, true, true>((PG8_LAS unsigned char*)smem, g, S, E);
  __syncthreads();
}

__device__ __forceinline__ void phase_prep0(const Params& p) {
  const int tid = threadIdx.x, wid = tid >> 6, lane = tid & 63;
  const bf16_t* PROJ = (const bf16_t*)(p.ws + A_PROJ);
  bf16_t* GQKV[3] = {(bf16_t*)(p.ws + A_GQ), (bf16_t*)(p.ws + A_GK), (bf16_t*)(p.ws + A_GV)};
  float* GA = (float*)(p.ws + A_GA); float* GB = (float*)(p.ws + A_GB);
  bf16_t* QLAT = (bf16_t*)(p.ws + A_QLAT); bf16_t* KVLAT = (bf16_t*)(p.ws + A_KVLAT);
  const float* cw = p.in[6];
  const int gw = blockIdx.x * NW + wid, nw = gridDim.x * NW;
#pragma unroll 2
  for (int row = gw; row < MTOK; row += nw) {
    const int s = row & (SEQ - 1);
    const bf16_t* pr = PROJ + (size_t)row * PROJ_LD;
#pragma unroll
    for (int part = 0; part < 3; ++part) {
      const int col = part * 512 + lane * 8;
      float acc[8];
#pragma unroll
      for (int e = 0; e < 8; ++e) acc[e] = 0.f;
#pragma unroll
      for (int j = 0; j < 4; ++j) {
        const int ds = 3 - j;
        if (s - ds >= 0) {
          const u32x4 t = *(const u32x4*)(pr - (size_t)ds * PROJ_LD + col);
          const f32x4 w0 = *(const f32x4*)(cw + j * 1536 + col), w1 = *(const f32x4*)(cw + j * 1536 + col + 4);
          acc[0] += w0[0] * bflo(t.x); acc[1] += w0[1] * bfhi(t.x); acc[2] += w0[2] * bflo(t.y); acc[3] += w0[3] * bfhi(t.y);
          acc[4] += w1[0] * bflo(t.z); acc[5] += w1[1] * bfhi(t.z); acc[6] += w1[2] * bflo(t.w); acc[7] += w1[3] * bfhi(t.w);
        }
      }
      float ss = 0.f;
#pragma unroll
      for (int e = 0; e < 8; ++e) { acc[e] = siluf_(acc[e]); ss += acc[e] * acc[e]; }
      if (part < 2) {
        ss = group_sum<8>(ss);
        const float r = rsqrtf(ss + 1e-12f);
#pragma unroll
        for (int e = 0; e < 8; ++e) acc[e] *= r;
      }
      u32x4 w = {pk2(acc[0], acc[1]), pk2(acc[2], acc[3]), pk2(acc[4], acc[5]), pk2(acc[6], acc[7])};
      *(u32x4*)(GQKV[part] + ((size_t)((row >> 14) * 8 + (lane >> 3)) * SEQ + s) * 64 + (lane & 7) * 8) = w;
    }
    if (lane < 8) {
      const float a = bf2f(pr[2048 + lane]), bb = bf2f(pr[2056 + lane]);
      const float g = -expf(p.in[7][lane]) * softplusf_(a + p.in[8][lane]);
      GA[(size_t)row * 8 + lane] = expf(g);
      ((float*)(p.ws + A_GG))[(size_t)row * 8 + lane] = g;
      GB[(size_t)row * 8 + lane] = sigmoidf_(bb);
    }
    {
      *(u32x4*)((bf16_t*)(p.ws + A_Z) + (size_t)row * 512 + lane * 8) = *(const u32x4*)(pr + 1536 + lane * 8);
      if (lane < 16) *(unsigned*)((bf16_t*)(p.ws + A_KR) + (size_t)row * 32 + lane * 2) = *(const unsigned*)(pr + 2448 + lane * 2);
    }
    {
      const u32x2 t = *(const u32x2*)(pr + 2064 + lane * 4);
      float v0 = bflo(t.x), v1 = bfhi(t.x), v2 = bflo(t.y), v3 = bfhi(t.y);
      float ss = wave_sum(v0 * v0 + v1 * v1 + v2 * v2 + v3 * v3);
      const float r = rsqrtf(ss * (1.f / 256.f) + 1e-6f);
      const f32x4 g = *(const f32x4*)(p.in[10] + lane * 4);
      u32x2 w = {pk2(v0 * r * g[0], v1 * r * g[1]), pk2(v2 * r * g[2], v3 * r * g[3])};
      *(u32x2*)(QLAT + (size_t)row * 256 + lane * 4) = w;
    }
    {
      const unsigned t = *(const unsigned*)(pr + 2320 + lane * 2);
      float v0 = bflo(t), v1 = bfhi(t);
      float ss = wave_sum(v0 * v0 + v1 * v1);
      const float r = rsqrtf(ss * (1.f / 128.f) + 1e-6f);
      const f32x2 g = *(const f32x2*)(p.in[11] + lane * 2);
      *(unsigned*)(KVLAT + (size_t)row * 128 + lane * 2) = pk2(v0 * r * g[0], v1 * r * g[1]);
    }
  }
}

__device__ __forceinline__ void phase_qkrope(const Params& p) {
  const int tid = threadIdx.x, wid = tid >> 6, lane = tid & 63;
  const int h = lane >> 3, sub = lane & 7;
  bf16_t* QH = (bf16_t*)((char*)p.out + O_QH); bf16_t* KH = (bf16_t*)((char*)p.out + O_KH);
  const bf16_t* KN = (const bf16_t*)(p.ws + A_KN); const bf16_t* PROJ = (const bf16_t*)(p.ws + A_PROJ);
  const int* pos = (const int*)p.in[2];
  const float* qg = p.in[14]; const float* kg = p.in[15];
  float qgn[8], kgn[8], qg1[2], qg2[2], kg1[2], kg2[2];
#pragma unroll
  for (int e = 0; e < 8; ++e) { qgn[e] = qg[sub * 8 + e]; kgn[e] = kg[sub * 8 + e]; }
#pragma unroll
  for (int e = 0; e < 2; ++e) { qg1[e] = qg[64 + 2 * sub + e]; qg2[e] = qg[80 + 2 * sub + e]; kg1[e] = kg[64 + 2 * sub + e]; kg2[e] = kg[80 + 2 * sub + e]; }
  float invf[2];
#pragma unroll
  for (int e = 0; e < 2; ++e) invf[e] = powf(10000.0f, -(float)(2 * (2 * sub + e)) / 32.0f);
  const float qscale = 0.10206207261596577f * 1.4426950408889634f;
  const int gw = blockIdx.x * NW + wid, nw = gridDim.x * NW;
#pragma unroll 2
  for (int row = gw; row < MTOK; row += nw) {
    const float fp = (float)pos[row];
    float cs[2], sn[2];
#pragma unroll
    for (int e = 0; e < 2; ++e) {
      const float ang = fp * invf[e];
      const double rev = (double)ang * 0.15915494309189535;
      const float fr = (float)(rev - rint(rev));
      sn[e] = __builtin_amdgcn_sinf(fr); cs[e] = __builtin_amdgcn_cosf(fr);
    }
    {
      bf16_t* q = QH + (size_t)row * 768 + h * 96;
      const u32x4 t = *(const u32x4*)(q + sub * 8);
      const unsigned t1 = *(const unsigned*)(q + 64 + 2 * sub), t2 = *(const unsigned*)(q + 80 + 2 * sub);
      float v[8] = {bflo(t.x), bfhi(t.x), bflo(t.y), bfhi(t.y), bflo(t.z), bfhi(t.z), bflo(t.w), bfhi(t.w)};
      float x1[2] = {bflo(t1), bfhi(t1)}, x2[2] = {bflo(t2), bfhi(t2)};
      float ss = x1[0] * x1[0] + x1[1] * x1[1] + x2[0] * x2[0] + x2[1] * x2[1];
#pragma unroll
      for (int e = 0; e < 8; ++e) ss += v[e] * v[e];
      ss = group_sum<8>(ss);
      const float r = rsqrtf(ss * (1.f / 96.f) + 1e-6f) * qscale;
#pragma unroll
      for (int e = 0; e < 8; ++e) v[e] *= r * qgn[e];
      float o1[2], o2[2];
#pragma unroll
      for (int e = 0; e < 2; ++e) { const float a = x1[e] * r * qg1[e], b = x2[e] * r * qg2[e]; o1[e] = a * cs[e] - b * sn[e]; o2[e] = b * cs[e] + a * sn[e]; }
      u32x4 w = {pk2(v[0], v[1]), pk2(v[2], v[3]), pk2(v[4], v[5]), pk2(v[6], v[7])};
      *(u32x4*)(q + sub * 8) = w; *(unsigned*)(q + 64 + 2 * sub) = pk2(o1[0], o1[1]); *(unsigned*)(q + 80 + 2 * sub) = pk2(o2[0], o2[1]);
    }
    {
      const bf16_t* kn = KN + (size_t)row * 512 + h * 64; const bf16_t* kr = (const bf16_t*)(p.ws + A_KR) + (size_t)row * 32;
      bf16_t* k = KH + (size_t)row * 768 + h * 96;
      const u32x4 t = *(const u32x4*)(kn + sub * 8);
      const unsigned t1 = *(const unsigned*)(kr + 2 * sub), t2 = *(const unsigned*)(kr + 16 + 2 * sub);
      float v[8] = {bflo(t.x), bfhi(t.x), bflo(t.y), bfhi(t.y), bflo(t.z), bfhi(t.z), bflo(t.w), bfhi(t.w)};
      float x1[2] = {bflo(t1), bfhi(t1)}, x2[2] = {bflo(t2), bfhi(t2)};
      float ss = x1[0] * x1[0] + x1[1] * x1[1] + x2[0] * x2[0] + x2[1] * x2[1];
#pragma unroll
      for (int e = 0; e < 8; ++e) ss += v[e] * v[e];
      ss = group_sum<8>(ss);
      const float r = rsqrtf(ss * (1.f / 96.f) + 1e-6f);
#pragma unroll
      for (int e = 0; e < 8; ++e) v[e] *= r * kgn[e];
      float o1[2], o2[2];
#pragma unroll
      for (int e = 0; e < 2; ++e) { const float a = x1[e] * r * kg1[e], b = x2[e] * r * kg2[e]; o1[e] = a * cs[e] - b * sn[e]; o2[e] = b * cs[e] + a * sn[e]; }
      u32x4 w = {pk2(v[0], v[1]), pk2(v[2], v[3]), pk2(v[4], v[5]), pk2(v[6], v[7])};
      *(u32x4*)(k + sub * 8) = w; *(unsigned*)(k + 64 + 2 * sub) = pk2(o1[0], o1[1]); *(unsigned*)(k + 80 + 2 * sub) = pk2(o2[0], o2[1]);
    }
  }
}

__device__ __forceinline__ float row32_sum(float x) {
  x = row16_sum(x);
  auto rr = __builtin_amdgcn_permlane32_swap(__float_as_uint(x), __float_as_uint(x), false, false);
  return __uint_as_float(rr[0]) + __uint_as_float(rr[1]);
}
template <int MODE> __device__ __forceinline__ void scan_unit(char* smem, const Params& p, int unit) {
  constexpr int T = 16, STEPF = 328, NH = MODE == 0 ? 8 : 16;
  const bool producer = threadIdx.x >= 256;
  const int tid = threadIdx.x & 255, rowl = (tid >> 6) * 2 + ((tid >> 4) & 1), j = (tid & 15) + ((tid >> 5) & 1) * 16;
  const int st = tid >> 4, sj = tid & 15;
  const int bh = unit >> 3, row0 = (unit & 7) * 8;
  const int b = bh / NH, h = bh % NH;
  float* buf = (float*)smem;
  const bf16_t* GQ = (const bf16_t*)(p.ws + A_GQ); const bf16_t* GK = (const bf16_t*)(p.ws + A_GK); const bf16_t* GV = (const bf16_t*)(p.ws + A_GV);
  const float* GA = (const float*)(p.ws + A_GA); const float* GB = (const float*)(p.ws + A_GB);
  bf16_t* GO = (bf16_t*)(p.ws + A_GO);
  const bf16_t* RKV = (const bf16_t*)(p.ws + A_RKV); const bf16_t* EE = (const bf16_t*)(p.ws + A_WL); const bf16_t* AA = (const bf16_t*)(p.ws + A_AL);
  const float* INV = (const float*)(p.ws + A_INV);
  bf16_t* Y = (bf16_t*)(p.ws + WS_H);
  f32x4 ckk = {0.f, 0.f, 0.f, 0.f}, cka = {0.f, 0.f, 0.f, 0.f};
  if (MODE == 1) { ckk = *(const f32x4*)(p.in[30] + h * 64 + 4 * sj); cka = *(const f32x4*)(p.in[31] + h * 64 + 4 * sj); }
  u32x2 g0, g1, g2, g3; float gs0 = 0.f, gs1 = 0.f; bf16_t gv = 0;
  auto gload = [&](int chunk) {
    const size_t tok = (size_t)b * SEQ + (size_t)chunk * T + st;
    if (MODE == 0) {
      g0 = *(const u32x2*)(GQ + tok * 512 + h * 64 + 4 * sj); g1 = *(const u32x2*)(GK + tok * 512 + h * 64 + 4 * sj);
      gs0 = GA[tok * 8 + h]; gs1 = GB[tok * 8 + h]; if (sj < 8) gv = GV[tok * 512 + h * 64 + row0 + sj];
    } else {
      g0 = *(const u32x2*)(RKV + tok * 3072 + h * 64 + 4 * sj); g1 = *(const u32x2*)(RKV + tok * 3072 + 1024 + h * 64 + 4 * sj);
      g2 = *(const u32x2*)(EE + tok * 1024 + h * 64 + 4 * sj); g3 = *(const u32x2*)(AA + tok * 1024 + h * 64 + 4 * sj);
      gs0 = INV[tok * 16 + h]; if (sj < 8) gv = RKV[tok * 3072 + 2048 + h * 64 + row0 + sj];
    }
  };
  auto gstore = [&](float* dst) {
    float* d = dst + st * STEPF;
    f32x4 r, w, k, a, bb; float v;
    if (MODE == 0) {
      const f32x4 q = {bflo(g0.x), bfhi(g0.x), bflo(g0.y), bfhi(g0.y)};
      k = (f32x4){bflo(g1.x), bfhi(g1.x), bflo(g1.y), bfhi(g1.y)};
      const float al = gs0, be = gs1;
      r = q * 0.125f; w = (f32x4){al, al, al, al}; a = k * (-al * be); bb = k; v = be * bf2f(gv);
    } else {
      r = (f32x4){bflo(g0.x), bfhi(g0.x), bflo(g0.y), bfhi(g0.y)};
      const f32x4 k0 = {bflo(g1.x), bfhi(g1.x), bflo(g1.y), bfhi(g1.y)};
      const f32x4 e = {bflo(g2.x), bfhi(g2.x), bflo(g2.y), bfhi(g2.y)};
      const f32x4 av = {bflo(g3.x), bfhi(g3.x), bflo(g3.y), bfhi(g3.y)};
      const f32x4 kk = k0 * ckk * gs0;
      a = -kk; bb = kk * av; k = k0 * (1.f + (av - 1.f) * cka);
      w = (f32x4){__expf(-e[0]), __expf(-e[1]), __expf(-e[2]), __expf(-e[3])};
      v = bf2f(gv);
    }
    *(f32x4*)(d + 4 * sj) = r; *(f32x4*)(d + 64 + 4 * sj) = w; *(f32x4*)(d + 128 + 4 * sj) = k; *(f32x4*)(d + 192 + 4 * sj) = a; *(f32x4*)(d + 256 + 4 * sj) = bb;
    if (sj < 8) d[320 + sj] = v;
  };
  f32x2 s = {0.f, 0.f};
  constexpr int NCH = SEQ / T;
  if (producer) { gload(0); gstore(buf); gload(1); }
  __syncthreads();
  for (int c = 0; c < NCH; ++c) {
    const float* cur = buf + (c & 1) * (T * STEPF);
    float* nxt = buf + ((c + 1) & 1) * (T * STEPF);
    if (producer) {
      if (c + 1 < NCH) gstore(nxt);
      if (c + 2 < NCH) gload(c + 2);
    } else {
    float yp[T];
    f32x2 r = *(const f32x2*)(cur + 2 * j), w = *(const f32x2*)(cur + 64 + 2 * j), k = *(const f32x2*)(cur + 128 + 2 * j),
          a = *(const f32x2*)(cur + 192 + 2 * j), bb = *(const f32x2*)(cur + 256 + 2 * j);
    float v = cur[320 + rowl];
#pragma unroll
    for (int t = 0; t < T; ++t) {
      f32x2 nr = r, nw = w, nk = k, na = a, nb = bb; float nv = v;
      if (t + 1 < T) {
        const float* d = cur + (t + 1) * STEPF;
        nr = *(const f32x2*)(d + 2 * j); nw = *(const f32x2*)(d + 64 + 2 * j); nk = *(const f32x2*)(d + 128 + 2 * j);
        na = *(const f32x2*)(d + 192 + 2 * j); nb = *(const f32x2*)(d + 256 + 2 * j); nv = d[320 + rowl];
      }
      float pa = s[0] * a[0] + s[1] * a[1];
      const f32x2 tkw = s * w + k * v;
      pa = row32_sum(pa);
      s = tkw + bb * pa;
      yp[t] = s[0] * r[0] + s[1] * r[1];
      r = nr; w = nw; k = nk; a = na; bb = nb; v = nv;
    }
    {
      float z[8];
#pragma unroll
      for (int i = 0; i < 8; ++i) { auto rr = __builtin_amdgcn_permlane32_swap(__float_as_uint(yp[i]), __float_as_uint(yp[i + 8]), false, false);
        z[i] = __uint_as_float(rr[0]) + __uint_as_float(rr[1]); }
      const int ln = threadIdx.x & 63;
      const bool b3 = (ln & 8) != 0, b2 = (ln & 4) != 0, b1 = (ln & 2) != 0;
      float n4[4], n2[2];
#pragma unroll
      for (int i = 0; i < 4; ++i) { const float wv = b3 ? z[i + 4] : z[i], ov = b3 ? z[i] : z[i + 4];
        n4[i] = wv + __int_as_float(__builtin_amdgcn_update_dpp(0, __float_as_int(ov), 0x140, 0xf, 0xf, false)); }
#pragma unroll
      for (int i = 0; i < 2; ++i) { const float wv = b2 ? n4[i + 2] : n4[i], ov = b2 ? n4[i] : n4[i + 2];
        n2[i] = wv + __int_as_float(__builtin_amdgcn_update_dpp(0, __float_as_int(ov), 0x141, 0xf, 0xf, false)); }
      const float wv = b1 ? n2[1] : n2[0], ov = b1 ? n2[0] : n2[1];
      const float n1 = wv + __int_as_float(__builtin_amdgcn_update_dpp(0, __float_as_int(ov), 0x1B, 0xf, 0xf, false));
      const float yt = n1 + __int_as_float(__builtin_amdgcn_update_dpp(0, __float_as_int(n1), 0xB1, 0xf, 0xf, false));
      if ((ln & 1) == 0) {
        const int t = 8 * (ln >> 5) + ((ln >> 1) & 7);
        const size_t tok = (size_t)b * SEQ + (size_t)c * T + t;
        if (MODE == 0) GO[tok * 512 + h * 64 + row0 + rowl] = f2bf(yt);
        else Y[tok * 1024 + h * 64 + row0 + rowl] = f2bf(yt);
      }
    }
    }
    LDS_BARRIER();
  }
  __syncthreads();
}

__device__ __forceinline__ void attn_unit(char* smem, const Params& p, int b, int h, int qb) {
  const int tid = threadIdx.x, wid = tid >> 6, lane = tid & 63, r32 = lane & 31, hi = lane >> 5;
  const bf16_t* QH = (const bf16_t*)((const char*)p.out + O_QH); const bf16_t* KH = (const bf16_t*)((const char*)p.out + O_KH);
  const bf16_t* VT = (const bf16_t*)((const char*)p.out + O_VT);
  bf16_t* MIX = (bf16_t*)(p.ws + WS_H);
  const int q0 = qb * 256, qrow = q0 + wid * 32 + r32;
  const size_t tokq = (size_t)b * SEQ + qrow;
  bf16x8 qr[6];
#pragma unroll
  for (int ks = 0; ks < 6; ++ks) qr[ks] = *(const bf16x8*)(QH + tokq * 768 + h * 96 + ks * 16 + hi * 8);
  f32x16 o0 = {}, o1 = {};
  float m = -1e30f, l = 0.f;
  const int ntiles = (q0 + 256) / 64;
  const bf16_t* Kg = KH + ((size_t)b * SEQ) * 768 + h * 96;
  const bf16_t* Vg = VT + ((size_t)(b * 8 + h) * 64) * SEQ;
  int krow[2], kc[2];
#pragma unroll
  for (int i = 0; i < 2; ++i) { const int id = tid + 512 * i; krow[i] = id / 12; kc[i] = id % 12; }
  const bool k2 = tid < 256;
  const int vrow = tid >> 3, vc = tid & 7;
  u32x4 rk[2], rv;
  rk[1] = (u32x4){0u, 0u, 0u, 0u};
  constexpr int STG = 22528, KSZ = 13312;
  auto gload = [&](int t) {
    const int kv0 = t * 64;
    rk[0] = *(const u32x4*)(Kg + (size_t)(kv0 + krow[0]) * 768 + kc[0] * 8);
    if (k2) rk[1] = *(const u32x4*)(Kg + (size_t)(kv0 + krow[1]) * 768 + kc[1] * 8);
    rv = *(const u32x4*)(Vg + (size_t)vrow * SEQ + kv0 + vc * 8);
  };
  auto sstore = [&](char* st) {
    *(u32x4*)(st + krow[0] * 208 + kc[0] * 16) = rk[0];
    if (k2) *(u32x4*)(st + krow[1] * 208 + kc[1] * 16) = rk[1];
    { char* d = st + KSZ + vrow * 144 + (vc >> 1) * 32 + (vc & 1) * 8;
      *(u32x2*)d = (u32x2){rv.x, rv.y}; *(u32x2*)(d + 16) = (u32x2){rv.z, rv.w}; }
  };
  gload(0); sstore(smem);
  __syncthreads();
  for (int t = 0; t < ntiles; ++t) {
    char* cur = smem + (t & 1) * STG; char* nxt = smem + ((t + 1) & 1) * STG;
    const bool more = t + 1 < ntiles;
    if (more) gload(t + 1);
    const int kv0 = t * 64;
    const int wq0 = q0 + wid * 32;
    if (kv0 <= wq0 + 31) {
      f32x16 s0 = {}, s1 = {};
#pragma unroll
      for (int ks = 0; ks < 6; ++ks) {
        const bf16x8 k0 = *(const bf16x8*)(cur + r32 * 208 + ks * 32 + hi * 16);
        const bf16x8 k1 = *(const bf16x8*)(cur + (32 + r32) * 208 + ks * 32 + hi * 16);
        s0 = __builtin_amdgcn_mfma_f32_32x32x16_bf16(k0, qr[ks], s0, 0, 0, 0);
        s1 = __builtin_amdgcn_mfma_f32_32x32x16_bf16(k1, qr[ks], s1, 0, 0, 0);
      }
      if (kv0 + 63 > wq0) {
#pragma unroll
        for (int r = 0; r < 16; ++r) { const int kv = kv0 + (r & 3) + 8 * (r >> 2) + 4 * hi; if (kv > qrow) s0[r] = -INFINITY; if (kv + 32 > qrow) s1[r] = -INFINITY; }
      }
      float mx = fmaxf(s0[0], s1[0]);
#pragma unroll
      for (int r = 1; r < 16; ++r) mx = fmaxf(mx, fmaxf(s0[r], s1[r]));
      { auto rr = __builtin_amdgcn_permlane32_swap(__float_as_uint(mx), __float_as_uint(mx), false, false); mx = fmaxf(__uint_as_float(rr[0]), __uint_as_float(rr[1])); }
      const float mn = fmaxf(m, mx);
      if (__any(mn > m)) {
        const float f = __builtin_amdgcn_exp2f(m - mn);
        m = mn; l *= f;
#pragma unroll
        for (int r = 0; r < 16; ++r) { o0[r] *= f; o1[r] *= f; }
      }
      float ps = 0.f;
#pragma unroll
      for (int r = 0; r < 16; ++r) { s0[r] = __builtin_amdgcn_exp2f(s0[r] - mn); s1[r] = __builtin_amdgcn_exp2f(s1[r] - mn); ps += s0[r] + s1[r]; }
      l += ps;
      bf16x8 pf[4];
      { u32x4 w;
        w = (u32x4){pk2(s0[0], s0[1]), pk2(s0[2], s0[3]), pk2(s0[4], s0[5]), pk2(s0[6], s0[7])}; pf[0] = __builtin_bit_cast(bf16x8, w);
        w = (u32x4){pk2(s0[8], s0[9]), pk2(s0[10], s0[11]), pk2(s0[12], s0[13]), pk2(s0[14], s0[15])}; pf[1] = __builtin_bit_cast(bf16x8, w);
        w = (u32x4){pk2(s1[0], s1[1]), pk2(s1[2], s1[3]), pk2(s1[4], s1[5]), pk2(s1[6], s1[7])}; pf[2] = __builtin_bit_cast(bf16x8, w);
        w = (u32x4){pk2(s1[8], s1[9]), pk2(s1[10], s1[11]), pk2(s1[12], s1[13]), pk2(s1[14], s1[15])}; pf[3] = __builtin_bit_cast(bf16x8, w); }
#pragma unroll
      for (int ks = 0; ks < 4; ++ks) {
        const bf16x8 v0 = *(const bf16x8*)(cur + KSZ + r32 * 144 + ks * 32 + hi * 16);
        const bf16x8 v1 = *(const bf16x8*)(cur + KSZ + (32 + r32) * 144 + ks * 32 + hi * 16);
        o0 = __builtin_amdgcn_mfma_f32_32x32x16_bf16(v0, pf[ks], o0, 0, 0, 0);
        o1 = __builtin_amdgcn_mfma_f32_32x32x16_bf16(v1, pf[ks], o1, 0, 0, 0);
      }
    }
    if (more) sstore(nxt);
    __syncthreads();
  }
  { auto rr = __builtin_amdgcn_permlane32_swap(__float_as_uint(l), __float_as_uint(l), false, false); l = __uint_as_float(rr[0]) + __uint_as_float(rr[1]); }
  const float il = 1.f / l;
  bf16_t* orow = MIX + tokq * 1024 + 512 + h * 64;
#pragma unroll
  for (int g = 0; g < 4; ++g) {
    const int d = 8 * g + 4 * hi;
    u32x2 w0 = {pk2(o0[4 * g] * il, o0[4 * g + 1] * il), pk2(o0[4 * g + 2] * il, o0[4 * g + 3] * il)};
    u32x2 w1 = {pk2(o1[4 * g] * il, o1[4 * g + 1] * il), pk2(o1[4 * g + 2] * il, o1[4 * g + 3] * il)};
    *(u32x2*)(orow + d) = w0; *(u32x2*)(orow + 32 + d) = w1;
  }
}

__device__ __forceinline__ void phase_gdnchunk(char* smem, const Params& p) {
  const int tid = threadIdx.x, wid = tid >> 6, lane = tid & 63, r32 = lane & 31, hi = lane >> 5;
  if (wid >= 2) return;
  char* wl = smem + wid * 65536;
  float* At = (float*)wl;
  float* XU = (float*)(wl + 16384);
  float* XW = (float*)(wl + 32768);
  bf16_t* T1 = (bf16_t*)(wl + 49152);
  bf16_t* T2 = (bf16_t*)(wl + 57344);
  float* tab = (float*)(smem + CTLW + 256 + wid * 512);
  const bf16_t* GQ = (const bf16_t*)(p.ws + A_GQ); const bf16_t* GK = (const bf16_t*)(p.ws + A_GK); const bf16_t* GV = (const bf16_t*)(p.ws + A_GV);
  const float* GG = (const float*)(p.ws + A_GG); const float* GB = (const float*)(p.ws + A_GB);
  bf16_t* CW = (bf16_t*)(p.ws + A_CW); bf16_t* CU = (bf16_t*)(p.ws + A_CU); bf16_t* CQK = (bf16_t*)(p.ws + A_CQK);
  bf16_t* CKD = (bf16_t*)(p.ws + A_CKD); bf16_t* CQD = (bf16_t*)(p.ws + A_CQD); float* GL = (float*)(p.ws + A_GL);
  const int crw = lane >> 3, cch = lane & 7;
  const int c = lane;
#define LWAIT() asm volatile("s_waitcnt lgkmcnt(0)" ::: "memory")
#pragma unroll 1
  for (int unit = blockIdx.x * 2 + wid; unit < 4096; unit += gridDim.x * 2) {
    const int bh = unit >> 8, n = unit & 255, b = bh >> 3, h = bh & 7;
    const size_t tok0 = (size_t)b * SEQ + (size_t)n * 64;
    const size_t hoff = ((size_t)bh * SEQ + (size_t)n * 64) * 64;
    const bf16_t* kbase = GK + hoff; const bf16_t* qbase = GQ + hoff; const bf16_t* vbase = GV + hoff;
    float gc = GG[(tok0 + lane) * 8 + h]; const float be = GB[(tok0 + lane) * 8 + h];
#pragma unroll
    for (int o = 1; o < 64; o <<= 1) { const float t = __shfl_up(gc, o); if (lane >= o) gc += t; }
    tab[lane] = gc; tab[64 + lane] = be;
    const float gl = __shfl(gc, 63);
    LWAIT();
#pragma unroll 1
    for (int pass = 0; pass < 2; ++pass) {
      const bf16_t* abase = pass == 0 ? kbase : qbase;
      f32x16 acc[2][2];
#pragma unroll
      for (int i = 0; i < 2; ++i)
#pragma unroll
        for (int jj = 0; jj < 2; ++jj) acc[i][jj] = (f32x16){};
#pragma unroll
      for (int ks = 0; ks < 4; ++ks) {
        bf16x8 ka[2], aa[2];
#pragma unroll
        for (int ib = 0; ib < 2; ++ib) {
          ka[ib] = *(const bf16x8*)(kbase + (size_t)(ib * 32 + r32) * 64 + ks * 16 + hi * 8);
          aa[ib] = *(const bf16x8*)(abase + (size_t)(ib * 32 + r32) * 64 + ks * 16 + hi * 8);
        }
#pragma unroll
        for (int ib = 0; ib < 2; ++ib)
#pragma unroll
          for (int jb = 0; jb < 2; ++jb) acc[ib][jb] = __builtin_amdgcn_mfma_f32_32x32x16_bf16(aa[ib], ka[jb], acc[ib][jb], 0, 0, 0);
      }
#pragma unroll
      for (int ib = 0; ib < 2; ++ib)
#pragma unroll
        for (int jb = 0; jb < 2; ++jb) {
          const int j = jb * 32 + r32; const float gcj = tab[j];
#pragma unroll
          for (int r = 0; r < 16; ++r) {
            const int i = ib * 32 + (r & 3) + 8 * (r >> 2) + 4 * hi;
            const float dec = __expf(fminf(tab[i] - gcj, 0.f));
            if (pass == 0) At[j * 64 + i] = (i > j) ? tab[64 + i] * acc[ib][jb][r] * dec : 0.f;
            else T2[i * 64 + j] = f2bf((i >= j) ? acc[ib][jb][r] * 0.125f * dec : 0.f);
          }
        }
      LWAIT();
    }
#pragma unroll
    for (int it = 0; it < 8; ++it) {
      const int row = it * 8 + crw;
      *(u32x4*)(CQK + (size_t)unit * 4096 + row * 64 + cch * 8) = *(const u32x4*)(T2 + row * 64 + cch * 8);
      *(u32x4*)(T1 + row * 64 + cch * 8) = *(const u32x4*)(kbase + (size_t)row * 64 + cch * 8);
    }
    LWAIT();
#pragma unroll
    for (int it = 0; it < 8; ++it) { const int row = it * 8 + crw; *(u32x4*)(T2 + row * 64 + cch * 8) = *(const u32x4*)(vbase + (size_t)row * 64 + cch * 8); }
    LWAIT();
#pragma unroll 1
    for (int i0 = 0; i0 < 64; i0 += 8) {
      float kd[8];
#pragma unroll
      for (int q = 0; q < 8; ++q) {
        const int i = i0 + q; const float kv = bf2f(T1[i * 64 + c]), gci = tab[i], bi = tab[64 + i];
        kd[q] = kv * __expf(fminf(gl - gci, 0.f));
        XU[i * 64 + c] = bi * bf2f(T2[i * 64 + c]);
        XW[i * 64 + c] = bi * __expf(gci) * kv;
      }
      u32x4 w = {pk2(kd[0], kd[1]), pk2(kd[2], kd[3]), pk2(kd[4], kd[5]), pk2(kd[6], kd[7])};
      *(u32x4*)(CKD + (size_t)unit * 4096 + c * 64 + i0) = w;
    }
    LWAIT();
#pragma unroll 1
    for (int I = 0; I < 4; ++I) {
      const int i0 = 16 * I;
      float xu[16], xw[16];
#pragma unroll
      for (int ii = 0; ii < 16; ++ii) { xu[ii] = XU[(i0 + ii) * 64 + c]; xw[ii] = XW[(i0 + ii) * 64 + c]; }
#pragma unroll 2
      for (int j = 0; j < i0; ++j) {
        const float uj = XU[j * 64 + c], wj = XW[j * 64 + c];
        const f32x4 a0 = *(const f32x4*)(At + j * 64 + i0), a1 = *(const f32x4*)(At + j * 64 + i0 + 4),
                    a2 = *(const f32x4*)(At + j * 64 + i0 + 8), a3 = *(const f32x4*)(At + j * 64 + i0 + 12);
#pragma unroll
        for (int q = 0; q < 4; ++q) {
          xu[q] -= a0[q] * uj; xw[q] -= a0[q] * wj; xu[4 + q] -= a1[q] * uj; xw[4 + q] -= a1[q] * wj;
          xu[8 + q] -= a2[q] * uj; xw[8 + q] -= a2[q] * wj; xu[12 + q] -= a3[q] * uj; xw[12 + q] -= a3[q] * wj;
        }
      }
#pragma unroll
      for (int jj = 0; jj < 15; ++jj) {
        const float* ar = At + (i0 + jj) * 64 + i0;
#pragma unroll
        for (int ii = jj + 1; ii < 16; ++ii) { const float av = ar[ii]; xu[ii] -= av * xu[jj]; xw[ii] -= av * xw[jj]; }
      }
#pragma unroll
      for (int ii = 0; ii < 16; ++ii) { XU[(i0 + ii) * 64 + c] = xu[ii]; XW[(i0 + ii) * 64 + c] = xw[ii]; }
      LWAIT();
    }
#pragma unroll 8
    for (int i = 0; i < 64; ++i) { T2[i * 64 + c] = f2bf(XU[i * 64 + c]); T1[i * 64 + c] = f2bf(XW[i * 64 + c]); }
    LWAIT();
#pragma unroll
    for (int it = 0; it < 8; ++it) {
      const int row = it * 8 + crw;
      *(u32x4*)(CU + (size_t)unit * 4096 + row * 64 + cch * 8) = *(const u32x4*)(T2 + row * 64 + cch * 8);
      *(u32x4*)(CW + (size_t)unit * 4096 + row * 64 + cch * 8) = *(const u32x4*)(T1 + row * 64 + cch * 8);
      const u32x4 qv = *(const u32x4*)(qbase + (size_t)row * 64 + cch * 8);
      const float sc = 0.125f * __expf(tab[row]);
      u32x4 qo = {pk2(bflo(qv.x) * sc, bfhi(qv.x) * sc), pk2(bflo(qv.y) * sc, bfhi(qv.y) * sc), pk2(bflo(qv.z) * sc, bfhi(qv.z) * sc), pk2(bflo(qv.w) * sc, bfhi(qv.w) * sc)};
      *(u32x4*)(CQD + (size_t)unit * 4096 + row * 64 + cch * 8) = qo;
    }
    if (lane == 0) GL[unit] = __expf(gl);
    LWAIT();
  }
#undef LWAIT
}

__device__ __forceinline__ void gdn_chunk_scan(char* smem, const Params& p, int bh) {
  constexpr int TB = 9216, IMG = 5 * TB;
  const int tid = threadIdx.x, wid = tid >> 6, lane = tid & 63, r32 = lane & 31, hi = lane >> 5;
  const int sg = (r32 & ~12) | ((r32 & 4) << 1) | ((r32 & 8) >> 1);
  const int b = bh >> 3, h = bh & 7;
  const bf16_t* SRC[5] = {(const bf16_t*)(p.ws + A_CW), (const bf16_t*)(p.ws + A_CQD), (const bf16_t*)(p.ws + A_CQK), (const bf16_t*)(p.ws + A_CKD), (const bf16_t*)(p.ws + A_CU)};
  const float* GL = (const float*)(p.ws + A_GL);
  bf16_t* GO = (bf16_t*)(p.ws + A_GO);
  const bool loader = wid >= 2;
  const int ltid = tid - 128;
  u32x4 lr[7];
#pragma unroll
  for (int i = 0; i < 7; ++i) lr[i] = (u32x4){0u, 0u, 0u, 0u};
  auto lload = [&](int n) {
    const size_t ub = ((size_t)bh * 256 + n) * 4096;
#pragma unroll
    for (int i = 0; i < 7; ++i) { const int id = ltid + 384 * i;
      if (id < 2560) { const int tile = id >> 9, w = id & 511; const bf16_t* src = tile == 0 ? SRC[0] : tile == 1 ? SRC[1] : tile == 2 ? SRC[2] : tile == 3 ? SRC[3] : SRC[4];
        lr[i] = *(const u32x4*)(src + ub + (w >> 3) * 64 + (w & 7) * 8); } }
  };
  auto lstore = [&](char* img) {
#pragma unroll
    for (int i = 0; i < 7; ++i) { const int id = ltid + 384 * i;
      if (id < 2560) { const int tile = id >> 9, w = id & 511; *(u32x4*)(img + tile * TB + (w >> 3) * 144 + (w & 7) * 16) = lr[i]; } }
  };
  f32x16 S[2]; S[0] = (f32x16){}; S[1] = (f32x16){};
  const int dv = wid * 32 + r32;
  if (loader) { lload(0); lstore(smem); lload(1); }
  __syncthreads();
  float egl = loader ? 0.f : GL[bh * 256];
  for (int n = 0; n < 256; ++n) {
    const char* cur = smem + (n & 1) * IMG; char* nxt = smem + ((n + 1) & 1) * IMG;
    if (loader) {
      if (n + 1 < 256) lstore(nxt);
      if (n + 2 < 256) lload(n + 2);
    } else {
      const float egl_n = egl;
      if (n + 1 < 256) egl = GL[bh * 256 + n + 1];
      const size_t tok0 = (size_t)b * SEQ + (size_t)n * 64;
      bf16x8 sb[4];
#pragma unroll
      for (int ks = 0; ks < 4; ++ks) { const f32x16& q = S[ks >> 1]; const int o = 8 * (ks & 1);
        u32x4 w = {pk2(q[o], q[o + 1]), pk2(q[o + 2], q[o + 3]), pk2(q[o + 4], q[o + 5]), pk2(q[o + 6], q[o + 7])}; sb[ks] = __builtin_bit_cast(bf16x8, w); }
      f32x16 vn[2]; vn[0] = (f32x16){}; vn[1] = (f32x16){};
      f32x16 o[2]; o[0] = (f32x16){}; o[1] = (f32x16){};
#pragma unroll
      for (int tb = 0; tb < 2; ++tb)
#pragma unroll
        for (int ks = 0; ks < 4; ++ks) {
          const bf16x8 wf = *(const bf16x8*)(cur + 0 * TB + (tb * 32 + sg) * 144 + ks * 32 + hi * 16);
          const bf16x8 qf = *(const bf16x8*)(cur + 1 * TB + (tb * 32 + r32) * 144 + ks * 32 + hi * 16);
          vn[tb] = __builtin_amdgcn_mfma_f32_32x32x16_bf16(wf, sb[ks], vn[tb], 0, 0, 0);
          o[tb] = __builtin_amdgcn_mfma_f32_32x32x16_bf16(qf, sb[ks], o[tb], 0, 0, 0);
        }
#pragma unroll
      for (int tb = 0; tb < 2; ++tb)
#pragma unroll
        for (int r = 0; r < 16; ++r) { const int t = tb * 32 + 16 * (r >> 3) + 8 * hi + (r & 7);
          vn[tb][r] = bf2f(*(const bf16_t*)(cur + 4 * TB + t * 144 + dv * 2)) - vn[tb][r]; }
      bf16x8 vb[4];
#pragma unroll
      for (int ks = 0; ks < 4; ++ks) { const f32x16& q = vn[ks >> 1]; const int o8 = 8 * (ks & 1);
        u32x4 w = {pk2(q[o8], q[o8 + 1]), pk2(q[o8 + 2], q[o8 + 3]), pk2(q[o8 + 4], q[o8 + 5]), pk2(q[o8 + 6], q[o8 + 7])}; vb[ks] = __builtin_bit_cast(bf16x8, w); }
#pragma unroll
      for (int r = 0; r < 16; ++r) { S[0][r] *= egl_n; S[1][r] *= egl_n; }
#pragma unroll
      for (int tb = 0; tb < 2; ++tb)
#pragma unroll
        for (int ks = 0; ks < 4; ++ks) {
          const bf16x8 af = *(const bf16x8*)(cur + 2 * TB + (tb * 32 + r32) * 144 + ks * 32 + hi * 16);
          const bf16x8 kf = *(const bf16x8*)(cur + 3 * TB + (tb * 32 + sg) * 144 + ks * 32 + hi * 16);
          o[tb] = __builtin_amdgcn_mfma_f32_32x32x16_bf16(af, vb[ks], o[tb], 0, 0, 0);
          S[tb] = __builtin_amdgcn_mfma_f32_32x32x16_bf16(kf, vb[ks], S[tb], 0, 0, 0);
        }
#pragma unroll
      for (int tb = 0; tb < 2; ++tb)
#pragma unroll
        for (int r = 0; r < 16; ++r) { const int t = tb * 32 + (r & 3) + 8 * (r >> 2) + 4 * hi; GO[(tok0 + t) * 512 + h * 64 + dv] = f2bf(o[tb][r]); }
    }
    LDS_BARRIER();
  }
  __syncthreads();
}

__device__ __forceinline__ void phase_mix0(char* smem, const Params& p, int rep) {
  if (rep == 0 && blockIdx.x < 16) gdn_chunk_scan(smem, p, blockIdx.x);
  __syncthreads();
  unsigned* ctr = (unsigned*)(p.ws + WS_CTL) + rep;
  volatile int* sh = (volatile int*)(smem + CTLW);
  for (;;) {
    if (threadIdx.x == 0) sh[0] = (int)atomicAdd(ctr, 1u);
    __syncthreads();
    const int u = sh[0];
    __syncthreads();
    if (u >= 1024) break;
    attn_unit(smem, p, (u & 15) >> 3, u & 7, 63 - (u >> 4));
  }
}

__device__ __forceinline__ void phase_gdnpost(const Params& p) {
  const int tid = threadIdx.x, wid = tid >> 6, lane = tid & 63;
  const bf16_t* GO = (const bf16_t*)(p.ws + A_GO); const bf16_t* PROJ = (const bf16_t*)(p.ws + A_PROJ);
  bf16_t* MIX = (bf16_t*)(p.ws + WS_H);
  const int sub = lane & 7;
  float gn[8];
#pragma unroll
  for (int e = 0; e < 8; ++e) gn[e] = p.in[9][sub * 8 + e];
  const int gw = blockIdx.x * NW + wid, nw = gridDim.x * NW;
#pragma unroll 2
  for (int row = gw; row < MTOK; row += nw) {
    const u32x4 t = *(const u32x4*)(GO + (size_t)row * 512 + lane * 8);
    const u32x4 z = *(const u32x4*)((const bf16_t*)(p.ws + A_Z) + (size_t)row * 512 + lane * 8);
    float v[8] = {bflo(t.x), bfhi(t.x), bflo(t.y), bfhi(t.y), bflo(t.z), bfhi(t.z), bflo(t.w), bfhi(t.w)};
    float zz[8] = {bflo(z.x), bfhi(z.x), bflo(z.y), bfhi(z.y), bflo(z.z), bfhi(z.z), bflo(z.w), bfhi(z.w)};
    float ss = 0.f;
#pragma unroll
    for (int e = 0; e < 8; ++e) ss += v[e] * v[e];
    ss = group_sum<8>(ss);
    const float r = rsqrtf(ss * (1.f / 64.f) + 1e-6f);
#pragma unroll
    for (int e = 0; e < 8; ++e) v[e] = v[e] * r * gn[e] * siluf_(zz[e]);
    u32x4 w = {pk2(v[0], v[1]), pk2(v[2], v[3]), pk2(v[4], v[5]), pk2(v[6], v[7])};
    *(u32x4*)(MIX + (size_t)row * 1024 + lane * 8) = w;
  }
}

__device__ __forceinline__ void phase_prep1(const Params& p) {
  const int tid = threadIdx.x, wid = tid >> 6, lane = tid & 63;
  bf16_t* WL = (bf16_t*)(p.ws + A_WL); bf16_t* AL = (bf16_t*)(p.ws + A_AL);
  const bf16_t* RKV = (const bf16_t*)(p.ws + A_RKV);
  float* INV = (float*)(p.ws + A_INV); float* SB = (float*)(p.ws + A_SB);
  const int col = lane * 16, h = lane >> 2;
  const int gw = blockIdx.x * NW + wid, nw = gridDim.x * NW;
  float cw0[16], ca0[16], ckk[16], cka[16], crk[16];
#pragma unroll
  for (int e = 0; e < 16; ++e) { cw0[e] = p.in[22][col + e]; ca0[e] = p.in[25][col + e]; ckk[e] = p.in[30][col + e]; cka[e] = p.in[31][col + e]; crk[e] = p.in[32][col + e]; }
#pragma unroll 2
  for (int row = gw; row < MTOK; row += nw) {
    float ssk = 0.f, sb = 0.f;
#pragma unroll
    for (int half = 0; half < 2; ++half) {
      const int c0 = col + half * 8;
      const u32x4 tw = *(const u32x4*)(WL + (size_t)row * 1024 + c0), ta = *(const u32x4*)(AL + (size_t)row * 1024 + c0);
      const u32x4 tr = *(const u32x4*)(RKV + (size_t)row * 3072 + c0), tk = *(const u32x4*)(RKV + (size_t)row * 3072 + 1024 + c0);
      float wl[8] = {bflo(tw.x), bfhi(tw.x), bflo(tw.y), bfhi(tw.y), bflo(tw.z), bfhi(tw.z), bflo(tw.w), bfhi(tw.w)};
      float al[8] = {bflo(ta.x), bfhi(ta.x), bflo(ta.y), bfhi(ta.y), bflo(ta.z), bfhi(ta.z), bflo(ta.w), bfhi(ta.w)};
      float rr[8] = {bflo(tr.x), bfhi(tr.x), bflo(tr.y), bfhi(tr.y), bflo(tr.z), bfhi(tr.z), bflo(tr.w), bfhi(tr.w)};
      float kk[8] = {bflo(tk.x), bfhi(tk.x), bflo(tk.y), bfhi(tk.y), bflo(tk.z), bfhi(tk.z), bflo(tk.w), bfhi(tk.w)};
      float eo[8], ao[8];
#pragma unroll
      for (int e = 0; e < 8; ++e) {
        const int c = c0 + e;
        eo[e] = 0.6065306597126334f * sigmoidf_(cw0[half * 8 + e] + wl[e]);
        const float a = sigmoidf_(ca0[half * 8 + e] + al[e]);
        const unsigned ab = pk2(a, 0.f); const float ar = bflo(ab);
        ao[e] = a;
        const float kkv = kk[e] * ckk[half * 8 + e]; ssk += kkv * kkv;
        const float kp = kk[e] * (1.f + (ar - 1.f) * cka[half * 8 + e]);
        sb += rr[e] * kp * crk[half * 8 + e];
      }
      u32x4 we = {pk2(eo[0], eo[1]), pk2(eo[2], eo[3]), pk2(eo[4], eo[5]), pk2(eo[6], eo[7])};
      u32x4 wa = {pk2(ao[0], ao[1]), pk2(ao[2], ao[3]), pk2(ao[4], ao[5]), pk2(ao[6], ao[7])};
      *(u32x4*)(WL + (size_t)row * 1024 + c0) = we; *(u32x4*)(AL + (size_t)row * 1024 + c0) = wa;
    }
    ssk = group_sum<4>(ssk); sb = group_sum<4>(sb);
    if ((lane & 3) == 0) { INV[(size_t)row * 16 + h] = rsqrtf(ssk + 1e-12f); SB[(size_t)row * 16 + h] = sb; }
  }
}

__device__ __forceinline__ void phase_post1(const Params& p) {
  const int tid = threadIdx.x, wid = tid >> 6, lane = tid & 63;
  const bf16_t* Y = (const bf16_t*)(p.ws + WS_H); const bf16_t* G = (const bf16_t*)(p.ws + A_WL);
  const bf16_t* RKV = (const bf16_t*)(p.ws + A_RKV); const float* SB = (const float*)(p.ws + A_SB);
  bf16_t* YG = (bf16_t*)(p.ws + A_AL);
  const int col = lane * 16, h = lane >> 2;
  const int gw = blockIdx.x * NW + wid, nw = gridDim.x * NW;
  float lng[16], lnb[16];
#pragma unroll
  for (int e = 0; e < 16; ++e) { lng[e] = p.in[33][col + e]; lnb[e] = p.in[34][col + e]; }
#pragma unroll 2
  for (int row = gw; row < MTOK; row += nw) {
    float y[16]; float sm = 0.f;
#pragma unroll
    for (int half = 0; half < 2; ++half) {
      const u32x4 t = *(const u32x4*)(Y + (size_t)row * 1024 + col + half * 8);
      float* d = y + half * 8;
      d[0] = bflo(t.x); d[1] = bfhi(t.x); d[2] = bflo(t.y); d[3] = bfhi(t.y); d[4] = bflo(t.z); d[5] = bfhi(t.z); d[6] = bflo(t.w); d[7] = bfhi(t.w);
    }
#pragma unroll
    for (int e = 0; e < 16; ++e) sm += y[e];
    sm = group_sum<4>(sm);
    const float mean = sm * (1.f / 64.f);
    float vs = 0.f;
#pragma unroll
    for (int e = 0; e < 16; ++e) { const float dlt = y[e] - mean; vs += dlt * dlt; }
    vs = group_sum<4>(vs);
    const float rstd = rsqrtf(vs * (1.f / 64.f) + 64e-5f);
    const float sb = SB[(size_t)row * 16 + h];
#pragma unroll
    for (int half = 0; half < 2; ++half) {
      const int c0 = col + half * 8;
      const u32x4 tv = *(const u32x4*)(RKV + (size_t)row * 3072 + 2048 + c0), tg = *(const u32x4*)(G + (size_t)row * 1024 + c0);
      float vv[8] = {bflo(tv.x), bfhi(tv.x), bflo(tv.y), bfhi(tv.y), bflo(tv.z), bfhi(tv.z), bflo(tv.w), bfhi(tv.w)};
      float gg[8] = {bflo(tg.x), bfhi(tg.x), bflo(tg.y), bfhi(tg.y), bflo(tg.z), bfhi(tg.z), bflo(tg.w), bfhi(tg.w)};
      float o[8];
#pragma unroll
      for (int e = 0; e < 8; ++e) { const int c = c0 + e; o[e] = ((y[half * 8 + e] - mean) * rstd * lng[half * 8 + e] + lnb[half * 8 + e] + sb * vv[e]) * gg[e]; }
      u32x4 w = {pk2(o[0], o[1]), pk2(o[2], o[3]), pk2(o[4], o[5]), pk2(o[6], o[7])};
      *(u32x4*)(YG + (size_t)row * 1024 + c0) = w;
    }
  }
}

constexpr int NPHASE = 22;
__device__ __forceinline__ void run_phase(int ph, char* smem, const Params& p, int rep = 0) {
  bf16_t* WT = (bf16_t*)(p.ws + WS_WT);
  bf16_t* H = (bf16_t*)(p.ws + WS_H);
  const float* MOD = (const float*)(p.ws + WS_MOD);
  switch (ONLY >= 0 ? ONLY : ph) {
    case 0: phase_prologue(smem, p); break;
    case 1: phase_adaln<0>(p, p.in[0], 0, 0, H); break;
    case 2: gemm_phase(smem, H, 1024, WT + W_IN, 1024, MTOK, 2560, 1024, EpiStore{(bf16_t*)(p.ws + A_PROJ), PROJ_LD}); break;
    case 3: phase_prep0(p); break;
    case 4: gemm_phase(smem, (const bf16_t*)(p.ws + A_QLAT), 256, WT + W_UQ, 256, MTOK, 768, 256, EpiStore{(bf16_t*)((char*)p.out + O_QH), 768}); break;
    case 5: gemm_phase(smem, (const bf16_t*)(p.ws + A_KVLAT), 128, WT + W_UKV, 128, MTOK, 1024, 128, EpiKV{(bf16_t*)(p.ws + A_KN), (bf16_t*)((char*)p.out + O_VT)}); break;
    case 6: phase_qkrope(p); phase_gdnchunk(smem, p); break;
    case 7: phase_mix0(smem, p, rep); break;
    case 8: phase_gdnpost(p); break;
    case 9: gemm_phase(smem, H, 1024, WT + W_OUT, 1024, MTOK, 1024, 1024, EpiResid{p.in[0], p.out, MOD + 2048}); break;
    case 10: phase_adaln<0>(p, p.out, 0, 1, H); break;
    case 11: gemm_phase(smem, H, 1024, WT + W_UP0, 1024, MTOK, 4096, 1024, EpiUp{(bf16_t*)(p.ws + A_U)}); break;
    case 12: gemm_phase(smem, (const bf16_t*)(p.ws + A_U), 4096, WT + W_DN0, 4096, MTOK, 1024, 4096, EpiResid{p.out, p.out, MOD + 5120}); break;
    case 13: phase_adaln<1>(p, p.out, 1, 0, (bf16_t*)(p.ws + A_A2)); break;
    case 14: gemm_phase(smem, (const bf16_t*)(p.ws + A_A2), 2048, WT + W_RKV, 2048, MTOK, 3584, 2048, EpiRkv{(bf16_t*)(p.ws + A_RKV), (bf16_t*)(p.ws + A_LORA)}); break;
    case 15: gemm_phase(smem, (const bf16_t*)(p.ws + A_LORA), 384, WT + W_W2, 128, MTOK, 1024, 128, EpiStore{(bf16_t*)(p.ws + A_WL), 1024}); break;
    case 16: gemm_phase(smem, (const bf16_t*)(p.ws + A_LORA) + 64, 384, WT + W_A2, 128, MTOK, 1024, 128, EpiStore{(bf16_t*)(p.ws + A_AL), 1024}); break;
    case 17: phase_prep1(p); break;
    case 18: if (blockIdx.x < 256) { const int i = blockIdx.x, x = i & 7, sl = i >> 3; scan_unit<1>(smem, p, ((x * 4 + (sl >> 3)) << 3) | (sl & 7)); } break;
    case 19: gemm_phase(smem, (const bf16_t*)(p.ws + A_LORA) + 128, 384, WT + W_G2, 256, MTOK, 1024, 256, EpiStore{(bf16_t*)(p.ws + A_WL), 1024}); break;
    case 20: phase_post1(p); break;
    case 21: gemm_phase(smem, (const bf16_t*)(p.ws + A_AL), 1024, WT + W_O, 1024, MTOK, 1024, 1024, EpiResid{p.out, p.out, MOD + 2 * 6144 + 2048}); break;
    case 22: phase_adaln<0>(p, p.out, 1, 1, H); break;
    case 23: gemm_phase(smem, H, 1024, WT + W_UP1, 1024, MTOK, 4096, 1024, EpiUp{(bf16_t*)(p.ws + A_U)}); break;
    case 24: gemm_phase(smem, (const bf16_t*)(p.ws + A_U), 4096, WT + W_DN1, 4096, MTOK, 1024, 4096, EpiResid{p.out, p.out, MOD + 2 * 6144 + 5120}); break;
  }
}

__device__ __forceinline__ constexpr bool sync_after(int ph) { return !(ph == 4 || ph == 15); }
__device__ __forceinline__ void grid_barrier(const Params& p, unsigned& nbar) {
  __syncthreads();
  if (threadIdx.x == 0) {
    unsigned* ctr = (unsigned*)(p.ws + WS_CTL) + 32;
    nbar += gridDim.x;
    __builtin_amdgcn_fence(__ATOMIC_RELEASE, "agent");
    __hip_atomic_fetch_add(ctr, 1u, __ATOMIC_RELAXED, __HIP_MEMORY_SCOPE_AGENT);
    while (__hip_atomic_load(ctr, __ATOMIC_RELAXED, __HIP_MEMORY_SCOPE_AGENT) < nbar) __builtin_amdgcn_s_sleep(2);
    __builtin_amdgcn_fence(__ATOMIC_ACQUIRE, "agent");
  }
  __syncthreads();
}
template <int PH> __device__ __forceinline__ void do_phase(char* smem, const Params& p, int lo, int hi, unsigned& nbar) {
  if (lo <= PH && PH < hi) {
    if ((PROBE_MASK >> PH) & 1u) { run_phase(PH, smem, p, 1); grid_barrier(p, nbar); }
    run_phase(PH, smem, p);
    if (PH + 1 < hi && sync_after(PH)) { if (PH == 0) { __syncthreads(); cg::this_grid().sync(); } else grid_barrier(p, nbar); } else __syncthreads();
  }
}
__global__ void __launch_bounds__(NT, 2) fwd_kernel(Params p, int lo, int hi) {
  extern __shared__ __attribute__((aligned(16))) char smem[];
  unsigned nbar = 0u;
  do_phase<0>(smem, p, lo, hi, nbar); do_phase<1>(smem, p, lo, hi, nbar); do_phase<2>(smem, p, lo, hi, nbar); do_phase<3>(smem, p, lo, hi, nbar); do_phase<4>(smem, p, lo, hi, nbar); do_phase<5>(smem, p, lo, hi, nbar); do_phase<6>(smem, p, lo, hi, nbar); do_phase<7>(smem, p, lo, hi, nbar); do_phase<8>(smem, p, lo, hi, nbar); do_phase<9>(smem, p, lo, hi, nbar); do_phase<10>(smem, p, lo, hi, nbar); do_phase<11>(smem, p, lo, hi, nbar); do_phase<12>(smem, p, lo, hi, nbar); do_phase<13>(smem, p, lo, hi, nbar); do_phase<14>(smem, p, lo, hi, nbar); do_phase<15>(smem, p, lo, hi, nbar); do_phase<16>(smem, p, lo, hi, nbar); do_phase<17>(smem, p, lo, hi, nbar); do_phase<18>(smem, p, lo, hi, nbar); do_phase<19>(smem, p, lo, hi, nbar); do_phase<20>(smem, p, lo, hi, nbar); do_phase<21>(smem, p, lo, hi, nbar); do_phase<22>(smem, p, lo, hi, nbar); do_phase<23>(smem, p, lo, hi, nbar); do_phase<24>(smem, p, lo, hi, nbar);
}

extern "C" void kernel_launch(void* const* d_in, const int* in_sizes, int n_in, void* d_out, int out_size, void* d_ws, size_t ws_size, hipStream_t stream) {
  constexpr size_t kDynLds = CTLW + 256 + 4096;
  static int grid_blocks = 0;
  if (!grid_blocks) {
    int dev = 0, cus = 0, per_cu = 0;
    hipGetDevice(&dev);
    hipDeviceGetAttribute(&cus, hipDeviceAttributeMultiprocessorCount, dev);
    hipFuncSetAttribute((const void*)fwd_kernel, hipFuncAttributeMaxDynamicSharedMemorySize, (int)kDynLds);
    hipOccupancyMaxActiveBlocksPerMultiprocessor(&per_cu, fwd_kernel, NT, kDynLds);
    if (per_cu > 1) per_cu = 1;
    if (per_cu < 1) per_cu = 1;
    grid_blocks = cus * per_cu;
  }
  if (ws_size < WS_NEED) { fprintf(stderr, "workspace too small: %zu\n", ws_size); return; }
  Params p{};
  for (int i = 0; i < 37; ++i) p.in[i] = (const float*)d_in[i];
  p.out = (float*)d_out; p.ws = (char*)d_ws;
  constexpr int NPH = 25;
  (void)hipMemsetAsync((char*)d_ws + WS_CTL, 0, 256, stream);
#if COOP
  int lo = 0, hi = NPH;
  void* args[] = {&p, &lo, &hi};
  hipError_t e = hipLaunchCooperativeKernel((void*)fwd_kernel, dim3(grid_blocks), dim3(NT), args, kDynLds, stream);
  if (e != hipSuccess) fprintf(stderr, "cooperative launch failed: %s (grid %d)\n", hipGetErrorString(e), grid_blocks);
#else
  for (int ph = 0; ph < NPH; ++ph) fwd_kernel<<<grid_blocks, NT, kDynLds, stream>>>(p, ph, ph + 1);
#endif
}
```

```cpp
#include <hip/hip_runtime.h>
#include <hip/hip_cooperative_groups.h>
#include <cstdint>
#include <cstdio>
namespace cg = cooperative_groups;

#ifndef ONLY
#define ONLY -1
#endif
#ifndef PROBE_MASK
#define PROBE_MASK 0u
#endif
#ifndef COOP
#define COOP 1
#endif

typedef unsigned short bf16_t;
typedef short bf16x8 __attribute__((ext_vector_type(8)));
typedef float f32x4 __attribute__((ext_vector_type(4)));
typedef float f32x2 __attribute__((ext_vector_type(2)));
typedef float f32x16 __attribute__((ext_vector_type(16)));
typedef unsigned u32x4 __attribute__((ext_vector_type(4)));
typedef unsigned u32x2 __attribute__((ext_vector_type(2)));
typedef __bf16 bf16x2_t __attribute__((ext_vector_type(2)));

constexpr int NW = 8, NT = NW * 64, CTLW = 131072;
constexpr int SEQ = 16384, NBATCH = 2, MTOK = NBATCH * SEQ, DM = 1024, DFF = 4096;
constexpr int PROJ_LD = 2560;
constexpr size_t MiB = 1u << 20;
constexpr size_t WS_CTL = 0;
constexpr size_t WS_MOD = 64 * 1024;
constexpr size_t WS_WT = 1 * MiB;
constexpr size_t WS_H = 64 * MiB;
constexpr size_t WS_AR = 128 * MiB;
constexpr size_t W_IN = 0;
constexpr size_t W_UQ = W_IN + (size_t)2560 * 1024;
constexpr size_t W_UKV = W_UQ + (size_t)768 * 256;
constexpr size_t W_OUT = W_UKV + (size_t)1024 * 128;
constexpr size_t W_RKV = W_OUT + (size_t)1024 * 1024;
constexpr size_t W_W2 = W_RKV + (size_t)3584 * 2048;
constexpr size_t W_A2 = W_W2 + (size_t)1024 * 128;
constexpr size_t W_G2 = W_A2 + (size_t)1024 * 128;
constexpr size_t W_O = W_G2 + (size_t)1024 * 256;
constexpr size_t W_UP0 = W_O + (size_t)1024 * 1024;
constexpr size_t W_UP1 = W_UP0 + (size_t)4096 * 1024;
constexpr size_t W_DN0 = W_UP1 + (size_t)4096 * 1024;
constexpr size_t W_DN1 = W_DN0 + (size_t)4096 * 1024;
constexpr size_t W_END = W_DN1 + (size_t)4096 * 1024;
static_assert(W_END * 2 <= 63 * MiB, "weights fit");
constexpr size_t A_PROJ = WS_AR;
constexpr size_t A_GQ = WS_AR + 160 * MiB;
constexpr size_t A_GK = A_GQ + 32 * MiB;
constexpr size_t A_GV = A_GK + 32 * MiB;
constexpr size_t A_KN = WS_AR + 256 * MiB;
constexpr size_t A_QLAT = WS_AR + 320 * MiB;
constexpr size_t A_KVLAT = WS_AR + 336 * MiB;
constexpr size_t A_GA = WS_AR + 344 * MiB;
constexpr size_t A_GB = WS_AR + 345 * MiB;
constexpr size_t A_GO = WS_AR + 346 * MiB;
constexpr size_t A_Z = WS_AR + 288 * MiB;
constexpr size_t A_KR = WS_AR + 378 * MiB;
constexpr size_t A_GL = WS_AR + 380 * MiB;
constexpr size_t A_GG = WS_AR + 381 * MiB;
constexpr size_t A_CW = WS_AR + 0 * MiB, A_CU = WS_AR + 32 * MiB, A_CQK = WS_AR + 64 * MiB, A_CKD = WS_AR + 96 * MiB, A_CQD = WS_AR + 128 * MiB;
constexpr size_t O_QH = 0;
constexpr size_t O_KH = 48 * MiB;
constexpr size_t O_VT = 96 * MiB;
constexpr size_t A_U = WS_AR;
constexpr size_t A_A2 = WS_AR;
constexpr size_t A_WL = WS_AR;
constexpr size_t A_AL = WS_AR + 64 * MiB;
constexpr size_t A_RKV = WS_AR + 128 * MiB;
constexpr size_t A_LORA = WS_AR + 320 * MiB;
constexpr size_t A_INV = WS_AR + 344 * MiB;
constexpr size_t A_SB = WS_AR + 346 * MiB;
constexpr size_t WS_NEED = 512 * MiB;

struct Params { const float* in[37]; float* out; char* ws; };

__device__ __forceinline__ float bf2f(bf16_t h) { return __uint_as_float(((unsigned)h) << 16); }
__device__ __forceinline__ float bflo(unsigned u) { return __uint_as_float(u << 16); }
__device__ __forceinline__ float bfhi(unsigned u) { return __uint_as_float(u & 0xffff0000u); }
__device__ __forceinline__ unsigned pk2(float lo, float hi) { f32x2 v = {lo, hi}; bf16x2_t b = __builtin_convertvector(v, bf16x2_t); return __builtin_bit_cast(unsigned, b); }
__device__ __forceinline__ bf16_t f2bf(float f) { return (bf16_t)(pk2(f, 0.f) & 0xffffu); }
__device__ __forceinline__ float wave_sum(float v) {
#pragma unroll
  for (int o = 32; o; o >>= 1) v += __shfl_xor(v, o);
  return v;
}
template <int W> __device__ __forceinline__ float group_sum(float v) {
#pragma unroll
  for (int o = W / 2; o; o >>= 1) v += __shfl_xor(v, o);
  return v;
}
__device__ __forceinline__ float sigmoidf_(float x) { return 1.f / (1.f + __expf(-x)); }
__device__ __forceinline__ float siluf_(float x) { return x / (1.f + __expf(-x)); }
__device__ __forceinline__ float softplusf_(float x) { return x > 20.f ? x : log1pf(expf(x)); }
__device__ __forceinline__ float softplus_fast(float x) {
  const float e = __expf(x);
  const float small = e * (1.f - e * (0.5f - e * (0.33333334f - 0.25f * e)));
  return x > 15.f ? x : (e < 0.02f ? small : __logf(1.f + e));
}
__device__ __forceinline__ float tanh_fast(float x) { const float t = __expf(-2.f * fabsf(x)); const float r = (1.f - t) / (1.f + t); return x < 0.f ? -r : r; }
#define LDS_BARRIER() do { asm volatile("s_waitcnt lgkmcnt(0)" ::: "memory"); __builtin_amdgcn_s_barrier(); asm volatile("" ::: "memory"); } while (0)
template <int CTRL> __device__ __forceinline__ float dpp_add(float x) {
  return x + __int_as_float(__builtin_amdgcn_update_dpp(0, __float_as_int(x), CTRL, 0xf, 0xf, false));
}
__device__ __forceinline__ float row16_sum(float x) {
  x = dpp_add<0x128>(x); x = dpp_add<0x124>(x); x = dpp_add<0x122>(x); x = dpp_add<0x121>(x);
  return x;
}

__device__ __forceinline__ void conv_job(char* smem, const float* __restrict__ src, int K, int N, bf16_t* dst, int ldd, int koff, int Kp, int Np,
                         const float* mu, int mode, int& tbase) {
  const int half = threadIdx.x >> 8, tid = threadIdx.x & 255;
  bf16_t* tile = (bf16_t*)smem + half * (64 * 72);
  const int VG = gridDim.x * 2, vb = blockIdx.x * 2 + half;
  const int tk = Kp / 64, tn = Np / 64, nt = tk * tn;
  const int first = (vb - (tbase % VG) + VG) % VG;
  for (int base = 0; base < nt; base += VG) {
    const int t = base + first;
    const bool act = t < nt;
    const int k0 = (t % tk) * 64, n0 = (t / tk) * 64;
    const int nl = tid & 63, kq = tid >> 6;
    if (act) {
#pragma unroll 4
      for (int i = 0; i < 16; ++i) {
        const int kl = kq + 4 * i, k = k0 + kl, n = n0 + nl;
        float v = 0.f;
        if (k < K && n < N) { v = src[(size_t)k * N + n]; if (mode == 1) v *= mu[k]; else if (mode == 2) v *= (1.f - mu[k]); }
        tile[nl * 72 + kl] = f2bf(v);
      }
    }
    __syncthreads();
    if (act) {
      const int n = tid >> 2, seg = (tid & 3) * 16;
      const u32x4 a = *(const u32x4*)(tile + n * 72 + seg), b = *(const u32x4*)(tile + n * 72 + seg + 8);
      bf16_t* d = dst + (size_t)(n0 + n) * ldd + koff + k0 + seg;
      *(u32x4*)d = a; *(u32x4*)(d + 8) = b;
    }
    __syncthreads();
  }
  tbase += nt;
}

__device__ __forceinline__ void phase_prologue(char* smem, const Params& p) {
  const int tid = threadIdx.x, wid = tid >> 6, lane = tid & 63;
  if (blockIdx.x == 0 && tid < 64) ((unsigned*)(p.ws + WS_CTL))[tid] = 0u;
  {
    float* sc = (float*)smem;
    float* red = sc + 2048;
    const float* c = p.in[1];
    for (int i = tid; i < 2048; i += NT) sc[i] = siluf_(c[i]);
    __syncthreads();
    float* MOD = (float*)(p.ws + WS_MOD);
    for (int item = blockIdx.x; item < 192; item += gridDim.x) {
      const int l = item / 96, jg = item % 96, col = jg * 64 + lane;
      const float* w = p.in[3] + (size_t)l * 1024 * 6144 + col;
      float a0 = 0.f, a1 = 0.f;
      const int kb = wid * 128;
#pragma unroll 8
      for (int k = 0; k < 128; ++k) { const float wv = w[(size_t)(kb + k) * 6144]; a0 += sc[kb + k] * wv; a1 += sc[1024 + kb + k] * wv; }
      red[(wid * 2 + 0) * 64 + lane] = a0; red[(wid * 2 + 1) * 64 + lane] = a1;
      __syncthreads();
      if (wid < 2) {
        float s = 0.f;
#pragma unroll
        for (int ww = 0; ww < NW; ++ww) s += red[(ww * 2 + wid) * 64 + lane];
        MOD[(size_t)(l * 2 + wid) * 6144 + col] = s + p.in[4][l * 6144 + col];
      }
      __syncthreads();
    }
    __syncthreads();
  }
  bf16_t* WT = (bf16_t*)(p.ws + WS_WT);
  const float* mu = p.in[17];
  int tb = 0;
  for (int job = 0; job < 24; ++job) {
    const float* src; int K, N; bf16_t* dst; int ldd, koff, Kp, Np; const float* mup; int mode;
    switch (job) {
      case 0: src = p.in[5]; K = 1024; N = 2480; dst = WT + W_IN; ldd = 1024; koff = 0; Kp = 1024; Np = 2560; mup = nullptr; mode = 0; break;
      case 1: src = p.in[12]; K = 256; N = 768; dst = WT + W_UQ; ldd = 256; koff = 0; Kp = 256; Np = 768; mup = nullptr; mode = 0; break;
      case 2: src = p.in[13]; K = 128; N = 1024; dst = WT + W_UKV; ldd = 128; koff = 0; Kp = 128; Np = 1024; mup = nullptr; mode = 0; break;
      case 3: src = p.in[16]; K = 1024; N = 1024; dst = WT + W_OUT; ldd = 1024; koff = 0; Kp = 1024; Np = 1024; mup = nullptr; mode = 0; break;
      case 4: src = p.in[18]; K = 1024; N = 1024; dst = WT + W_RKV + (size_t)0 * 2048; ldd = 2048; koff = 0; Kp = 1024; Np = 1024; mup = mu + 0 * 1024; mode = 2; break;
      case 5: src = p.in[18]; K = 1024; N = 1024; dst = WT + W_RKV + (size_t)0 * 2048; ldd = 2048; koff = 1024; Kp = 1024; Np = 1024; mup = mu + 0 * 1024; mode = 1; break;
      case 6: src = p.in[19]; K = 1024; N = 1024; dst = WT + W_RKV + (size_t)1024 * 2048; ldd = 2048; koff = 0; Kp = 1024; Np = 1024; mup = mu + 2 * 1024; mode = 2; break;
      case 7: src = p.in[19]; K = 1024; N = 1024; dst = WT + W_RKV + (size_t)1024 * 2048; ldd = 2048; koff = 1024; Kp = 1024; Np = 1024; mup = mu + 2 * 1024; mode = 1; break;
      case 8: src = p.in[20]; K = 1024; N = 1024; dst = WT + W_RKV + (size_t)2048 * 2048; ldd = 2048; koff = 0; Kp = 1024; Np = 1024; mup = mu + 3 * 1024; mode = 2; break;
      case 9: src = p.in[20]; K = 1024; N = 1024; dst = WT + W_RKV + (size_t)2048 * 2048; ldd = 2048; koff = 1024; Kp = 1024; Np = 1024; mup = mu + 3 * 1024; mode = 1; break;
      case 10: src = p.in[23]; K = 1024; N = 64; dst = WT + W_RKV + (size_t)3072 * 2048; ldd = 2048; koff = 0; Kp = 1024; Np = 64; mup = mu + 1 * 1024; mode = 2; break;
      case 11: src = p.in[23]; K = 1024; N = 64; dst = WT + W_RKV + (size_t)3072 * 2048; ldd = 2048; koff = 1024; Kp = 1024; Np = 64; mup = mu + 1 * 1024; mode = 1; break;
      case 12: src = p.in[26]; K = 1024; N = 64; dst = WT + W_RKV + (size_t)3136 * 2048; ldd = 2048; koff = 0; Kp = 1024; Np = 64; mup = mu + 4 * 1024; mode = 2; break;
      case 13: src = p.in[26]; K = 1024; N = 64; dst = WT + W_RKV + (size_t)3136 * 2048; ldd = 2048; koff = 1024; Kp = 1024; Np = 64; mup = mu + 4 * 1024; mode = 1; break;
      case 14: src = p.in[28]; K = 1024; N = 160; dst = WT + W_RKV + (size_t)3200 * 2048; ldd = 2048; koff = 0; Kp = 1024; Np = 384; mup = mu + 5 * 1024; mode = 2; break;
      case 15: src = p.in[28]; K = 1024; N = 160; dst = WT + W_RKV + (size_t)3200 * 2048; ldd = 2048; koff = 1024; Kp = 1024; Np = 384; mup = mu + 5 * 1024; mode = 1; break;
      case 16: src = p.in[24]; K = 64; N = 1024; dst = WT + W_W2; ldd = 128; koff = 0; Kp = 128; Np = 1024; mup = nullptr; mode = 0; break;
      case 17: src = p.in[27]; K = 64; N = 1024; dst = WT + W_A2; ldd = 128; koff = 0; Kp = 128; Np = 1024; mup = nullptr; mode = 0; break;
      case 18: src = p.in[29]; K = 160; N = 1024; dst = WT + W_G2; ldd = 256; koff = 0; Kp = 256; Np = 1024; mup = nullptr; mode = 0; break;
      case 19: src = p.in[21]; K = 1024; N = 1024; dst = WT + W_O; ldd = 1024; koff = 0; Kp = 1024; Np = 1024; mup = nullptr; mode = 0; break;
      case 20: src = p.in[35]; K = 1024; N = 4096; dst = WT + W_UP0; ldd = 1024; koff = 0; Kp = 1024; Np = 4096; mup = nullptr; mode = 0; break;
      case 21: src = p.in[35] + (size_t)1024 * 4096; K = 1024; N = 4096; dst = WT + W_UP1; ldd = 1024; koff = 0; Kp = 1024; Np = 4096; mup = nullptr; mode = 0; break;
      case 22: src = p.in[36]; K = 4096; N = 1024; dst = WT + W_DN0; ldd = 4096; koff = 0; Kp = 4096; Np = 1024; mup = nullptr; mode = 0; break;
      default: src = p.in[36] + (size_t)4096 * 1024; K = 4096; N = 1024; dst = WT + W_DN1; ldd = 4096; koff = 0; Kp = 4096; Np = 1024; mup = nullptr; mode = 0; break;
    }
    conv_job(smem, src, K, N, dst, ldd, koff, Kp, Np, mup, mode, tb);
  }
}

template <int MODE> __device__ __forceinline__ void phase_adaln(const Params& p, const float* src, int layer, int which, bf16_t* dst) {
  const int tid = threadIdx.x, wid = tid >> 6, lane = tid & 63;
  const float* MOD = (const float*)(p.ws + WS_MOD);
  const int gw = blockIdx.x * NW + wid, nw = gridDim.x * NW;
  for (int row0 = gw; row0 < MTOK; row0 += 4 * nw) {
    f32x4 v[4][4];
#pragma unroll
    for (int u = 0; u < 4; ++u) {
      const int rowc = (row0 + u * nw < MTOK) ? row0 + u * nw : MTOK - 1;
      const float* xr = src + (size_t)rowc * DM;
#pragma unroll
      for (int i = 0; i < 4; ++i) v[u][i] = *(const f32x4*)(xr + i * 256 + lane * 4);
    }
#pragma unroll
    for (int u = 0; u < 4; ++u) {
      const int row = row0 + u * nw;
      if (row < MTOK) {
        const int b = row >> 14, s = row & (SEQ - 1);
        const float* shift = MOD + (size_t)(layer * 2 + b) * 6144 + which * 3072;
        const float* scale = shift + 1024;
        float ss = 0.f;
#pragma unroll
        for (int i = 0; i < 4; ++i) ss += v[u][i][0] * v[u][i][0] + v[u][i][1] * v[u][i][1] + v[u][i][2] * v[u][i][2] + v[u][i][3] * v[u][i][3];
        ss = wave_sum(ss);
        const float r = rsqrtf(ss * (1.f / 1024.f) + 1e-6f);
#pragma unroll
        for (int i = 0; i < 4; ++i) {
          const int col = i * 256 + lane * 4;
          const f32x4 sc = *(const f32x4*)(scale + col), sh = *(const f32x4*)(shift + col);
          u32x2 w;
          w.x = pk2(v[u][i][0] * r * (1.f + sc[0]) + sh[0], v[u][i][1] * r * (1.f + sc[1]) + sh[1]);
          w.y = pk2(v[u][i][2] * r * (1.f + sc[2]) + sh[2], v[u][i][3] * r * (1.f + sc[3]) + sh[3]);
          if (MODE == 0) { *(u32x2*)(dst + (size_t)row * 1024 + col) = w; }
          else {
            *(u32x2*)(dst + (size_t)row * 2048 + col) = w;
            if (s + 1 < SEQ) *(u32x2*)(dst + (size_t)(row + 1) * 2048 + 1024 + col) = w;
            if (s == 0) { u32x2 z = {0u, 0u}; *(u32x2*)(dst + (size_t)row * 2048 + 1024 + col) = z; }
          }
        }
      }
    }
  }
}

struct EpiStore { bf16_t* C; int ldc;
  __device__ __forceinline__ void operator()(int row, int col, f32x4 v) const { u32x2 w = {pk2(v[0], v[1]), pk2(v[2], v[3])}; *(u32x2*)(C + (size_t)row * ldc + col) = w; } };
struct EpiKV { bf16_t* KN; bf16_t* Vt;
  __device__ __forceinline__ void operator()(int row, int col, f32x4 v) const {
    const int h = col >> 7, c = col & 127;
    if (c < 64) { u32x2 w = {pk2(v[0], v[1]), pk2(v[2], v[3])}; *(u32x2*)(KN + (size_t)row * 512 + h * 64 + c) = w; }
    else { const int b = row >> 14, s = row & (SEQ - 1); bf16_t* d = Vt + ((size_t)((b * 8 + h) * 64 + (c - 64))) * SEQ + s;
#pragma unroll
      for (int j = 0; j < 4; ++j) d[(size_t)j * SEQ] = f2bf(v[j]); }
  } };
struct EpiResid { const float* base; float* out; const float* gate;
  __device__ __forceinline__ void operator()(int row, int col, f32x4 v) const {
    const int b = row >> 14; const f32x4 g = *(const f32x4*)(gate + (size_t)b * 6144 + col);
    const f32x4 x = *(const f32x4*)(base + (size_t)row * DM + col);
    *(f32x4*)(out + (size_t)row * DM + col) = x + g * v; } };
struct EpiUp { bf16_t* U;
  __device__ __forceinline__ void operator()(int row, int col, f32x4 v) const {
    f32x4 r;
#pragma unroll
    for (int j = 0; j < 4; ++j) { const float t = v[j] > 0.f ? v[j] : 0.f; r[j] = t * t; }
    u32x2 w = {pk2(r[0], r[1]), pk2(r[2], r[3])}; *(u32x2*)(U + (size_t)row * DFF + col) = w; } };
struct EpiRkv { bf16_t* RKV; bf16_t* LORA;
  __device__ __forceinline__ void operator()(int row, int col, f32x4 v) const {
    if (col < 3072) { u32x2 w = {pk2(v[0], v[1]), pk2(v[2], v[3])}; *(u32x2*)(RKV + (size_t)row * 3072 + col) = w; }
    else { const int c = col - 3072; f32x4 r;
      if (c < 64) { for (int j = 0; j < 4; ++j) r[j] = tanh_fast(v[j]); }
      else if (c < 128) r = v;
      else if (c < 288) { for (int j = 0; j < 4; ++j) r[j] = sigmoidf_(v[j]); }
      else r = (f32x4){0.f, 0.f, 0.f, 0.f};
      if (c < 384) { u32x2 w = {pk2(r[0], r[1]), pk2(r[2], r[3])}; *(u32x2*)(LORA + (size_t)row * 384 + c) = w; } }
  } };

namespace pg8 {
#define PG8_LAS __attribute__((address_space(3)))
typedef unsigned short bf16_t;
typedef short bf16x8 __attribute__((ext_vector_type(8)));
typedef float f32x4 __attribute__((ext_vector_type(4)));
typedef unsigned u32x4 __attribute__((ext_vector_type(4)));
constexpr int BM = 256, BK = 64, HALF = 128, HTB = HALF * BK * 2  , STAGE_BYTES = 8 * HTB, NXCD = 8, WGM = 8;

__host__ __device__ __forceinline__ int lds_byte(int r, int c) { const int st = (r >> 4) * 2 + (c >> 5), rr = r & 15, cc = c & 31, ob = rr * 64 + cc * 2; return st * 1024 + (ob ^ (((ob >> 9) & 1) << 5)); }
__host__ __device__ __forceinline__ void stage_rc(int b, int& R, int& C) { const int st = b / 1024, sb = b % 1024, swz = sb ^ (((sb >> 9) & 1) << 5); R = (st >> 1) * 16 + swz / 64; C = (st & 1) * 32 + (swz % 64) / 2; }
__host__ __device__ __forceinline__ int perm32(int rho) { const int n = rho >> 4, i = rho & 15; return 8 * (i >> 2) + 4 * n + (i & 3); }

struct Unit { int pm, pn; };
struct Gemm { const bf16_t* A; const bf16_t* Bt; int M, N, K, lda; };

struct StaticOrder {
    int nM, nN, nwg, G, c;
    __host__ __device__ void init(int M, int N, int G_, int c_) { nM = M / BM; nN = N / BM; nwg = nM * nN; G = G_; c = c_; }
    __host__ __device__ bool next(int i, Unit& u) const {
        const long L = (long)i * G + c; if (L >= nwg) return false;
        int wgid = (int)L; { const int q = nwg / NXCD, r = nwg % NXCD, xcd = wgid % NXCD, off = wgid / NXCD; wgid = (xcd < r ? xcd * (q + 1) : r * (q + 1) + (xcd - r) * q) + off; }
        const int nig = WGM * nN, gid = wgid / nig, fm = gid * WGM, gsz = (nM - fm) < WGM ? (nM - fm) : WGM;
        u.pm = fm + ((wgid % nig) % gsz); u.pn = (wgid % nig) / gsz; return true;
    }
    __device__ __forceinline__ void a_ready(const Unit&) const {}
    __device__ __forceinline__ void done(const Unit&) const {}
};


template <class Epi, class Sched, bool ALIGN_EPI = false, bool SP2 = false>
__device__ __forceinline__ void gemm_phase(PG8_LAS unsigned char* lds, const Gemm g, const Sched& S, const Epi& E) {
    const int tid = threadIdx.x, wid = __builtin_amdgcn_readfirstlane(tid >> 6), lane = tid & 63, wr = wid >> 2, wc = wid & 3, fr = lane & 15, fq = lane >> 4;
    const int K = g.K, nt = K / BK;
    unsigned voffA[2], voffB[2];
#pragma unroll
    for (int i = 0; i < 2; ++i) { int R, C; stage_rc(tid * 16 + i * 8192, R, C); const int Rb = Epi::PERM ? ((R & ~31) + perm32(R & 31)) : R;
        voffA[i] = (unsigned)(R * g.lda + C) * 2u; voffB[i] = (unsigned)(Rb * K + C) * 2u; }
    const size_t kstep = (size_t)(BK * 2);
    const size_t hstepA = (size_t)HALF * g.lda * 2, hstepB = (size_t)HALF * K * 2;
    const size_t tstepA = 2 * hstepA, tstepB = 2 * hstepB;
    const unsigned ldsw = (unsigned)wid * 1024u;
    const int aoff = lds_byte(wr * 64 + fr, fq * 8), boff = lds_byte(wc * 32 + fr, fq * 8);
#define PG8_SA(b, h) (((b) * 2 + (h)) * HTB)
#define PG8_SB(b, h) ((4 + (b) * 2 + (h)) * HTB)
#define PG8_STAGE(bufoff, gbase, voff) do { _Pragma("unroll") for (int _i = 0; _i < 2; ++_i) \
        __builtin_amdgcn_global_load_lds((const unsigned*)((const char*)(gbase) + (voff)[_i]), (PG8_LAS unsigned*)(lds + (bufoff) + ldsw + _i * 8192), 16, 0, 0); } while (0)
#define PG8_LDA(dst, b, h) do { _Pragma("unroll") for (int m = 0; m < 4; ++m) _Pragma("unroll") for (int k = 0; k < 2; ++k) dst[m][k] = *(const PG8_LAS bf16x8*)(lds + PG8_SA(b, h) + aoff + m * 2048 + k * 1024); } while (0)
#define PG8_LDB(dst, b, h) do { _Pragma("unroll") for (int n = 0; n < 2; ++n) _Pragma("unroll") for (int k = 0; k < 2; ++k) dst[n][k] = *(const PG8_LAS bf16x8*)(lds + PG8_SB(b, h) + boff + n * 2048 + k * 1024); } while (0)
#define PG8_MMA(ai, bj, At, Bt) do { __builtin_amdgcn_s_setprio(1); _Pragma("unroll") for (int m = 0; m < 4; ++m) _Pragma("unroll") for (int n = 0; n < 2; ++n) _Pragma("unroll") for (int k = 0; k < 2; ++k) \
        acc[ai][bj][m][n] = __builtin_amdgcn_mfma_f32_16x16x32_bf16(Bt[n][k], At[m][k], acc[ai][bj][m][n], 0, 0, 0); __builtin_amdgcn_s_setprio(0); } while (0)
#define PG8_WAIT_V(n) asm volatile("s_waitcnt vmcnt(" #n ")" ::: "memory")
#define PG8_WAIT_L(n) asm volatile("s_waitcnt lgkmcnt(" #n ")" ::: "memory")
#define PG8_BAR __builtin_amdgcn_s_barrier()
#define PG8_SCHED __builtin_amdgcn_sched_barrier(0)
    Unit cur, nxt; int ui = 0;
    if (!S.next(0, cur)) return;
    f32x4 acc[2][2][4][2];
#pragma unroll
    for (int a = 0; a < 2; ++a)
#pragma unroll
        for (int b = 0; b < 2; ++b)
#pragma unroll
            for (int m = 0; m < 4; ++m)
#pragma unroll
                for (int n = 0; n < 2; ++n) acc[a][b][m][n] = (f32x4){0.f, 0.f, 0.f, 0.f};
    bf16x8 At[4][2], B0[2][2], B1[2][2];
    const char* cA = (const char*)g.A + (size_t)cur.pm * tstepA; const char* cB = (const char*)g.Bt + (size_t)cur.pn * tstepB;
    S.a_ready(cur);
    if constexpr (SP2) {
        PG8_STAGE(PG8_SB(0, 0), cB, voffB); PG8_STAGE(PG8_SB(0, 1), cB + hstepB, voffB); PG8_STAGE(PG8_SA(0, 0), cA, voffA); PG8_STAGE(PG8_SA(0, 1), cA + hstepA, voffA);
        if (wr == 1) PG8_BAR;
        PG8_WAIT_V(2); PG8_BAR;
        PG8_STAGE(PG8_SB(1, 0), cB + kstep, voffB); PG8_STAGE(PG8_SA(1, 0), cA + kstep, voffA); PG8_STAGE(PG8_SB(1, 1), cB + hstepB + kstep, voffB);
        PG8_WAIT_V(6); PG8_BAR;
    } else {
        PG8_STAGE(PG8_SB(0, 0), cB, voffB); PG8_STAGE(PG8_SA(0, 0), cA, voffA); PG8_STAGE(PG8_SB(0, 1), cB + hstepB, voffB); PG8_STAGE(PG8_SA(0, 1), cA + hstepA, voffA);
        if (wr == 1) PG8_BAR;
        PG8_WAIT_V(4); PG8_BAR;
        PG8_STAGE(PG8_SB(1, 0), cB + kstep, voffB); PG8_STAGE(PG8_SA(1, 0), cA + kstep, voffA); PG8_STAGE(PG8_SB(1, 1), cB + hstepB + kstep, voffB);
        PG8_WAIT_V(6); PG8_BAR;
    }
    for (;;) {
        const bool has_next = S.next(ui + 1, nxt);
        const char* nA = has_next ? (const char*)g.A + (size_t)nxt.pm * tstepA : cA; const char* nB = has_next ? (const char*)g.Bt + (size_t)nxt.pn * tstepB : cB;
#pragma unroll 1
        for (int t = 0; t < nt; t += 2) {
            const bool last = (t == nt - 2);
            const char* a1 = cA + (size_t)(t + 1) * kstep;
            const char* a2 = last ? nA : cA + (size_t)(t + 2) * kstep; const char* b2 = last ? nB : cB + (size_t)(t + 2) * kstep;
            const char* a3 = a2 + kstep; const char* b3 = b2 + kstep;
            if (last && has_next) S.a_ready(nxt);
            if constexpr (SP2) {
            PG8_LDB(B0, 0, 0); PG8_LDB(B1, 0, 1); PG8_SCHED; PG8_LDA(At, 0, 0); PG8_STAGE(PG8_SA(1, 1), a1 + hstepA, voffA);
            PG8_WAIT_V(8); PG8_WAIT_L(0); PG8_BAR; PG8_MMA(0, 0, At, B0); PG8_MMA(0, 1, At, B1); PG8_BAR; PG8_SCHED;
            PG8_LDA(At, 0, 1); PG8_STAGE(PG8_SB(0, 0), b2, voffB); PG8_STAGE(PG8_SB(0, 1), b2 + hstepB, voffB); PG8_STAGE(PG8_SA(0, 0), a2, voffA);
            PG8_WAIT_V(8); PG8_WAIT_L(0); PG8_BAR; PG8_MMA(1, 0, At, B0); PG8_MMA(1, 1, At, B1); PG8_BAR; PG8_SCHED;
            PG8_LDB(B0, 1, 0); PG8_LDB(B1, 1, 1); PG8_SCHED; PG8_LDA(At, 1, 0); PG8_STAGE(PG8_SA(0, 1), a2 + hstepA, voffA);
            PG8_WAIT_V(8); PG8_WAIT_L(0); PG8_BAR; PG8_MMA(0, 0, At, B0); PG8_MMA(0, 1, At, B1); PG8_BAR; PG8_SCHED;
            PG8_LDA(At, 1, 1); PG8_STAGE(PG8_SB(1, 0), b3, voffB); PG8_STAGE(PG8_SB(1, 1), b3 + hstepB, voffB); PG8_STAGE(PG8_SA(1, 0), a3, voffA);
            PG8_WAIT_V(8); PG8_WAIT_L(0); PG8_BAR; PG8_MMA(1, 0, At, B0); PG8_MMA(1, 1, At, B1); PG8_BAR; PG8_SCHED;
            } else {
            PG8_LDB(B0, 0, 0); PG8_SCHED; PG8_LDA(At, 0, 0); PG8_STAGE(PG8_SA(1, 1), a1 + hstepA, voffA);
            PG8_WAIT_L(8); PG8_BAR; PG8_WAIT_L(0); PG8_MMA(0, 0, At, B0); PG8_BAR; PG8_SCHED;
            PG8_LDB(B1, 0, 1); PG8_STAGE(PG8_SB(0, 0), b2, voffB);
            PG8_BAR; PG8_WAIT_L(0); PG8_MMA(0, 1, At, B1); PG8_BAR;
            PG8_LDA(At, 0, 1); PG8_STAGE(PG8_SA(0, 0), a2, voffA);
            PG8_BAR; PG8_WAIT_L(0); PG8_MMA(1, 0, At, B0); PG8_BAR; PG8_SCHED;
            PG8_STAGE(PG8_SB(0, 1), b2 + hstepB, voffB);
            PG8_WAIT_V(6); PG8_BAR; PG8_MMA(1, 1, At, B1); PG8_BAR;
            PG8_LDB(B0, 1, 0); PG8_SCHED; PG8_LDA(At, 1, 0); PG8_STAGE(PG8_SA(0, 1), a2 + hstepA, voffA);
            PG8_WAIT_L(8); PG8_BAR; PG8_WAIT_L(0); PG8_MMA(0, 0, At, B0); PG8_BAR; PG8_SCHED;
            PG8_LDB(B1, 1, 1); PG8_STAGE(PG8_SB(1, 0), b3, voffB);
            PG8_BAR; PG8_WAIT_L(0); PG8_MMA(0, 1, At, B1); PG8_BAR;
            PG8_LDA(At, 1, 1); PG8_STAGE(PG8_SA(1, 0), a3, voffA);
            PG8_BAR; PG8_WAIT_L(0); PG8_MMA(1, 0, At, B0); PG8_BAR; PG8_SCHED;
            PG8_STAGE(PG8_SB(1, 1), b3 + hstepB, voffB);
            PG8_WAIT_V(6); PG8_BAR; PG8_MMA(1, 1, At, B1); PG8_BAR;
            }
        }
        if constexpr (ALIGN_EPI) { if (wr == 0) PG8_BAR; }
        if constexpr (!Epi::AFTER_DRAIN) { E(acc, cur, wr, wc, fr, fq); S.done(cur); }
        if (!has_next) break;
#pragma unroll
        for (int a = 0; a < 2; ++a)
#pragma unroll
            for (int b = 0; b < 2; ++b)
#pragma unroll
                for (int m = 0; m < 4; ++m)
#pragma unroll
                    for (int n = 0; n < 2; ++n) acc[a][b][m][n] = (f32x4){0.f, 0.f, 0.f, 0.f};
        cur = nxt; cA = nA; cB = nB; ++ui;
        if constexpr (ALIGN_EPI) { if (wr == 1) PG8_BAR; }
    }
    PG8_WAIT_V(0);
    if constexpr (!ALIGN_EPI) { if (wr == 0) PG8_BAR; }
    PG8_BAR;
    if constexpr (Epi::AFTER_DRAIN) { E.fused(acc, cur, wr, wc, fr, fq, lds, wid, lane); S.done(cur); }
#undef PG8_SA
#undef PG8_SB
#undef PG8_STAGE
#undef PG8_LDA
#undef PG8_LDB
#undef PG8_MMA
#undef PG8_WAIT_V
#undef PG8_WAIT_L
#undef PG8_BAR
#undef PG8_SCHED
}
}


template <class F> struct EpiAdapt {
  static constexpr bool PERM = false, AFTER_DRAIN = false; F f;
  __device__ __forceinline__ void operator()(const pg8::f32x4 (&acc)[2][2][4][2], const pg8::Unit& u, int wr, int wc, int fr, int fq) const {
#pragma unroll
    for (int ai = 0; ai < 2; ++ai)
#pragma unroll
      for (int m = 0; m < 4; ++m) { const int row = u.pm * 256 + 128 * ai + 64 * wr + 16 * m + fr;
#pragma unroll
        for (int bj = 0; bj < 2; ++bj)
#pragma unroll
          for (int n = 0; n < 2; ++n) f(row, u.pn * 256 + 128 * bj + 32 * wc + 16 * n + 4 * fq, acc[ai][bj][m][n]); }
  }
};
template <class F>
__device__ __forceinline__ void gemm_phase(char* smem, const bf16_t* A, int lda, const bf16_t* Bt, int ldb, int M, int N, int K, const F f) {
  (void)ldb;
  asm volatile("" : "+s"(K));
  pg8::Gemm g{A, Bt, M, N, K, lda}; pg8::StaticOrder S; S.init(M, N, (int)gridDim.x, (int)blockIdx.x);
  EpiAdapt<F> E{f};
  pg8::gemm_phase<EpiAdapt<F>, pg8::StaticOrder, true, true>((PG8_LAS unsigned char*)smem, g, S, E);
  __syncthreads();
}

__device__ __forceinline__ void phase_prep0(const Params& p) {
  const int tid = threadIdx.x, wid = tid >> 6, lane = tid & 63;
  const bf16_t* PROJ = (const bf16_t*)(p.ws + A_PROJ);
  bf16_t* GQKV[3] = {(bf16_t*)(p.ws + A_GQ), (bf16_t*)(p.ws + A_GK), (bf16_t*)(p.ws + A_GV)};
  float* GA = (float*)(p.ws + A_GA); float* GB = (float*)(p.ws + A_GB);
  bf16_t* QLAT = (bf16_t*)(p.ws + A_QLAT); bf16_t* KVLAT = (bf16_t*)(p.ws + A_KVLAT);
  const float* cw = p.in[6];
  const int gw = blockIdx.x * NW + wid, nw = gridDim.x * NW;
  const float gA = expf(p.in[7][lane & 7]), gdt = p.in[8][lane & 7];
#pragma unroll 2
  for (int row = gw; row < MTOK; row += nw) {
    const int s = row & (SEQ - 1);
    const bf16_t* pr = PROJ + (size_t)row * PROJ_LD;
#pragma unroll
    for (int part = 0; part < 3; ++part) {
      const int col = part * 512 + lane * 8;
      float acc[8];
#pragma unroll
      for (int e = 0; e < 8; ++e) acc[e] = 0.f;
#pragma unroll
      for (int j = 0; j < 4; ++j) {
        const int ds = 3 - j;
        if (s - ds >= 0) {
          const u32x4 t = *(const u32x4*)(pr - (size_t)ds * PROJ_LD + col);
          const f32x4 w0 = *(const f32x4*)(cw + j * 1536 + col), w1 = *(const f32x4*)(cw + j * 1536 + col + 4);
          acc[0] += w0[0] * bflo(t.x); acc[1] += w0[1] * bfhi(t.x); acc[2] += w0[2] * bflo(t.y); acc[3] += w0[3] * bfhi(t.y);
          acc[4] += w1[0] * bflo(t.z); acc[5] += w1[1] * bfhi(t.z); acc[6] += w1[2] * bflo(t.w); acc[7] += w1[3] * bfhi(t.w);
        }
      }
      float ss = 0.f;
#pragma unroll
      for (int e = 0; e < 8; ++e) { acc[e] = siluf_(acc[e]); ss += acc[e] * acc[e]; }
      if (part < 2) {
        ss = group_sum<8>(ss);
        const float r = rsqrtf(ss + 1e-12f);
#pragma unroll
        for (int e = 0; e < 8; ++e) acc[e] *= r;
      }
      u32x4 w = {pk2(acc[0], acc[1]), pk2(acc[2], acc[3]), pk2(acc[4], acc[5]), pk2(acc[6], acc[7])};
      *(u32x4*)(GQKV[part] + ((size_t)((row >> 14) * 8 + (lane >> 3)) * SEQ + s) * 64 + (lane & 7) * 8) = w;
    }
    if (lane < 8) {
      const float a = bf2f(pr[2048 + lane]), bb = bf2f(pr[2056 + lane]);
      const float g = -gA * softplus_fast(a + gdt);
      GA[(size_t)row * 8 + lane] = __expf(g);
      ((float*)(p.ws + A_GG))[(size_t)row * 8 + lane] = g;
      GB[(size_t)row * 8 + lane] = sigmoidf_(bb);
    }
    {
      *(u32x4*)((bf16_t*)(p.ws + A_Z) + (size_t)row * 512 + lane * 8) = *(const u32x4*)(pr + 1536 + lane * 8);
      if (lane < 16) *(unsigned*)((bf16_t*)(p.ws + A_KR) + (size_t)row * 32 + lane * 2) = *(const unsigned*)(pr + 2448 + lane * 2);
    }
    {
      const u32x2 t = *(const u32x2*)(pr + 2064 + lane * 4);
      float v0 = bflo(t.x), v1 = bfhi(t.x), v2 = bflo(t.y), v3 = bfhi(t.y);
      float ss = wave_sum(v0 * v0 + v1 * v1 + v2 * v2 + v3 * v3);
      const float r = rsqrtf(ss * (1.f / 256.f) + 1e-6f);
      const f32x4 g = *(const f32x4*)(p.in[10] + lane * 4);
      u32x2 w = {pk2(v0 * r * g[0], v1 * r * g[1]), pk2(v2 * r * g[2], v3 * r * g[3])};
      *(u32x2*)(QLAT + (size_t)row * 256 + lane * 4) = w;
    }
    {
      const unsigned t = *(const unsigned*)(pr + 2320 + lane * 2);
      float v0 = bflo(t), v1 = bfhi(t);
      float ss = wave_sum(v0 * v0 + v1 * v1);
      const float r = rsqrtf(ss * (1.f / 128.f) + 1e-6f);
      const f32x2 g = *(const f32x2*)(p.in[11] + lane * 2);
      *(unsigned*)(KVLAT + (size_t)row * 128 + lane * 2) = pk2(v0 * r * g[0], v1 * r * g[1]);
    }
  }
}

__device__ __forceinline__ void phase_qkrope(const Params& p) {
  const int tid = threadIdx.x, wid = tid >> 6, lane = tid & 63;
  const int h = lane >> 3, sub = lane & 7;
  bf16_t* QH = (bf16_t*)((char*)p.out + O_QH); bf16_t* KH = (bf16_t*)((char*)p.out + O_KH);
  const bf16_t* KN = (const bf16_t*)(p.ws + A_KN); const bf16_t* PROJ = (const bf16_t*)(p.ws + A_PROJ);
  const int* pos = (const int*)p.in[2];
  const float* qg = p.in[14]; const float* kg = p.in[15];
  float qgn[8], kgn[8], qg1[2], qg2[2], kg1[2], kg2[2];
#pragma unroll
  for (int e = 0; e < 8; ++e) { qgn[e] = qg[sub * 8 + e]; kgn[e] = kg[sub * 8 + e]; }
#pragma unroll
  for (int e = 0; e < 2; ++e) { qg1[e] = qg[64 + 2 * sub + e]; qg2[e] = qg[80 + 2 * sub + e]; kg1[e] = kg[64 + 2 * sub + e]; kg2[e] = kg[80 + 2 * sub + e]; }
  float invf[2];
#pragma unroll
  for (int e = 0; e < 2; ++e) invf[e] = powf(10000.0f, -(float)(2 * (2 * sub + e)) / 32.0f);
  const float qscale = 0.10206207261596577f * 1.4426950408889634f;
  const int gw = blockIdx.x * NW + wid, nw = gridDim.x * NW;
#pragma unroll 2
  for (int row = gw; row < MTOK; row += nw) {
    const float fp = (float)pos[row];
    float cs[2], sn[2];
#pragma unroll
    for (int e = 0; e < 2; ++e) {
      const float ang = fp * invf[e];
      const double rev = (double)ang * 0.15915494309189535;
      const float fr = (float)(rev - rint(rev));
      sn[e] = __builtin_amdgcn_sinf(fr); cs[e] = __builtin_amdgcn_cosf(fr);
    }
    {
      bf16_t* q = QH + (size_t)row * 768 + h * 96;
      const u32x4 t = *(const u32x4*)(q + sub * 8);
      const unsigned t1 = *(const unsigned*)(q + 64 + 2 * sub), t2 = *(const unsigned*)(q + 80 + 2 * sub);
      float v[8] = {bflo(t.x), bfhi(t.x), bflo(t.y), bfhi(t.y), bflo(t.z), bfhi(t.z), bflo(t.w), bfhi(t.w)};
      float x1[2] = {bflo(t1), bfhi(t1)}, x2[2] = {bflo(t2), bfhi(t2)};
      float ss = x1[0] * x1[0] + x1[1] * x1[1] + x2[0] * x2[0] + x2[1] * x2[1];
#pragma unroll
      for (int e = 0; e < 8; ++e) ss += v[e] * v[e];
      ss = group_sum<8>(ss);
      const float r = rsqrtf(ss * (1.f / 96.f) + 1e-6f) * qscale;
#pragma unroll
      for (int e = 0; e < 8; ++e) v[e] *= r * qgn[e];
      float o1[2], o2[2];
#pragma unroll
      for (int e = 0; e < 2; ++e) { const float a = x1[e] * r * qg1[e], b = x2[e] * r * qg2[e]; o1[e] = a * cs[e] - b * sn[e]; o2[e] = b * cs[e] + a * sn[e]; }
      u32x4 w = {pk2(v[0], v[1]), pk2(v[2], v[3]), pk2(v[4], v[5]), pk2(v[6], v[7])};
      *(u32x4*)(q + sub * 8) = w; *(unsigned*)(q + 64 + 2 * sub) = pk2(o1[0], o1[1]); *(unsigned*)(q + 80 + 2 * sub) = pk2(o2[0], o2[1]);
    }
    {
      const bf16_t* kn = KN + (size_t)row * 512 + h * 64; const bf16_t* kr = (const bf16_t*)(p.ws + A_KR) + (size_t)row * 32;
      bf16_t* k = KH + (size_t)row * 768 + h * 96;
      const u32x4 t = *(const u32x4*)(kn + sub * 8);
      const unsigned t1 = *(const unsigned*)(kr + 2 * sub), t2 = *(const unsigned*)(kr + 16 + 2 * sub);
      float v[8] = {bflo(t.x), bfhi(t.x), bflo(t.y), bfhi(t.y), bflo(t.z), bfhi(t.z), bflo(t.w), bfhi(t.w)};
      float x1[2] = {bflo(t1), bfhi(t1)}, x2[2] = {bflo(t2), bfhi(t2)};
      float ss = x1[0] * x1[0] + x1[1] * x1[1] + x2[0] * x2[0] + x2[1] * x2[1];
#pragma unroll
      for (int e = 0; e < 8; ++e) ss += v[e] * v[e];
      ss = group_sum<8>(ss);
      const float r = rsqrtf(ss * (1.f / 96.f) + 1e-6f);
#pragma unroll
      for (int e = 0; e < 8; ++e) v[e] *= r * kgn[e];
      float o1[2], o2[2];
#pragma unroll
      for (int e = 0; e < 2; ++e) { const float a = x1[e] * r * kg1[e], b = x2[e] * r * kg2[e]; o1[e] = a * cs[e] - b * sn[e]; o2[e] = b * cs[e] + a * sn[e]; }
      u32x4 w = {pk2(v[0], v[1]), pk2(v[2], v[3]), pk2(v[4], v[5]), pk2(v[6], v[7])};
      *(u32x4*)(k + sub * 8) = w; *(unsigned*)(k + 64 + 2 * sub) = pk2(o1[0], o1[1]); *(unsigned*)(k + 80 + 2 * sub) = pk2(o2[0], o2[1]);
    }
  }
}

__device__ __forceinline__ float row32_sum(float x) {
  x = row16_sum(x);
  auto rr = __builtin_amdgcn_permlane32_swap(__float_as_uint(x), __float_as_uint(x), false, false);
  return __uint_as_float(rr[0]) + __uint_as_float(rr[1]);
}
template <int MODE> __device__ __forceinline__ void scan_unit(char* smem, const Params& p, int unit) {
  constexpr int T = 16, STEPF = 328, NH = MODE == 0 ? 8 : 16;
  const bool producer = threadIdx.x >= 256;
  const int tid = threadIdx.x & 255, rowl = (tid >> 6) * 2 + ((tid >> 4) & 1), j = (tid & 15) + ((tid >> 5) & 1) * 16;
  const int st = tid >> 4, sj = tid & 15;
  const int bh = unit >> 3, row0 = (unit & 7) * 8;
  const int b = bh / NH, h = bh % NH;
  float* buf = (float*)smem;
  const bf16_t* GQ = (const bf16_t*)(p.ws + A_GQ); const bf16_t* GK = (const bf16_t*)(p.ws + A_GK); const bf16_t* GV = (const bf16_t*)(p.ws + A_GV);
  const float* GA = (const float*)(p.ws + A_GA); const float* GB = (const float*)(p.ws + A_GB);
  bf16_t* GO = (bf16_t*)(p.ws + A_GO);
  const bf16_t* RKV = (const bf16_t*)(p.ws + A_RKV); const bf16_t* EE = (const bf16_t*)(p.ws + A_WL); const bf16_t* AA = (const bf16_t*)(p.ws + A_AL);
  const float* INV = (const float*)(p.ws + A_INV);
  bf16_t* Y = (bf16_t*)(p.ws + WS_H);
  f32x4 ckk = {0.f, 0.f, 0.f, 0.f}, cka = {0.f, 0.f, 0.f, 0.f};
  if (MODE == 1) { ckk = *(const f32x4*)(p.in[30] + h * 64 + 4 * sj); cka = *(const f32x4*)(p.in[31] + h * 64 + 4 * sj); }
  u32x2 g0, g1, g2, g3; float gs0 = 0.f, gs1 = 0.f; bf16_t gv = 0;
  auto gload = [&](int chunk) {
    const size_t tok = (size_t)b * SEQ + (size_t)chunk * T + st;
    if (MODE == 0) {
      g0 = *(const u32x2*)(GQ + tok * 512 + h * 64 + 4 * sj); g1 = *(const u32x2*)(GK + tok * 512 + h * 64 + 4 * sj);
      gs0 = GA[tok * 8 + h]; gs1 = GB[tok * 8 + h]; if (sj < 8) gv = GV[tok * 512 + h * 64 + row0 + sj];
    } else {
      g0 = *(const u32x2*)(RKV + tok * 3072 + h * 64 + 4 * sj); g1 = *(const u32x2*)(RKV + tok * 3072 + 1024 + h * 64 + 4 * sj);
      g2 = *(const u32x2*)(EE + tok * 1024 + h * 64 + 4 * sj); g3 = *(const u32x2*)(AA + tok * 1024 + h * 64 + 4 * sj);
      gs0 = INV[tok * 16 + h]; if (sj < 8) gv = RKV[tok * 3072 + 2048 + h * 64 + row0 + sj];
    }
  };
  auto gstore = [&](float* dst) {
    float* d = dst + st * STEPF;
    f32x4 r, w, k, a, bb; float v;
    if (MODE == 0) {
      const f32x4 q = {bflo(g0.x), bfhi(g0.x), bflo(g0.y), bfhi(g0.y)};
      k = (f32x4){bflo(g1.x), bfhi(g1.x), bflo(g1.y), bfhi(g1.y)};
      const float al = gs0, be = gs1;
      r = q * 0.125f; w = (f32x4){al, al, al, al}; a = k * (-al * be); bb = k; v = be * bf2f(gv);
    } else {
      r = (f32x4){bflo(g0.x), bfhi(g0.x), bflo(g0.y), bfhi(g0.y)};
      const f32x4 k0 = {bflo(g1.x), bfhi(g1.x), bflo(g1.y), bfhi(g1.y)};
      const f32x4 e = {bflo(g2.x), bfhi(g2.x), bflo(g2.y), bfhi(g2.y)};
      const f32x4 av = {bflo(g3.x), bfhi(g3.x), bflo(g3.y), bfhi(g3.y)};
      const f32x4 kk = k0 * ckk * gs0;
      a = -kk; bb = kk * av; k = k0 * (1.f + (av - 1.f) * cka);
      w = (f32x4){__expf(-e[0]), __expf(-e[1]), __expf(-e[2]), __expf(-e[3])};
      v = bf2f(gv);
    }
    *(f32x4*)(d + 4 * sj) = r; *(f32x4*)(d + 64 + 4 * sj) = w; *(f32x4*)(d + 128 + 4 * sj) = k; *(f32x4*)(d + 192 + 4 * sj) = a; *(f32x4*)(d + 256 + 4 * sj) = bb;
    if (sj < 8) d[320 + sj] = v;
  };
  f32x2 s = {0.f, 0.f};
  constexpr int NCH = SEQ / T;
  if (producer) { gload(0); gstore(buf); gload(1); }
  __syncthreads();
  for (int c = 0; c < NCH; ++c) {
    const float* cur = buf + (c & 1) * (T * STEPF);
    float* nxt = buf + ((c + 1) & 1) * (T * STEPF);
    if (producer) {
      if (c + 1 < NCH) gstore(nxt);
      if (c + 2 < NCH) gload(c + 2);
    } else {
    float yp[T];
    f32x2 r = *(const f32x2*)(cur + 2 * j), w = *(const f32x2*)(cur + 64 + 2 * j), k = *(const f32x2*)(cur + 128 + 2 * j),
          a = *(const f32x2*)(cur + 192 + 2 * j), bb = *(const f32x2*)(cur + 256 + 2 * j);
    float v = cur[320 + rowl];
#pragma unroll
    for (int t = 0; t < T; ++t) {
      f32x2 nr = r, nw = w, nk = k, na = a, nb = bb; float nv = v;
      if (t + 1 < T) {
        const float* d = cur + (t + 1) * STEPF;
        nr = *(const f32x2*)(d + 2 * j); nw = *(const f32x2*)(d + 64 + 2 * j); nk = *(const f32x2*)(d + 128 + 2 * j);
        na = *(const f32x2*)(d + 192 + 2 * j); nb = *(const f32x2*)(d + 256 + 2 * j); nv = d[320 + rowl];
      }
      float pa = s[0] * a[0] + s[1] * a[1];
      const f32x2 tkw = s * w + k * v;
      pa = row32_sum(pa);
      s = tkw + bb * pa;
      yp[t] = s[0] * r[0] + s[1] * r[1];
      r = nr; w = nw; k = nk; a = na; bb = nb; v = nv;
    }
    {
      float z[8];
#pragma unroll
      for (int i = 0; i < 8; ++i) { auto rr = __builtin_amdgcn_permlane32_swap(__float_as_uint(yp[i]), __float_as_uint(yp[i + 8]), false, false);
        z[i] = __uint_as_float(rr[0]) + __uint_as_float(rr[1]); }
      const int ln = threadIdx.x & 63;
      const bool b3 = (ln & 8) != 0, b2 = (ln & 4) != 0, b1 = (ln & 2) != 0;
      float n4[4], n2[2];
#pragma unroll
      for (int i = 0; i < 4; ++i) { const float wv = b3 ? z[i + 4] : z[i], ov = b3 ? z[i] : z[i + 4];
        n4[i] = wv + __int_as_float(__builtin_amdgcn_update_dpp(0, __float_as_int(ov), 0x140, 0xf, 0xf, false)); }
#pragma unroll
      for (int i = 0; i < 2; ++i) { const float wv = b2 ? n4[i + 2] : n4[i], ov = b2 ? n4[i] : n4[i + 2];
        n2[i] = wv + __int_as_float(__builtin_amdgcn_update_dpp(0, __float_as_int(ov), 0x141, 0xf, 0xf, false)); }
      const float wv = b1 ? n2[1] : n2[0], ov = b1 ? n2[0] : n2[1];
      const float n1 = wv + __int_as_float(__builtin_amdgcn_update_dpp(0, __float_as_int(ov), 0x1B, 0xf, 0xf, false));
      const float yt = n1 + __int_as_float(__builtin_amdgcn_update_dpp(0, __float_as_int(n1), 0xB1, 0xf, 0xf, false));
      if ((ln & 1) == 0) {
        const int t = 8 * (ln >> 5) + ((ln >> 1) & 7);
        const size_t tok = (size_t)b * SEQ + (size_t)c * T + t;
        if (MODE == 0) GO[tok * 512 + h * 64 + row0 + rowl] = f2bf(yt);
        else Y[tok * 1024 + h * 64 + row0 + rowl] = f2bf(yt);
      }
    }
    }
    LDS_BARRIER();
  }
  __syncthreads();
}

__device__ __forceinline__ void attn_unit(char* smem, const Params& p, int b, int h, int qb) {
  const int tid = threadIdx.x, wid = tid >> 6, lane = tid & 63, r32 = lane & 31, hi = lane >> 5;
  const bf16_t* QH = (const bf16_t*)((const char*)p.out + O_QH); const bf16_t* KH = (const bf16_t*)((const char*)p.out + O_KH);
  const bf16_t* VT = (const bf16_t*)((const char*)p.out + O_VT);
  bf16_t* MIX = (bf16_t*)(p.ws + WS_H);
  const int q0 = qb * 256, qrow = q0 + wid * 32 + r32;
  const size_t tokq = (size_t)b * SEQ + qrow;
  bf16x8 qr[6];
#pragma unroll
  for (int ks = 0; ks < 6; ++ks) qr[ks] = *(const bf16x8*)(QH + tokq * 768 + h * 96 + ks * 16 + hi * 8);
  f32x16 o0 = {}, o1 = {};
  float m = -1e30f, l = 0.f;
  const int ntiles = (q0 + 256) / 64;
  const bf16_t* Kg = KH + ((size_t)b * SEQ) * 768 + h * 96;
  const bf16_t* Vg = VT + ((size_t)(b * 8 + h) * 64) * SEQ;
  int krow[2], kc[2];
#pragma unroll
  for (int i = 0; i < 2; ++i) { const int id = tid + 512 * i; krow[i] = id / 12; kc[i] = id % 12; }
  const bool k2 = tid < 256;
  const int vrow = tid >> 3, vc = tid & 7;
  u32x4 rk[2], rv;
  rk[1] = (u32x4){0u, 0u, 0u, 0u};
  constexpr int STG = 22528, KSZ = 13312;
  auto gload = [&](int t) {
    const int kv0 = t * 64;
    rk[0] = *(const u32x4*)(Kg + (size_t)(kv0 + krow[0]) * 768 + kc[0] * 8);
    if (k2) rk[1] = *(const u32x4*)(Kg + (size_t)(kv0 + krow[1]) * 768 + kc[1] * 8);
    rv = *(const u32x4*)(Vg + (size_t)vrow * SEQ + kv0 + vc * 8);
  };
  auto sstore = [&](char* st) {
    *(u32x4*)(st + krow[0] * 208 + kc[0] * 16) = rk[0];
    if (k2) *(u32x4*)(st + krow[1] * 208 + kc[1] * 16) = rk[1];
    { char* d = st + KSZ + vrow * 144 + (vc >> 1) * 32 + (vc & 1) * 8;
      *(u32x2*)d = (u32x2){rv.x, rv.y}; *(u32x2*)(d + 16) = (u32x2){rv.z, rv.w}; }
  };
  gload(0); sstore(smem);
  __syncthreads();
  for (int t = 0; t < ntiles; ++t) {
    char* cur = smem + (t & 1) * STG; char* nxt = smem + ((t + 1) & 1) * STG;
    const bool more = t + 1 < ntiles;
    if (more) gload(t + 1);
    const int kv0 = t * 64;
    const int wq0 = q0 + wid * 32;
    if (kv0 <= wq0 + 31) {
      f32x16 s0 = {}, s1 = {};
#pragma unroll
      for (int ks = 0; ks < 6; ++ks) {
        const bf16x8 k0 = *(const bf16x8*)(cur + r32 * 208 + ks * 32 + hi * 16);
        const bf16x8 k1 = *(const bf16x8*)(cur + (32 + r32) * 208 + ks * 32 + hi * 16);
        s0 = __builtin_amdgcn_mfma_f32_32x32x16_bf16(k0, qr[ks], s0, 0, 0, 0);
        s1 = __builtin_amdgcn_mfma_f32_32x32x16_bf16(k1, qr[ks], s1, 0, 0, 0);
      }
      if (kv0 + 63 > wq0) {
#pragma unroll
        for (int r = 0; r < 16; ++r) { const int kv = kv0 + (r & 3) + 8 * (r >> 2) + 4 * hi; if (kv > qrow) s0[r] = -INFINITY; if (kv + 32 > qrow) s1[r] = -INFINITY; }
      }
      float mx = fmaxf(s0[0], s1[0]);
#pragma unroll
      for (int r = 1; r < 16; ++r) mx = fmaxf(mx, fmaxf(s0[r], s1[r]));
      { auto rr = __builtin_amdgcn_permlane32_swap(__float_as_uint(mx), __float_as_uint(mx), false, false); mx = fmaxf(__uint_as_float(rr[0]), __uint_as_float(rr[1])); }
      const float mn = fmaxf(m, mx);
      if (__any(mn > m)) {
        const float f = __builtin_amdgcn_exp2f(m - mn);
        m = mn; l *= f;
#pragma unroll
        for (int r = 0; r < 16; ++r) { o0[r] *= f; o1[r] *= f; }
      }
      float ps = 0.f;
#pragma unroll
      for (int r = 0; r < 16; ++r) { s0[r] = __builtin_amdgcn_exp2f(s0[r] - mn); s1[r] = __builtin_amdgcn_exp2f(s1[r] - mn); ps += s0[r] + s1[r]; }
      l += ps;
      bf16x8 pf[4];
      { u32x4 w;
        w = (u32x4){pk2(s0[0], s0[1]), pk2(s0[2], s0[3]), pk2(s0[4], s0[5]), pk2(s0[6], s0[7])}; pf[0] = __builtin_bit_cast(bf16x8, w);
        w = (u32x4){pk2(s0[8], s0[9]), pk2(s0[10], s0[11]), pk2(s0[12], s0[13]), pk2(s0[14], s0[15])}; pf[1] = __builtin_bit_cast(bf16x8, w);
        w = (u32x4){pk2(s1[0], s1[1]), pk2(s1[2], s1[3]), pk2(s1[4], s1[5]), pk2(s1[6], s1[7])}; pf[2] = __builtin_bit_cast(bf16x8, w);
        w = (u32x4){pk2(s1[8], s1[9]), pk2(s1[10], s1[11]), pk2(s1[12], s1[13]), pk2(s1[14], s1[15])}; pf[3] = __builtin_bit_cast(bf16x8, w); }
#pragma unroll
      for (int ks = 0; ks < 4; ++ks) {
        const bf16x8 v0 = *(const bf16x8*)(cur + KSZ + r32 * 144 + ks * 32 + hi * 16);
        const bf16x8 v1 = *(const bf16x8*)(cur + KSZ + (32 + r32) * 144 + ks * 32 + hi * 16);
        o0 = __builtin_amdgcn_mfma_f32_32x32x16_bf16(v0, pf[ks], o0, 0, 0, 0);
        o1 = __builtin_amdgcn_mfma_f32_32x32x16_bf16(v1, pf[ks], o1, 0, 0, 0);
      }
    }
    if (more) sstore(nxt);
    __syncthreads();
  }
  { auto rr = __builtin_amdgcn_permlane32_swap(__float_as_uint(l), __float_as_uint(l), false, false); l = __uint_as_float(rr[0]) + __uint_as_float(rr[1]); }
  const float il = 1.f / l;
  bf16_t* orow = MIX + tokq * 1024 + 512 + h * 64;
#pragma unroll
  for (int g = 0; g < 4; ++g) {
    const int d = 8 * g + 4 * hi;
    u32x2 w0 = {pk2(o0[4 * g] * il, o0[4 * g + 1] * il), pk2(o0[4 * g + 2] * il, o0[4 * g + 3] * il)};
    u32x2 w1 = {pk2(o1[4 * g] * il, o1[4 * g + 1] * il), pk2(o1[4 * g + 2] * il, o1[4 * g + 3] * il)};
    *(u32x2*)(orow + d) = w0; *(u32x2*)(orow + 32 + d) = w1;
  }
}

__device__ __forceinline__ void phase_gdnchunk(char* smem, const Params& p) {
  const int tid = threadIdx.x, wid = tid >> 6, lane = tid & 63, r32 = lane & 31, hi = lane >> 5;
  if (wid >= 2) return;
  char* wl = smem + wid * 65536;
  float* At = (float*)wl;
  float* XU = (float*)(wl + 16384);
  float* XW = (float*)(wl + 32768);
  bf16_t* T1 = (bf16_t*)(wl + 49152);
  bf16_t* T2 = (bf16_t*)(wl + 57344);
  float* tab = (float*)(smem + CTLW + 256 + wid * 512);
  const bf16_t* GQ = (const bf16_t*)(p.ws + A_GQ); const bf16_t* GK = (const bf16_t*)(p.ws + A_GK); const bf16_t* GV = (const bf16_t*)(p.ws + A_GV);
  const float* GG = (const float*)(p.ws + A_GG); const float* GB = (const float*)(p.ws + A_GB);
  bf16_t* CW = (bf16_t*)(p.ws + A_CW); bf16_t* CU = (bf16_t*)(p.ws + A_CU); bf16_t* CQK = (bf16_t*)(p.ws + A_CQK);
  bf16_t* CKD = (bf16_t*)(p.ws + A_CKD); bf16_t* CQD = (bf16_t*)(p.ws + A_CQD); float* GL = (float*)(p.ws + A_GL);
  const int crw = lane >> 3, cch = lane & 7;
  const int c = lane;
#define LWAIT() asm volatile("s_waitcnt lgkmcnt(0)" ::: "memory")
#pragma unroll 1
  for (int unit = blockIdx.x * 2 + wid; unit < 4096; unit += gridDim.x * 2) {
    const int bh = unit >> 8, n = unit & 255, b = bh >> 3, h = bh & 7;
    const size_t tok0 = (size_t)b * SEQ + (size_t)n * 64;
    const size_t hoff = ((size_t)bh * SEQ + (size_t)n * 64) * 64;
    const bf16_t* kbase = GK + hoff; const bf16_t* qbase = GQ + hoff; const bf16_t* vbase = GV + hoff;
    float gc = GG[(tok0 + lane) * 8 + h]; const float be = GB[(tok0 + lane) * 8 + h];
#pragma unroll
    for (int o = 1; o < 64; o <<= 1) { const float t = __shfl_up(gc, o); if (lane >= o) gc += t; }
    tab[lane] = gc; tab[64 + lane] = be;
    const float gl = __shfl(gc, 63);
    LWAIT();
#pragma unroll 1
    for (int pass = 0; pass < 2; ++pass) {
      const bf16_t* abase = pass == 0 ? kbase : qbase;
      f32x16 acc[2][2];
#pragma unroll
      for (int i = 0; i < 2; ++i)
#pragma unroll
        for (int jj = 0; jj < 2; ++jj) acc[i][jj] = (f32x16){};
#pragma unroll
      for (int ks = 0; ks < 4; ++ks) {
        bf16x8 ka[2], aa[2];
#pragma unroll
        for (int ib = 0; ib < 2; ++ib) {
          ka[ib] = *(const bf16x8*)(kbase + (size_t)(ib * 32 + r32) * 64 + ks * 16 + hi * 8);
          aa[ib] = *(const bf16x8*)(abase + (size_t)(ib * 32 + r32) * 64 + ks * 16 + hi * 8);
        }
#pragma unroll
        for (int ib = 0; ib < 2; ++ib)
#pragma unroll
          for (int jb = 0; jb < 2; ++jb) acc[ib][jb] = __builtin_amdgcn_mfma_f32_32x32x16_bf16(aa[ib], ka[jb], acc[ib][jb], 0, 0, 0);
      }
#pragma unroll
      for (int ib = 0; ib < 2; ++ib)
#pragma unroll
        for (int jb = 0; jb < 2; ++jb) {
          const int j = jb * 32 + r32; const float gcj = tab[j];
#pragma unroll
          for (int r = 0; r < 16; ++r) {
            const int i = ib * 32 + (r & 3) + 8 * (r >> 2) + 4 * hi;
            const float dec = __expf(fminf(tab[i] - gcj, 0.f));
            if (pass == 0) At[j * 64 + i] = (i > j) ? tab[64 + i] * acc[ib][jb][r] * dec : 0.f;
            else T2[i * 64 + j] = f2bf((i >= j) ? acc[ib][jb][r] * 0.125f * dec : 0.f);
          }
        }
      LWAIT();
    }
#pragma unroll
    for (int it = 0; it < 8; ++it) {
      const int row = it * 8 + crw;
      *(u32x4*)(CQK + (size_t)unit * 4096 + row * 64 + cch * 8) = *(const u32x4*)(T2 + row * 64 + cch * 8);
      *(u32x4*)(T1 + row * 64 + cch * 8) = *(const u32x4*)(kbase + (size_t)row * 64 + cch * 8);
    }
    LWAIT();
#pragma unroll
    for (int it = 0; it < 8; ++it) { const int row = it * 8 + crw; *(u32x4*)(T2 + row * 64 + cch * 8) = *(const u32x4*)(vbase + (size_t)row * 64 + cch * 8); }
    LWAIT();
#pragma unroll 1
    for (int i0 = 0; i0 < 64; i0 += 8) {
      float kd[8];
#pragma unroll
      for (int q = 0; q < 8; ++q) {
        const int i = i0 + q; const float kv = bf2f(T1[i * 64 + c]), gci = tab[i], bi = tab[64 + i];
        kd[q] = kv * __expf(fminf(gl - gci, 0.f));
        XU[i * 64 + c] = bi * bf2f(T2[i * 64 + c]);
        XW[i * 64 + c] = bi * __expf(gci) * kv;
      }
      u32x4 w = {pk2(kd[0], kd[1]), pk2(kd[2], kd[3]), pk2(kd[4], kd[5]), pk2(kd[6], kd[7])};
      *(u32x4*)(CKD + (size_t)unit * 4096 + c * 64 + i0) = w;
    }
    LWAIT();
#pragma unroll 1
    for (int I = 0; I < 4; ++I) {
      const int i0 = 16 * I;
      float xu[16], xw[16];
#pragma unroll
      for (int ii = 0; ii < 16; ++ii) { xu[ii] = XU[(i0 + ii) * 64 + c]; xw[ii] = XW[(i0 + ii) * 64 + c]; }
#pragma unroll 2
      for (int j = 0; j < i0; ++j) {
        const float uj = XU[j * 64 + c], wj = XW[j * 64 + c];
        const f32x4 a0 = *(const f32x4*)(At + j * 64 + i0), a1 = *(const f32x4*)(At + j * 64 + i0 + 4),
                    a2 = *(const f32x4*)(At + j * 64 + i0 + 8), a3 = *(const f32x4*)(At + j * 64 + i0 + 12);
#pragma unroll
        for (int q = 0; q < 4; ++q) {
          xu[q] -= a0[q] * uj; xw[q] -= a0[q] * wj; xu[4 + q] -= a1[q] * uj; xw[4 + q] -= a1[q] * wj;
          xu[8 + q] -= a2[q] * uj; xw[8 + q] -= a2[q] * wj; xu[12 + q] -= a3[q] * uj; xw[12 + q] -= a3[q] * wj;
        }
      }
#pragma unroll
      for (int jj = 0; jj < 15; ++jj) {
        const float* ar = At + (i0 + jj) * 64 + i0;
#pragma unroll
        for (int ii = jj + 1; ii < 16; ++ii) { const float av = ar[ii]; xu[ii] -= av * xu[jj]; xw[ii] -= av * xw[jj]; }
      }
#pragma unroll
      for (int ii = 0; ii < 16; ++ii) { XU[(i0 + ii) * 64 + c] = xu[ii]; XW[(i0 + ii) * 64 + c] = xw[ii]; }
      LWAIT();
    }
#pragma unroll 8
    for (int i = 0; i < 64; ++i) { T2[i * 64 + c] = f2bf(XU[i * 64 + c]); T1[i * 64 + c] = f2bf(XW[i * 64 + c]); }
    LWAIT();
#pragma unroll
    for (int it = 0; it < 8; ++it) {
      const int row = it * 8 + crw;
      *(u32x4*)(CU + (size_t)unit * 4096 + row * 64 + cch * 8) = *(const u32x4*)(T2 + row * 64 + cch * 8);
      *(u32x4*)(CW + (size_t)unit * 4096 + row * 64 + cch * 8) = *(const u32x4*)(T1 + row * 64 + cch * 8);
      const u32x4 qv = *(const u32x4*)(qbase + (size_t)row * 64 + cch * 8);
      const float sc = 0.125f * __expf(tab[row]);
      u32x4 qo = {pk2(bflo(qv.x) * sc, bfhi(qv.x) * sc), pk2(bflo(qv.y) * sc, bfhi(qv.y) * sc), pk2(bflo(qv.z) * sc, bfhi(qv.z) * sc), pk2(bflo(qv.w) * sc, bfhi(qv.w) * sc)};
      *(u32x4*)(CQD + (size_t)unit * 4096 + row * 64 + cch * 8) = qo;
    }
    if (lane == 0) GL[unit] = __expf(gl);
    LWAIT();
  }
#undef LWAIT
}

__device__ __forceinline__ void gdn_chunk_scan(char* smem, const Params& p, int bh) {
  constexpr int TB = 9216, IMG = 5 * TB;
  const int tid = threadIdx.x, wid = tid >> 6, lane = tid & 63, r32 = lane & 31, hi = lane >> 5;
  const int sg = (r32 & ~12) | ((r32 & 4) << 1) | ((r32 & 8) >> 1);
  const int b = bh >> 3, h = bh & 7;
  const bf16_t* SRC[5] = {(const bf16_t*)(p.ws + A_CW), (const bf16_t*)(p.ws + A_CQD), (const bf16_t*)(p.ws + A_CQK), (const bf16_t*)(p.ws + A_CKD), (const bf16_t*)(p.ws + A_CU)};
  const float* GL = (const float*)(p.ws + A_GL);
  bf16_t* GO = (bf16_t*)(p.ws + A_GO);
  const bool loader = wid >= 2;
  const int ltid = tid - 128;
  u32x4 lr[7];
#pragma unroll
  for (int i = 0; i < 7; ++i) lr[i] = (u32x4){0u, 0u, 0u, 0u};
  auto lload = [&](int n) {
    const size_t ub = ((size_t)bh * 256 + n) * 4096;
#pragma unroll
    for (int i = 0; i < 7; ++i) { const int id = ltid + 384 * i;
      if (id < 2560) { const int tile = id >> 9, w = id & 511; const bf16_t* src = tile == 0 ? SRC[0] : tile == 1 ? SRC[1] : tile == 2 ? SRC[2] : tile == 3 ? SRC[3] : SRC[4];
        lr[i] = *(const u32x4*)(src + ub + (w >> 3) * 64 + (w & 7) * 8); } }
  };
  auto lstore = [&](char* img) {
#pragma unroll
    for (int i = 0; i < 7; ++i) { const int id = ltid + 384 * i;
      if (id < 2560) { const int tile = id >> 9, w = id & 511; *(u32x4*)(img + tile * TB + (w >> 3) * 144 + (w & 7) * 16) = lr[i]; } }
  };
  f32x16 S[2]; S[0] = (f32x16){}; S[1] = (f32x16){};
  const int dv = wid * 32 + r32;
  if (loader) { lload(0); lstore(smem); lload(1); }
  __syncthreads();
  float egl = loader ? 0.f : GL[bh * 256];
  for (int n = 0; n < 256; ++n) {
    const char* cur = smem + (n & 1) * IMG; char* nxt = smem + ((n + 1) & 1) * IMG;
    if (loader) {
      if (n + 1 < 256) lstore(nxt);
      if (n + 2 < 256) lload(n + 2);
    } else {
      const float egl_n = egl;
      if (n + 1 < 256) egl = GL[bh * 256 + n + 1];
      const size_t tok0 = (size_t)b * SEQ + (size_t)n * 64;
      bf16x8 sb[4];
#pragma unroll
      for (int ks = 0; ks < 4; ++ks) { const f32x16& q = S[ks >> 1]; const int o = 8 * (ks & 1);
        u32x4 w = {pk2(q[o], q[o + 1]), pk2(q[o + 2], q[o + 3]), pk2(q[o + 4], q[o + 5]), pk2(q[o + 6], q[o + 7])}; sb[ks] = __builtin_bit_cast(bf16x8, w); }
      f32x16 vn[2]; vn[0] = (f32x16){}; vn[1] = (f32x16){};
      f32x16 o[2]; o[0] = (f32x16){}; o[1] = (f32x16){};
#pragma unroll
      for (int tb = 0; tb < 2; ++tb)
#pragma unroll
        for (int ks = 0; ks < 4; ++ks) {
          const bf16x8 wf = *(const bf16x8*)(cur + 0 * TB + (tb * 32 + sg) * 144 + ks * 32 + hi * 16);
          const bf16x8 qf = *(const bf16x8*)(cur + 1 * TB + (tb * 32 + r32) * 144 + ks * 32 + hi * 16);
          vn[tb] = __builtin_amdgcn_mfma_f32_32x32x16_bf16(wf, sb[ks], vn[tb], 0, 0, 0);
          o[tb] = __builtin_amdgcn_mfma_f32_32x32x16_bf16(qf, sb[ks], o[tb], 0, 0, 0);
        }
#pragma unroll
      for (int tb = 0; tb < 2; ++tb)
#pragma unroll
        for (int r = 0; r < 16; ++r) { const int t = tb * 32 + 16 * (r >> 3) + 8 * hi + (r & 7);
          vn[tb][r] = bf2f(*(const bf16_t*)(cur + 4 * TB + t * 144 + dv * 2)) - vn[tb][r]; }
      bf16x8 vb[4];
#pragma unroll
      for (int ks = 0; ks < 4; ++ks) { const f32x16& q = vn[ks >> 1]; const int o8 = 8 * (ks & 1);
        u32x4 w = {pk2(q[o8], q[o8 + 1]), pk2(q[o8 + 2], q[o8 + 3]), pk2(q[o8 + 4], q[o8 + 5]), pk2(q[o8 + 6], q[o8 + 7])}; vb[ks] = __builtin_bit_cast(bf16x8, w); }
#pragma unroll
      for (int r = 0; r < 16; ++r) { S[0][r] *= egl_n; S[1][r] *= egl_n; }
#pragma unroll
      for (int tb = 0; tb < 2; ++tb)
#pragma unroll
        for (int ks = 0; ks < 4; ++ks) {
          const bf16x8 af = *(const bf16x8*)(cur + 2 * TB + (tb * 32 + r32) * 144 + ks * 32 + hi * 16);
          const bf16x8 kf = *(const bf16x8*)(cur + 3 * TB + (tb * 32 + sg) * 144 + ks * 32 + hi * 16);
          o[tb] = __builtin_amdgcn_mfma_f32_32x32x16_bf16(af, vb[ks], o[tb], 0, 0, 0);
          S[tb] = __builtin_amdgcn_mfma_f32_32x32x16_bf16(kf, vb[ks], S[tb], 0, 0, 0);
        }
#pragma unroll
      for (int tb = 0; tb < 2; ++tb)
#pragma unroll
        for (int r = 0; r < 16; ++r) { const int t = tb * 32 + (r & 3) + 8 * (r >> 2) + 4 * hi; GO[(tok0 + t) * 512 + h * 64 + dv] = f2bf(o[tb][r]); }
    }
    LDS_BARRIER();
  }
  __syncthreads();
}

__device__ __forceinline__ void phase_mix0(char* smem, const Params& p, int rep) {
  if (rep == 0 && blockIdx.x < 16) gdn_chunk_scan(smem, p, blockIdx.x);
  __syncthreads();
  unsigned* ctr = (unsigned*)(p.ws + WS_CTL) + rep;
  volatile int* sh = (volatile int*)(smem + CTLW);
  for (;;) {
    if (threadIdx.x == 0) sh[0] = (int)atomicAdd(ctr, 1u);
    __syncthreads();
    const int u = sh[0];
    __syncthreads();
    if (u >= 1024) break;
    attn_unit(smem, p, (u & 15) >> 3, u & 7, 63 - (u >> 4));
  }
}

__device__ __forceinline__ void phase_gdnpost(const Params& p) {
  const int tid = threadIdx.x, wid = tid >> 6, lane = tid & 63;
  const bf16_t* GO = (const bf16_t*)(p.ws + A_GO); const bf16_t* PROJ = (const bf16_t*)(p.ws + A_PROJ);
  bf16_t* MIX = (bf16_t*)(p.ws + WS_H);
  const int sub = lane & 7;
  float gn[8];
#pragma unroll
  for (int e = 0; e < 8; ++e) gn[e] = p.in[9][sub * 8 + e];
  const int gw = blockIdx.x * NW + wid, nw = gridDim.x * NW;
#pragma unroll 2
  for (int row = gw; row < MTOK; row += nw) {
    const u32x4 t = *(const u32x4*)(GO + (size_t)row * 512 + lane * 8);
    const u32x4 z = *(const u32x4*)((const bf16_t*)(p.ws + A_Z) + (size_t)row * 512 + lane * 8);
    float v[8] = {bflo(t.x), bfhi(t.x), bflo(t.y), bfhi(t.y), bflo(t.z), bfhi(t.z), bflo(t.w), bfhi(t.w)};
    float zz[8] = {bflo(z.x), bfhi(z.x), bflo(z.y), bfhi(z.y), bflo(z.z), bfhi(z.z), bflo(z.w), bfhi(z.w)};
    float ss = 0.f;
#pragma unroll
    for (int e = 0; e < 8; ++e) ss += v[e] * v[e];
    ss = group_sum<8>(ss);
    const float r = rsqrtf(ss * (1.f / 64.f) + 1e-6f);
#pragma unroll
    for (int e = 0; e < 8; ++e) v[e] = v[e] * r * gn[e] * siluf_(zz[e]);
    u32x4 w = {pk2(v[0], v[1]), pk2(v[2], v[3]), pk2(v[4], v[5]), pk2(v[6], v[7])};
    *(u32x4*)(MIX + (size_t)row * 1024 + lane * 8) = w;
  }
}

__device__ __forceinline__ void phase_prep1(const Params& p) {
  const int tid = threadIdx.x, wid = tid >> 6, lane = tid & 63;
  bf16_t* WL = (bf16_t*)(p.ws + A_WL); bf16_t* AL = (bf16_t*)(p.ws + A_AL);
  const bf16_t* RKV = (const bf16_t*)(p.ws + A_RKV);
  float* INV = (float*)(p.ws + A_INV); float* SB = (float*)(p.ws + A_SB);
  const int col = lane * 16, h = lane >> 2;
  const int gw = blockIdx.x * NW + wid, nw = gridDim.x * NW;
  float cw0[16], ca0[16], ckk[16], cka[16], crk[16];
#pragma unroll
  for (int e = 0; e < 16; ++e) { cw0[e] = p.in[22][col + e]; ca0[e] = p.in[25][col + e]; ckk[e] = p.in[30][col + e]; cka[e] = p.in[31][col + e]; crk[e] = p.in[32][col + e]; }
#pragma unroll 2
  for (int row = gw; row < MTOK; row += nw) {
    float ssk = 0.f, sb = 0.f;
#pragma unroll
    for (int half = 0; half < 2; ++half) {
      const int c0 = col + half * 8;
      const u32x4 tw = *(const u32x4*)(WL + (size_t)row * 1024 + c0), ta = *(const u32x4*)(AL + (size_t)row * 1024 + c0);
      const u32x4 tr = *(const u32x4*)(RKV + (size_t)row * 3072 + c0), tk = *(const u32x4*)(RKV + (size_t)row * 3072 + 1024 + c0);
      float wl[8] = {bflo(tw.x), bfhi(tw.x), bflo(tw.y), bfhi(tw.y), bflo(tw.z), bfhi(tw.z), bflo(tw.w), bfhi(tw.w)};
      float al[8] = {bflo(ta.x), bfhi(ta.x), bflo(ta.y), bfhi(ta.y), bflo(ta.z), bfhi(ta.z), bflo(ta.w), bfhi(ta.w)};
      float rr[8] = {bflo(tr.x), bfhi(tr.x), bflo(tr.y), bfhi(tr.y), bflo(tr.z), bfhi(tr.z), bflo(tr.w), bfhi(tr.w)};
      float kk[8] = {bflo(tk.x), bfhi(tk.x), bflo(tk.y), bfhi(tk.y), bflo(tk.z), bfhi(tk.z), bflo(tk.w), bfhi(tk.w)};
      float eo[8], ao[8];
#pragma unroll
      for (int e = 0; e < 8; ++e) {
        const int c = c0 + e;
        eo[e] = 0.6065306597126334f * sigmoidf_(cw0[half * 8 + e] + wl[e]);
        const float a = sigmoidf_(ca0[half * 8 + e] + al[e]);
        const unsigned ab = pk2(a, 0.f); const float ar = bflo(ab);
        ao[e] = a;
        const float kkv = kk[e] * ckk[half * 8 + e]; ssk += kkv * kkv;
        const float kp = kk[e] * (1.f + (ar - 1.f) * cka[half * 8 + e]);
        sb += rr[e] * kp * crk[half * 8 + e];
      }
      u32x4 we = {pk2(eo[0], eo[1]), pk2(eo[2], eo[3]), pk2(eo[4], eo[5]), pk2(eo[6], eo[7])};
      u32x4 wa = {pk2(ao[0], ao[1]), pk2(ao[2], ao[3]), pk2(ao[4], ao[5]), pk2(ao[6], ao[7])};
      *(u32x4*)(WL + (size_t)row * 1024 + c0) = we; *(u32x4*)(AL + (size_t)row * 1024 + c0) = wa;
    }
    ssk = group_sum<4>(ssk); sb = group_sum<4>(sb);
    if ((lane & 3) == 0) { INV[(size_t)row * 16 + h] = rsqrtf(ssk + 1e-12f); SB[(size_t)row * 16 + h] = sb; }
  }
}

__device__ __forceinline__ void phase_post1(const Params& p) {
  const int tid = threadIdx.x, wid = tid >> 6, lane = tid & 63;
  const bf16_t* Y = (const bf16_t*)(p.ws + WS_H); const bf16_t* G = (const bf16_t*)(p.ws + A_WL);
  const bf16_t* RKV = (const bf16_t*)(p.ws + A_RKV); const float* SB = (const float*)(p.ws + A_SB);
  bf16_t* YG = (bf16_t*)(p.ws + A_AL);
  const int col = lane * 16, h = lane >> 2;
  const int gw = blockIdx.x * NW + wid, nw = gridDim.x * NW;
  float lng[16], lnb[16];
#pragma unroll
  for (int e = 0; e < 16; ++e) { lng[e] = p.in[33][col + e]; lnb[e] = p.in[34][col + e]; }
#pragma unroll 2
  for (int row = gw; row < MTOK; row += nw) {
    float y[16]; float sm = 0.f;
#pragma unroll
    for (int half = 0; half < 2; ++half) {
      const u32x4 t = *(const u32x4*)(Y + (size_t)row * 1024 + col + half * 8);
      float* d = y + half * 8;
      d[0] = bflo(t.x); d[1] = bfhi(t.x); d[2] = bflo(t.y); d[3] = bfhi(t.y); d[4] = bflo(t.z); d[5] = bfhi(t.z); d[6] = bflo(t.w); d[7] = bfhi(t.w);
    }
#pragma unroll
    for (int e = 0; e < 16; ++e) sm += y[e];
    sm = group_sum<4>(sm);
    const float mean = sm * (1.f / 64.f);
    float vs = 0.f;
#pragma unroll
    for (int e = 0; e < 16; ++e) { const float dlt = y[e] - mean; vs += dlt * dlt; }
    vs = group_sum<4>(vs);
    const float rstd = rsqrtf(vs * (1.f / 64.f) + 64e-5f);
    const float sb = SB[(size_t)row * 16 + h];
#pragma unroll
    for (int half = 0; half < 2; ++half) {
      const int c0 = col + half * 8;
      const u32x4 tv = *(const u32x4*)(RKV + (size_t)row * 3072 + 2048 + c0), tg = *(const u32x4*)(G + (size_t)row * 1024 + c0);
      float vv[8] = {bflo(tv.x), bfhi(tv.x), bflo(tv.y), bfhi(tv.y), bflo(tv.z), bfhi(tv.z), bflo(tv.w), bfhi(tv.w)};
      float gg[8] = {bflo(tg.x), bfhi(tg.x), bflo(tg.y), bfhi(tg.y), bflo(tg.z), bfhi(tg.z), bflo(tg.w), bfhi(tg.w)};
      float o[8];
#pragma unroll
      for (int e = 0; e < 8; ++e) { const int c = c0 + e; o[e] = ((y[half * 8 + e] - mean) * rstd * lng[half * 8 + e] + lnb[half * 8 + e] + sb * vv[e]) * gg[e]; }
      u32x4 w = {pk2(o[0], o[1]), pk2(o[2], o[3]), pk2(o[4], o[5]), pk2(o[6], o[7])};
      *(u32x4*)(YG + (size_t)row * 1024 + c0) = w;
    }
  }
}

constexpr int NPHASE = 22;
__device__ __forceinline__ void run_phase(int ph, char* smem, const Params& p, int rep = 0) {
  bf16_t* WT = (bf16_t*)(p.ws + WS_WT);
  bf16_t* H = (bf16_t*)(p.ws + WS_H);
  const float* MOD = (const float*)(p.ws + WS_MOD);
  switch (ONLY >= 0 ? ONLY : ph) {
    case 0: phase_prologue(smem, p); break;
    case 1: phase_adaln<0>(p, p.in[0], 0, 0, H); break;
    case 2: gemm_phase(smem, H, 1024, WT + W_IN, 1024, MTOK, 2560, 1024, EpiStore{(bf16_t*)(p.ws + A_PROJ), PROJ_LD}); break;
    case 3: phase_prep0(p); break;
    case 4: gemm_phase(smem, (const bf16_t*)(p.ws + A_QLAT), 256, WT + W_UQ, 256, MTOK, 768, 256, EpiStore{(bf16_t*)((char*)p.out + O_QH), 768}); break;
    case 5: gemm_phase(smem, (const bf16_t*)(p.ws + A_KVLAT), 128, WT + W_UKV, 128, MTOK, 1024, 128, EpiKV{(bf16_t*)(p.ws + A_KN), (bf16_t*)((char*)p.out + O_VT)}); break;
    case 6: phase_qkrope(p); phase_gdnchunk(smem, p); break;
    case 7: phase_mix0(smem, p, rep); break;
    case 8: phase_gdnpost(p); break;
    case 9: gemm_phase(smem, H, 1024, WT + W_OUT, 1024, MTOK, 1024, 1024, EpiResid{p.in[0], p.out, MOD + 2048}); break;
    case 10: phase_adaln<0>(p, p.out, 0, 1, H); break;
    case 11: gemm_phase(smem, H, 1024, WT + W_UP0, 1024, MTOK, 4096, 1024, EpiUp{(bf16_t*)(p.ws + A_U)}); break;
    case 12: gemm_phase(smem, (const bf16_t*)(p.ws + A_U), 4096, WT + W_DN0, 4096, MTOK, 1024, 4096, EpiResid{p.out, p.out, MOD + 5120}); break;
    case 13: phase_adaln<1>(p, p.out, 1, 0, (bf16_t*)(p.ws + A_A2)); break;
    case 14: gemm_phase(smem, (const bf16_t*)(p.ws + A_A2), 2048, WT + W_RKV, 2048, MTOK, 3584, 2048, EpiRkv{(bf16_t*)(p.ws + A_RKV), (bf16_t*)(p.ws + A_LORA)}); break;
    case 15: gemm_phase(smem, (const bf16_t*)(p.ws + A_LORA), 384, WT + W_W2, 128, MTOK, 1024, 128, EpiStore{(bf16_t*)(p.ws + A_WL), 1024}); break;
    case 16: gemm_phase(smem, (const bf16_t*)(p.ws + A_LORA) + 64, 384, WT + W_A2, 128, MTOK, 1024, 128, EpiStore{(bf16_t*)(p.ws + A_AL), 1024}); break;
    case 17: phase_prep1(p); break;
    case 18: if (blockIdx.x < 256) { const int i = blockIdx.x, x = i & 7, sl = i >> 3; scan_unit<1>(smem, p, ((x * 4 + (sl >> 3)) << 3) | (sl & 7)); } break;
    case 19: gemm_phase(smem, (const bf16_t*)(p.ws + A_LORA) + 128, 384, WT + W_G2, 256, MTOK, 1024, 256, EpiStore{(bf16_t*)(p.ws + A_WL), 1024}); break;
    case 20: phase_post1(p); break;
    case 21: gemm_phase(smem, (const bf16_t*)(p.ws + A_AL), 1024, WT + W_O, 1024, MTOK, 1024, 1024, EpiResid{p.out, p.out, MOD + 2 * 6144 + 2048}); break;
    case 22: phase_adaln<0>(p, p.out, 1, 1, H); break;
    case 23: gemm_phase(smem, H, 1024, WT + W_UP1, 1024, MTOK, 4096, 1024, EpiUp{(bf16_t*)(p.ws + A_U)}); break;
    case 24: gemm_phase(smem, (const bf16_t*)(p.ws + A_U), 4096, WT + W_DN1, 4096, MTOK, 1024, 4096, EpiResid{p.out, p.out, MOD + 2 * 6144 + 5120}); break;
  }
}

__device__ __forceinline__ constexpr bool sync_after(int ph) { return !(ph == 4 || ph == 15); }
__device__ __forceinline__ void grid_barrier(const Params& p, unsigned& nbar) {
  __syncthreads();
  if (threadIdx.x == 0) {
    unsigned* ctr = (unsigned*)(p.ws + WS_CTL) + 32;
    nbar += gridDim.x;
    __builtin_amdgcn_fence(__ATOMIC_RELEASE, "agent");
    __hip_atomic_fetch_add(ctr, 1u, __ATOMIC_RELAXED, __HIP_MEMORY_SCOPE_AGENT);
    while (__hip_atomic_load(ctr, __ATOMIC_RELAXED, __HIP_MEMORY_SCOPE_AGENT) < nbar) __builtin_amdgcn_s_sleep(2);
    __builtin_amdgcn_fence(__ATOMIC_ACQUIRE, "agent");
  }
  __syncthreads();
}
template <int PH> __device__ __forceinline__ void do_phase(char* smem, const Params& p, int lo, int hi, unsigned& nbar) {
  if (lo <= PH && PH < hi) {
    if ((PROBE_MASK >> PH) & 1u) { run_phase(PH, smem, p, 1); grid_barrier(p, nbar); }
    run_phase(PH, smem, p);
    if (PH + 1 < hi && sync_after(PH)) { if (PH == 0) { __syncthreads(); cg::this_grid().sync(); } else grid_barrier(p, nbar); } else __syncthreads();
  }
}
__global__ void __launch_bounds__(NT, 2) fwd_kernel(Params p, int lo, int hi) {
  extern __shared__ __attribute__((aligned(16))) char smem[];
  unsigned nbar = 0u;
  do_phase<0>(smem, p, lo, hi, nbar); do_phase<1>(smem, p, lo, hi, nbar); do_phase<2>(smem, p, lo, hi, nbar); do_phase<3>(smem, p, lo, hi, nbar); do_phase<4>(smem, p, lo, hi, nbar); do_phase<5>(smem, p, lo, hi, nbar); do_phase<6>(smem, p, lo, hi, nbar); do_phase<7>(smem, p, lo, hi, nbar); do_phase<8>(smem, p, lo, hi, nbar); do_phase<9>(smem, p, lo, hi, nbar); do_phase<10>(smem, p, lo, hi, nbar); do_phase<11>(smem, p, lo, hi, nbar); do_phase<12>(smem, p, lo, hi, nbar); do_phase<13>(smem, p, lo, hi, nbar); do_phase<14>(smem, p, lo, hi, nbar); do_phase<15>(smem, p, lo, hi, nbar); do_phase<16>(smem, p, lo, hi, nbar); do_phase<17>(smem, p, lo, hi, nbar); do_phase<18>(smem, p, lo, hi, nbar); do_phase<19>(smem, p, lo, hi, nbar); do_phase<20>(smem, p, lo, hi, nbar); do_phase<21>(smem, p, lo, hi, nbar); do_phase<22>(smem, p, lo, hi, nbar); do_phase<23>(smem, p, lo, hi, nbar); do_phase<24>(smem, p, lo, hi, nbar);
}

extern "C" void kernel_launch(void* const* d_in, const int* in_sizes, int n_in, void* d_out, int out_size, void* d_ws, size_t ws_size, hipStream_t stream) {
  constexpr size_t kDynLds = CTLW + 256 + 4096;
  static int grid_blocks = 0;
  if (!grid_blocks) {
    int dev = 0, cus = 0, per_cu = 0;
    hipGetDevice(&dev);
    hipDeviceGetAttribute(&cus, hipDeviceAttributeMultiprocessorCount, dev);
    hipFuncSetAttribute((const void*)fwd_kernel, hipFuncAttributeMaxDynamicSharedMemorySize, (int)kDynLds);
    hipOccupancyMaxActiveBlocksPerMultiprocessor(&per_cu, fwd_kernel, NT, kDynLds);
    if (per_cu > 1) per_cu = 1;
    if (per_cu < 1) per_cu = 1;
    grid_blocks = cus * per_cu;
  }
  if (ws_size < WS_NEED) { fprintf(stderr, "workspace too small: %zu\n", ws_size); return; }
  Params p{};
  for (int i = 0; i < 37; ++i) p.in[i] = (const float*)d_in[i];
  p.out = (float*)d_out; p.ws = (char*)d_ws;
  constexpr int NPH = 25;
  (void)hipMemsetAsync((char*)d_ws + WS_CTL, 0, 256, stream);
#if COOP
  int lo = 0, hi = NPH;
  void* args[] = {&p, &lo, &hi};
  hipError_t e = hipLaunchCooperativeKernel((void*)fwd_kernel, dim3(grid_blocks), dim3(NT), args, kDynLds, stream);
  if (e != hipSuccess) fprintf(stderr, "cooperative launch failed: %s (grid %d)\n", hipGetErrorString(e), grid_blocks);
#else
  for (int ph = 0; ph < NPH; ++ph) fwd_kernel<<<grid_blocks, NT, kDynLds, stream>>>(p, ph, ph + 1);
#endif
}
```

```cpp
#include <hip/hip_runtime.h>
#include <hip/hip_cooperative_groups.h>
#include <cstdint>
#include <cstdio>
namespace cg = cooperative_groups;

#ifndef ONLY
#define ONLY -1
#endif
#ifndef PROBE_MASK
#define PROBE_MASK 0u
#endif
#ifndef COOP
#define COOP 1
#endif

typedef unsigned short bf16_t;
typedef short bf16x8 __attribute__((ext_vector_type(8)));
typedef float f32x4 __attribute__((ext_vector_type(4)));
typedef float f32x2 __attribute__((ext_vector_type(2)));
typedef float f32x16 __attribute__((ext_vector_type(16)));
typedef unsigned u32x4 __attribute__((ext_vector_type(4)));
typedef unsigned u32x2 __attribute__((ext_vector_type(2)));
typedef __bf16 bf16x2_t __attribute__((ext_vector_type(2)));

constexpr int NW = 8, NT = NW * 64, CTLW = 131072;
constexpr int SEQ = 16384, NBATCH = 2, MTOK = NBATCH * SEQ, DM = 1024, DFF = 4096;
constexpr int PROJ_LD = 2560;
constexpr size_t MiB = 1u << 20;
constexpr size_t WS_CTL = 0;
constexpr size_t WS_MOD = 64 * 1024;
constexpr size_t WS_WT = 1 * MiB;
constexpr size_t WS_H = 64 * MiB;
constexpr size_t WS_AR = 128 * MiB;
constexpr size_t W_IN = 0;
constexpr size_t W_UQ = W_IN + (size_t)2560 * 1024;
constexpr size_t W_UKV = W_UQ + (size_t)768 * 256;
constexpr size_t W_OUT = W_UKV + (size_t)1024 * 128;
constexpr size_t W_RKV = W_OUT + (size_t)1024 * 1024;
constexpr size_t W_W2 = W_RKV + (size_t)3584 * 2048;
constexpr size_t W_A2 = W_W2 + (size_t)1024 * 128;
constexpr size_t W_G2 = W_A2 + (size_t)1024 * 128;
constexpr size_t W_O = W_G2 + (size_t)1024 * 256;
constexpr size_t W_UP0 = W_O + (size_t)1024 * 1024;
constexpr size_t W_UP1 = W_UP0 + (size_t)4096 * 1024;
constexpr size_t W_DN0 = W_UP1 + (size_t)4096 * 1024;
constexpr size_t W_DN1 = W_DN0 + (size_t)4096 * 1024;
constexpr size_t W_END = W_DN1 + (size_t)4096 * 1024;
static_assert(W_END * 2 <= 63 * MiB, "weights fit");
constexpr size_t A_PROJ = WS_AR;
constexpr size_t A_GQ = WS_AR + 160 * MiB;
constexpr size_t A_GK = A_GQ + 32 * MiB;
constexpr size_t A_GV = A_GK + 32 * MiB;
constexpr size_t A_KN = WS_AR + 256 * MiB;
constexpr size_t A_QLAT = WS_AR + 320 * MiB;
constexpr size_t A_KVLAT = WS_AR + 336 * MiB;
constexpr size_t A_GA = WS_AR + 344 * MiB;
constexpr size_t A_GB = WS_AR + 345 * MiB;
constexpr size_t A_GO = WS_AR + 346 * MiB;
constexpr size_t A_Z = WS_AR + 288 * MiB;
constexpr size_t A_KR = WS_AR + 378 * MiB;
constexpr size_t A_GL = WS_AR + 380 * MiB;
constexpr size_t A_GG = WS_AR + 381 * MiB;
constexpr size_t A_CW = WS_AR + 0 * MiB, A_CU = WS_AR + 32 * MiB, A_CQK = WS_AR + 64 * MiB, A_CKD = WS_AR + 96 * MiB, A_CQD = WS_AR + 128 * MiB;
constexpr size_t O_QH = 0;
constexpr size_t O_KH = 48 * MiB;
constexpr size_t O_VT = 96 * MiB;
constexpr size_t A_U = WS_AR;
constexpr size_t A_A2 = WS_AR;
constexpr size_t A_WL = WS_AR;
constexpr size_t A_AL = WS_AR + 64 * MiB;
constexpr size_t A_RKV = WS_AR + 128 * MiB;
constexpr size_t A_LORA = WS_AR + 320 * MiB;
constexpr size_t A_INV = WS_AR + 344 * MiB;
constexpr size_t A_SB = WS_AR + 346 * MiB;
constexpr size_t WS_NEED = 512 * MiB;

struct Params { const float* in[37]; float* out; char* ws; };

__device__ __forceinline__ float bf2f(bf16_t h) { return __uint_as_float(((unsigned)h) << 16); }
__device__ __forceinline__ float bflo(unsigned u) { return __uint_as_float(u << 16); }
__device__ __forceinline__ float bfhi(unsigned u) { return __uint_as_float(u & 0xffff0000u); }
__device__ __forceinline__ unsigned pk2(float lo, float hi) { f32x2 v = {lo, hi}; bf16x2_t b = __builtin_convertvector(v, bf16x2_t); return __builtin_bit_cast(unsigned, b); }
__device__ __forceinline__ bf16_t f2bf(float f) { return (bf16_t)(pk2(f, 0.f) & 0xffffu); }
__device__ __forceinline__ float wave_sum(float v) {
#pragma unroll
  for (int o = 32; o; o >>= 1) v += __shfl_xor(v, o);
  return v;
}
template <int W> __device__ __forceinline__ float group_sum(float v) {
#pragma unroll
  for (int o = W / 2; o; o >>= 1) v += __shfl_xor(v, o);
  return v;
}
__device__ __forceinline__ float sigmoidf_(float x) { return __builtin_amdgcn_rcpf(1.f + __expf(-x)); }
__device__ __forceinline__ float siluf_(float x) { return x * __builtin_amdgcn_rcpf(1.f + __expf(-x)); }
__device__ __forceinline__ float softplusf_(float x) { return x > 20.f ? x : log1pf(expf(x)); }
__device__ __forceinline__ float softplus_fast(float x) {
  const float e = __expf(x);
  const float small = e * (1.f - e * (0.5f - e * (0.33333334f - 0.25f * e)));
  return x > 15.f ? x : (e < 0.02f ? small : __logf(1.f + e));
}
__device__ __forceinline__ float tanh_fast(float x) { const float t = __expf(-2.f * fabsf(x)); const float r = (1.f - t) * __builtin_amdgcn_rcpf(1.f + t); return x < 0.f ? -r : r; }
#define LDS_BARRIER() do { asm volatile("s_waitcnt lgkmcnt(0)" ::: "memory"); __builtin_amdgcn_s_barrier(); asm volatile("" ::: "memory"); } while (0)
template <int CTRL> __device__ __forceinline__ float dpp_add(float x) {
  return x + __int_as_float(__builtin_amdgcn_update_dpp(0, __float_as_int(x), CTRL, 0xf, 0xf, false));
}
__device__ __forceinline__ float row16_sum(float x) {
  x = dpp_add<0x128>(x); x = dpp_add<0x124>(x); x = dpp_add<0x122>(x); x = dpp_add<0x121>(x);
  return x;
}

__device__ __forceinline__ void conv_job(char* smem, const float* __restrict__ src, int K, int N, bf16_t* dst, int ldd, int koff, int Kp, int Np,
                         const float* mu, int mode, int& tbase) {
  const int half = threadIdx.x >> 8, tid = threadIdx.x & 255;
  bf16_t* tile = (bf16_t*)smem + half * (64 * 72);
  const int VG = gridDim.x * 2, vb = blockIdx.x * 2 + half;
  const int tk = Kp / 64, tn = Np / 64, nt = tk * tn;
  const int first = (vb - (tbase % VG) + VG) % VG;
  for (int base = 0; base < nt; base += VG) {
    const int t = base + first;
    const bool act = t < nt;
    const int k0 = (t % tk) * 64, n0 = (t / tk) * 64;
    const int nl = tid & 63, kq = tid >> 6;
    if (act) {
#pragma unroll 4
      for (int i = 0; i < 16; ++i) {
        const int kl = kq + 4 * i, k = k0 + kl, n = n0 + nl;
        float v = 0.f;
        if (k < K && n < N) { v = src[(size_t)k * N + n]; if (mode == 1) v *= mu[k]; else if (mode == 2) v *= (1.f - mu[k]); }
        tile[nl * 72 + kl] = f2bf(v);
      }
    }
    __syncthreads();
    if (act) {
      const int n = tid >> 2, seg = (tid & 3) * 16;
      const u32x4 a = *(const u32x4*)(tile + n * 72 + seg), b = *(const u32x4*)(tile + n * 72 + seg + 8);
      bf16_t* d = dst + (size_t)(n0 + n) * ldd + koff + k0 + seg;
      *(u32x4*)d = a; *(u32x4*)(d + 8) = b;
    }
    __syncthreads();
  }
  tbase += nt;
}

__device__ __forceinline__ void phase_prologue(char* smem, const Params& p) {
  const int tid = threadIdx.x, wid = tid >> 6, lane = tid & 63;
  if (blockIdx.x == 0 && tid < 64) ((unsigned*)(p.ws + WS_CTL))[tid] = 0u;
  {
    float* sc = (float*)smem;
    float* red = sc + 2048;
    const float* c = p.in[1];
    for (int i = tid; i < 2048; i += NT) sc[i] = siluf_(c[i]);
    __syncthreads();
    float* MOD = (float*)(p.ws + WS_MOD);
    for (int item = blockIdx.x; item < 192; item += gridDim.x) {
      const int l = item / 96, jg = item % 96, col = jg * 64 + lane;
      const float* w = p.in[3] + (size_t)l * 1024 * 6144 + col;
      float a0 = 0.f, a1 = 0.f;
      const int kb = wid * 128;
#pragma unroll 8
      for (int k = 0; k < 128; ++k) { const float wv = w[(size_t)(kb + k) * 6144]; a0 += sc[kb + k] * wv; a1 += sc[1024 + kb + k] * wv; }
      red[(wid * 2 + 0) * 64 + lane] = a0; red[(wid * 2 + 1) * 64 + lane] = a1;
      __syncthreads();
      if (wid < 2) {
        float s = 0.f;
#pragma unroll
        for (int ww = 0; ww < NW; ++ww) s += red[(ww * 2 + wid) * 64 + lane];
        MOD[(size_t)(l * 2 + wid) * 6144 + col] = s + p.in[4][l * 6144 + col];
      }
      __syncthreads();
    }
    __syncthreads();
  }
  bf16_t* WT = (bf16_t*)(p.ws + WS_WT);
  const float* mu = p.in[17];
  int tb = 0;
  for (int job = 0; job < 24; ++job) {
    const float* src; int K, N; bf16_t* dst; int ldd, koff, Kp, Np; const float* mup; int mode;
    switch (job) {
      case 0: src = p.in[5]; K = 1024; N = 2480; dst = WT + W_IN; ldd = 1024; koff = 0; Kp = 1024; Np = 2560; mup = nullptr; mode = 0; break;
      case 1: src = p.in[12]; K = 256; N = 768; dst = WT + W_UQ; ldd = 256; koff = 0; Kp = 256; Np = 768; mup = nullptr; mode = 0; break;
      case 2: src = p.in[13]; K = 128; N = 1024; dst = WT + W_UKV; ldd = 128; koff = 0; Kp = 128; Np = 1024; mup = nullptr; mode = 0; break;
      case 3: src = p.in[16]; K = 1024; N = 1024; dst = WT + W_OUT; ldd = 1024; koff = 0; Kp = 1024; Np = 1024; mup = nullptr; mode = 0; break;
      case 4: src = p.in[18]; K = 1024; N = 1024; dst = WT + W_RKV + (size_t)0 * 2048; ldd = 2048; koff = 0; Kp = 1024; Np = 1024; mup = mu + 0 * 1024; mode = 2; break;
      case 5: src = p.in[18]; K = 1024; N = 1024; dst = WT + W_RKV + (size_t)0 * 2048; ldd = 2048; koff = 1024; Kp = 1024; Np = 1024; mup = mu + 0 * 1024; mode = 1; break;
      case 6: src = p.in[19]; K = 1024; N = 1024; dst = WT + W_RKV + (size_t)1024 * 2048; ldd = 2048; koff = 0; Kp = 1024; Np = 1024; mup = mu + 2 * 1024; mode = 2; break;
      case 7: src = p.in[19]; K = 1024; N = 1024; dst = WT + W_RKV + (size_t)1024 * 2048; ldd = 2048; koff = 1024; Kp = 1024; Np = 1024; mup = mu + 2 * 1024; mode = 1; break;
      case 8: src = p.in[20]; K = 1024; N = 1024; dst = WT + W_RKV + (size_t)2048 * 2048; ldd = 2048; koff = 0; Kp = 1024; Np = 1024; mup = mu + 3 * 1024; mode = 2; break;
      case 9: src = p.in[20]; K = 1024; N = 1024; dst = WT + W_RKV + (size_t)2048 * 2048; ldd = 2048; koff = 1024; Kp = 1024; Np = 1024; mup = mu + 3 * 1024; mode = 1; break;
      case 10: src = p.in[23]; K = 1024; N = 64; dst = WT + W_RKV + (size_t)3072 * 2048; ldd = 2048; koff = 0; Kp = 1024; Np = 64; mup = mu + 1 * 1024; mode = 2; break;
      case 11: src = p.in[23]; K = 1024; N = 64; dst = WT + W_RKV + (size_t)3072 * 2048; ldd = 2048; koff = 1024; Kp = 1024; Np = 64; mup = mu + 1 * 1024; mode = 1; break;
      case 12: src = p.in[26]; K = 1024; N = 64; dst = WT + W_RKV + (size_t)3136 * 2048; ldd = 2048; koff = 0; Kp = 1024; Np = 64; mup = mu + 4 * 1024; mode = 2; break;
      case 13: src = p.in[26]; K = 1024; N = 64; dst = WT + W_RKV + (size_t)3136 * 2048; ldd = 2048; koff = 1024; Kp = 1024; Np = 64; mup = mu + 4 * 1024; mode = 1; break;
      case 14: src = p.in[28]; K = 1024; N = 160; dst = WT + W_RKV + (size_t)3200 * 2048; ldd = 2048; koff = 0; Kp = 1024; Np = 384; mup = mu + 5 * 1024; mode = 2; break;
      case 15: src = p.in[28]; K = 1024; N = 160; dst = WT + W_RKV + (size_t)3200 * 2048; ldd = 2048; koff = 1024; Kp = 1024; Np = 384; mup = mu + 5 * 1024; mode = 1; break;
      case 16: src = p.in[24]; K = 64; N = 1024; dst = WT + W_W2; ldd = 128; koff = 0; Kp = 128; Np = 1024; mup = nullptr; mode = 0; break;
      case 17: src = p.in[27]; K = 64; N = 1024; dst = WT + W_A2; ldd = 128; koff = 0; Kp = 128; Np = 1024; mup = nullptr; mode = 0; break;
      case 18: src = p.in[29]; K = 160; N = 1024; dst = WT + W_G2; ldd = 256; koff = 0; Kp = 256; Np = 1024; mup = nullptr; mode = 0; break;
      case 19: src = p.in[21]; K = 1024; N = 1024; dst = WT + W_O; ldd = 1024; koff = 0; Kp = 1024; Np = 1024; mup = nullptr; mode = 0; break;
      case 20: src = p.in[35]; K = 1024; N = 4096; dst = WT + W_UP0; ldd = 1024; koff = 0; Kp = 1024; Np = 4096; mup = nullptr; mode = 0; break;
      case 21: src = p.in[35] + (size_t)1024 * 4096; K = 1024; N = 4096; dst = WT + W_UP1; ldd = 1024; koff = 0; Kp = 1024; Np = 4096; mup = nullptr; mode = 0; break;
      case 22: src = p.in[36]; K = 4096; N = 1024; dst = WT + W_DN0; ldd = 4096; koff = 0; Kp = 4096; Np = 1024; mup = nullptr; mode = 0; break;
      default: src = p.in[36] + (size_t)4096 * 1024; K = 4096; N = 1024; dst = WT + W_DN1; ldd = 4096; koff = 0; Kp = 4096; Np = 1024; mup = nullptr; mode = 0; break;
    }
    conv_job(smem, src, K, N, dst, ldd, koff, Kp, Np, mup, mode, tb);
  }
}

template <int MODE> __device__ __forceinline__ void phase_adaln(const Params& p, const float* src, int layer, int which, bf16_t* dst) {
  const int tid = threadIdx.x, wid = tid >> 6, lane = tid & 63;
  const float* MOD = (const float*)(p.ws + WS_MOD);
  const int gw = blockIdx.x * NW + wid, nw = gridDim.x * NW;
  for (int row0 = gw; row0 < MTOK; row0 += 4 * nw) {
    f32x4 v[4][4];
#pragma unroll
    for (int u = 0; u < 4; ++u) {
      const int rowc = (row0 + u * nw < MTOK) ? row0 + u * nw : MTOK - 1;
      const float* xr = src + (size_t)rowc * DM;
#pragma unroll
      for (int i = 0; i < 4; ++i) v[u][i] = *(const f32x4*)(xr + i * 256 + lane * 4);
    }
#pragma unroll
    for (int u = 0; u < 4; ++u) {
      const int row = row0 + u * nw;
      if (row < MTOK) {
        const int b = row >> 14, s = row & (SEQ - 1);
        const float* shift = MOD + (size_t)(layer * 2 + b) * 6144 + which * 3072;
        const float* scale = shift + 1024;
        float ss = 0.f;
#pragma unroll
        for (int i = 0; i < 4; ++i) ss += v[u][i][0] * v[u][i][0] + v[u][i][1] * v[u][i][1] + v[u][i][2] * v[u][i][2] + v[u][i][3] * v[u][i][3];
        ss = wave_sum(ss);
        const float r = rsqrtf(ss * (1.f / 1024.f) + 1e-6f);
#pragma unroll
        for (int i = 0; i < 4; ++i) {
          const int col = i * 256 + lane * 4;
          const f32x4 sc = *(const f32x4*)(scale + col), sh = *(const f32x4*)(shift + col);
          u32x2 w;
          w.x = pk2(v[u][i][0] * r * (1.f + sc[0]) + sh[0], v[u][i][1] * r * (1.f + sc[1]) + sh[1]);
          w.y = pk2(v[u][i][2] * r * (1.f + sc[2]) + sh[2], v[u][i][3] * r * (1.f + sc[3]) + sh[3]);
          if (MODE == 0) { *(u32x2*)(dst + (size_t)row * 1024 + col) = w; }
          else {
            *(u32x2*)(dst + (size_t)row * 2048 + col) = w;
            if (s + 1 < SEQ) *(u32x2*)(dst + (size_t)(row + 1) * 2048 + 1024 + col) = w;
            if (s == 0) { u32x2 z = {0u, 0u}; *(u32x2*)(dst + (size_t)row * 2048 + 1024 + col) = z; }
          }
        }
      }
    }
  }
}

struct EpiStore { bf16_t* C; int ldc;
  __device__ __forceinline__ void operator()(int row, int col, f32x4 v) const { u32x2 w = {pk2(v[0], v[1]), pk2(v[2], v[3])}; *(u32x2*)(C + (size_t)row * ldc + col) = w; } };
struct EpiKV { bf16_t* KN; bf16_t* Vt;
  __device__ __forceinline__ void operator()(int row, int col, f32x4 v) const {
    const int h = col >> 7, c = col & 127;
    if (c < 64) { u32x2 w = {pk2(v[0], v[1]), pk2(v[2], v[3])}; *(u32x2*)(KN + (size_t)row * 512 + h * 64 + c) = w; }
    else { const int b = row >> 14, s = row & (SEQ - 1); bf16_t* d = Vt + ((size_t)((b * 8 + h) * 64 + (c - 64))) * SEQ + s;
#pragma unroll
      for (int j = 0; j < 4; ++j) d[(size_t)j * SEQ] = f2bf(v[j]); }
  } };
struct EpiResid { const float* base; float* out; const float* gate;
  __device__ __forceinline__ void operator()(int row, int col, f32x4 v) const {
    const int b = row >> 14; const f32x4 g = *(const f32x4*)(gate + (size_t)b * 6144 + col);
    const f32x4 x = *(const f32x4*)(base + (size_t)row * DM + col);
    *(f32x4*)(out + (size_t)row * DM + col) = x + g * v; } };
struct EpiUp { bf16_t* U;
  __device__ __forceinline__ void operator()(int row, int col, f32x4 v) const {
    f32x4 r;
#pragma unroll
    for (int j = 0; j < 4; ++j) { const float t = v[j] > 0.f ? v[j] : 0.f; r[j] = t * t; }
    u32x2 w = {pk2(r[0], r[1]), pk2(r[2], r[3])}; *(u32x2*)(U + (size_t)row * DFF + col) = w; } };
struct EpiRkv { bf16_t* RKV; bf16_t* LORA;
  __device__ __forceinline__ void operator()(int row, int col, f32x4 v) const {
    if (col < 3072) { u32x2 w = {pk2(v[0], v[1]), pk2(v[2], v[3])}; *(u32x2*)(RKV + (size_t)row * 3072 + col) = w; }
    else { const int c = col - 3072; f32x4 r;
      if (c < 64) { for (int j = 0; j < 4; ++j) r[j] = tanh_fast(v[j]); }
      else if (c < 128) r = v;
      else if (c < 288) { for (int j = 0; j < 4; ++j) r[j] = sigmoidf_(v[j]); }
      else r = (f32x4){0.f, 0.f, 0.f, 0.f};
      if (c < 384) { u32x2 w = {pk2(r[0], r[1]), pk2(r[2], r[3])}; *(u32x2*)(LORA + (size_t)row * 384 + c) = w; } }
  } };

namespace pg8 {
#define PG8_LAS __attribute__((address_space(3)))
typedef unsigned short bf16_t;
typedef short bf16x8 __attribute__((ext_vector_type(8)));
typedef float f32x4 __attribute__((ext_vector_type(4)));
typedef unsigned u32x4 __attribute__((ext_vector_type(4)));
constexpr int BM = 256, BK = 64, HALF = 128, HTB = HALF * BK * 2  , STAGE_BYTES = 8 * HTB, NXCD = 8, WGM = 8;

__host__ __device__ __forceinline__ int lds_byte(int r, int c) { const int st = (r >> 4) * 2 + (c >> 5), rr = r & 15, cc = c & 31, ob = rr * 64 + cc * 2; return st * 1024 + (ob ^ (((ob >> 9) & 1) << 5)); }
__host__ __device__ __forceinline__ void stage_rc(int b, int& R, int& C) { const int st = b / 1024, sb = b % 1024, swz = sb ^ (((sb >> 9) & 1) << 5); R = (st >> 1) * 16 + swz / 64; C = (st & 1) * 32 + (swz % 64) / 2; }
__host__ __device__ __forceinline__ int perm32(int rho) { const int n = rho >> 4, i = rho & 15; return 8 * (i >> 2) + 4 * n + (i & 3); }

struct Unit { int pm, pn; };
struct Gemm { const bf16_t* A; const bf16_t* Bt; int M, N, K, lda; };

struct StaticOrder {
    int nM, nN, nwg, G, c;
    __host__ __device__ void init(int M, int N, int G_, int c_) { nM = M / BM; nN = N / BM; nwg = nM * nN; G = G_; c = c_; }
    __host__ __device__ bool next(int i, Unit& u) const {
        const long L = (long)i * G + c; if (L >= nwg) return false;
        int wgid = (int)L; { const int q = nwg / NXCD, r = nwg % NXCD, xcd = wgid % NXCD, off = wgid / NXCD; wgid = (xcd < r ? xcd * (q + 1) : r * (q + 1) + (xcd - r) * q) + off; }
        const int nig = WGM * nN, gid = wgid / nig, fm = gid * WGM, gsz = (nM - fm) < WGM ? (nM - fm) : WGM;
        u.pm = fm + ((wgid % nig) % gsz); u.pn = (wgid % nig) / gsz; return true;
    }
    __device__ __forceinline__ void a_ready(const Unit&) const {}
    __device__ __forceinline__ void done(const Unit&) const {}
};


template <class Epi, class Sched, bool ALIGN_EPI = false, bool SP2 = false>
__device__ __forceinline__ void gemm_phase(PG8_LAS unsigned char* lds, const Gemm g, const Sched& S, const Epi& E) {
    const int tid = threadIdx.x, wid = __builtin_amdgcn_readfirstlane(tid >> 6), lane = tid & 63, wr = wid >> 2, wc = wid & 3, fr = lane & 15, fq = lane >> 4;
    const int K = g.K, nt = K / BK;
    unsigned voffA[2], voffB[2];
#pragma unroll
    for (int i = 0; i < 2; ++i) { int R, C; stage_rc(tid * 16 + i * 8192, R, C); const int Rb = Epi::PERM ? ((R & ~31) + perm32(R & 31)) : R;
        voffA[i] = (unsigned)(R * g.lda + C) * 2u; voffB[i] = (unsigned)(Rb * K + C) * 2u; }
    const size_t kstep = (size_t)(BK * 2);
    const size_t hstepA = (size_t)HALF * g.lda * 2, hstepB = (size_t)HALF * K * 2;
    const size_t tstepA = 2 * hstepA, tstepB = 2 * hstepB;
    const unsigned ldsw = (unsigned)wid * 1024u;
    const int aoff = lds_byte(wr * 64 + fr, fq * 8), boff = lds_byte(wc * 32 + fr, fq * 8);
#define PG8_SA(b, h) (((b) * 2 + (h)) * HTB)
#define PG8_SB(b, h) ((4 + (b) * 2 + (h)) * HTB)
#define PG8_STAGE(bufoff, gbase, voff) do { _Pragma("unroll") for (int _i = 0; _i < 2; ++_i) \
        __builtin_amdgcn_global_load_lds((const unsigned*)((const char*)(gbase) + (voff)[_i]), (PG8_LAS unsigned*)(lds + (bufoff) + ldsw + _i * 8192), 16, 0, 0); } while (0)
#define PG8_LDA(dst, b, h) do { _Pragma("unroll") for (int m = 0; m < 4; ++m) _Pragma("unroll") for (int k = 0; k < 2; ++k) dst[m][k] = *(const PG8_LAS bf16x8*)(lds + PG8_SA(b, h) + aoff + m * 2048 + k * 1024); } while (0)
#define PG8_LDB(dst, b, h) do { _Pragma("unroll") for (int n = 0; n < 2; ++n) _Pragma("unroll") for (int k = 0; k < 2; ++k) dst[n][k] = *(const PG8_LAS bf16x8*)(lds + PG8_SB(b, h) + boff + n * 2048 + k * 1024); } while (0)
#define PG8_MMA(ai, bj, At, Bt) do { __builtin_amdgcn_s_setprio(1); _Pragma("unroll") for (int m = 0; m < 4; ++m) _Pragma("unroll") for (int n = 0; n < 2; ++n) _Pragma("unroll") for (int k = 0; k < 2; ++k) \
        acc[ai][bj][m][n] = __builtin_amdgcn_mfma_f32_16x16x32_bf16(Bt[n][k], At[m][k], acc[ai][bj][m][n], 0, 0, 0); __builtin_amdgcn_s_setprio(0); } while (0)
#define PG8_WAIT_V(n) asm volatile("s_waitcnt vmcnt(" #n ")" ::: "memory")
#define PG8_WAIT_L(n) asm volatile("s_waitcnt lgkmcnt(" #n ")" ::: "memory")
#define PG8_BAR __builtin_amdgcn_s_barrier()
#define PG8_SCHED __builtin_amdgcn_sched_barrier(0)
    Unit cur, nxt; int ui = 0;
    if (!S.next(0, cur)) return;
    f32x4 acc[2][2][4][2];
#pragma unroll
    for (int a = 0; a < 2; ++a)
#pragma unroll
        for (int b = 0; b < 2; ++b)
#pragma unroll
            for (int m = 0; m < 4; ++m)
#pragma unroll
                for (int n = 0; n < 2; ++n) acc[a][b][m][n] = (f32x4){0.f, 0.f, 0.f, 0.f};
    bf16x8 At[4][2], B0[2][2], B1[2][2];
    const char* cA = (const char*)g.A + (size_t)cur.pm * tstepA; const char* cB = (const char*)g.Bt + (size_t)cur.pn * tstepB;
    S.a_ready(cur);
    if constexpr (SP2) {
        PG8_STAGE(PG8_SB(0, 0), cB, voffB); PG8_STAGE(PG8_SB(0, 1), cB + hstepB, voffB); PG8_STAGE(PG8_SA(0, 0), cA, voffA); PG8_STAGE(PG8_SA(0, 1), cA + hstepA, voffA);
        if (wr == 1) PG8_BAR;
        PG8_WAIT_V(2); PG8_BAR;
        PG8_STAGE(PG8_SB(1, 0), cB + kstep, voffB); PG8_STAGE(PG8_SA(1, 0), cA + kstep, voffA); PG8_STAGE(PG8_SB(1, 1), cB + hstepB + kstep, voffB);
        PG8_WAIT_V(6); PG8_BAR;
    } else {
        PG8_STAGE(PG8_SB(0, 0), cB, voffB); PG8_STAGE(PG8_SA(0, 0), cA, voffA); PG8_STAGE(PG8_SB(0, 1), cB + hstepB, voffB); PG8_STAGE(PG8_SA(0, 1), cA + hstepA, voffA);
        if (wr == 1) PG8_BAR;
        PG8_WAIT_V(4); PG8_BAR;
        PG8_STAGE(PG8_SB(1, 0), cB + kstep, voffB); PG8_STAGE(PG8_SA(1, 0), cA + kstep, voffA); PG8_STAGE(PG8_SB(1, 1), cB + hstepB + kstep, voffB);
        PG8_WAIT_V(6); PG8_BAR;
    }
    for (;;) {
        const bool has_next = S.next(ui + 1, nxt);
        const char* nA = has_next ? (const char*)g.A + (size_t)nxt.pm * tstepA : cA; const char* nB = has_next ? (const char*)g.Bt + (size_t)nxt.pn * tstepB : cB;
#pragma unroll 1
        for (int t = 0; t < nt; t += 2) {
            const bool last = (t == nt - 2);
            const char* a1 = cA + (size_t)(t + 1) * kstep;
            const char* a2 = last ? nA : cA + (size_t)(t + 2) * kstep; const char* b2 = last ? nB : cB + (size_t)(t + 2) * kstep;
            const char* a3 = a2 + kstep; const char* b3 = b2 + kstep;
            if (last && has_next) S.a_ready(nxt);
            if constexpr (SP2) {
            PG8_LDB(B0, 0, 0); PG8_LDB(B1, 0, 1); PG8_SCHED; PG8_LDA(At, 0, 0); PG8_STAGE(PG8_SA(1, 1), a1 + hstepA, voffA);
            PG8_WAIT_V(8); PG8_WAIT_L(0); PG8_BAR; PG8_MMA(0, 0, At, B0); PG8_MMA(0, 1, At, B1); PG8_BAR; PG8_SCHED;
            PG8_LDA(At, 0, 1); PG8_STAGE(PG8_SB(0, 0), b2, voffB); PG8_STAGE(PG8_SB(0, 1), b2 + hstepB, voffB); PG8_STAGE(PG8_SA(0, 0), a2, voffA);
            PG8_WAIT_V(8); PG8_WAIT_L(0); PG8_BAR; PG8_MMA(1, 0, At, B0); PG8_MMA(1, 1, At, B1); PG8_BAR; PG8_SCHED;
            PG8_LDB(B0, 1, 0); PG8_LDB(B1, 1, 1); PG8_SCHED; PG8_LDA(At, 1, 0); PG8_STAGE(PG8_SA(0, 1), a2 + hstepA, voffA);
            PG8_WAIT_V(8); PG8_WAIT_L(0); PG8_BAR; PG8_MMA(0, 0, At, B0); PG8_MMA(0, 1, At, B1); PG8_BAR; PG8_SCHED;
            PG8_LDA(At, 1, 1); PG8_STAGE(PG8_SB(1, 0), b3, voffB); PG8_STAGE(PG8_SB(1, 1), b3 + hstepB, voffB); PG8_STAGE(PG8_SA(1, 0), a3, voffA);
            PG8_WAIT_V(8); PG8_WAIT_L(0); PG8_BAR; PG8_MMA(1, 0, At, B0); PG8_MMA(1, 1, At, B1); PG8_BAR; PG8_SCHED;
            } else {
            PG8_LDB(B0, 0, 0); PG8_SCHED; PG8_LDA(At, 0, 0); PG8_STAGE(PG8_SA(1, 1), a1 + hstepA, voffA);
            PG8_WAIT_L(8); PG8_BAR; PG8_WAIT_L(0); PG8_MMA(0, 0, At, B0); PG8_BAR; PG8_SCHED;
            PG8_LDB(B1, 0, 1); PG8_STAGE(PG8_SB(0, 0), b2, voffB);
            PG8_BAR; PG8_WAIT_L(0); PG8_MMA(0, 1, At, B1); PG8_BAR;
            PG8_LDA(At, 0, 1); PG8_STAGE(PG8_SA(0, 0), a2, voffA);
            PG8_BAR; PG8_WAIT_L(0); PG8_MMA(1, 0, At, B0); PG8_BAR; PG8_SCHED;
            PG8_STAGE(PG8_SB(0, 1), b2 + hstepB, voffB);
            PG8_WAIT_V(6); PG8_BAR; PG8_MMA(1, 1, At, B1); PG8_BAR;
            PG8_LDB(B0, 1, 0); PG8_SCHED; PG8_LDA(At, 1, 0); PG8_STAGE(PG8_SA(0, 1), a2 + hstepA, voffA);
            PG8_WAIT_L(8); PG8_BAR; PG8_WAIT_L(0); PG8_MMA(0, 0, At, B0); PG8_BAR; PG8_SCHED;
            PG8_LDB(B1, 1, 1); PG8_STAGE(PG8_SB(1, 0), b3, voffB);
            PG8_BAR; PG8_WAIT_L(0); PG8_MMA(0, 1, At, B1); PG8_BAR;
            PG8_LDA(At, 1, 1); PG8_STAGE(PG8_SA(1, 0), a3, voffA);
            PG8_BAR; PG8_WAIT_L(0); PG8_MMA(1, 0, At, B0); PG8_BAR; PG8_SCHED;
            PG8_STAGE(PG8_SB(1, 1), b3 + hstepB, voffB);
            PG8_WAIT_V(6); PG8_BAR; PG8_MMA(1, 1, At, B1); PG8_BAR;
            }
        }
        if constexpr (ALIGN_EPI) { if (wr == 0) PG8_BAR; }
        if constexpr (!Epi::AFTER_DRAIN) { E(acc, cur, wr, wc, fr, fq); S.done(cur); }
        if (!has_next) break;
#pragma unroll
        for (int a = 0; a < 2; ++a)
#pragma unroll
            for (int b = 0; b < 2; ++b)
#pragma unroll
                for (int m = 0; m < 4; ++m)
#pragma unroll
                    for (int n = 0; n < 2; ++n) acc[a][b][m][n] = (f32x4){0.f, 0.f, 0.f, 0.f};
        cur = nxt; cA = nA; cB = nB; ++ui;
        if constexpr (ALIGN_EPI) { if (wr == 1) PG8_BAR; }
    }
    PG8_WAIT_V(0);
    if constexpr (!ALIGN_EPI) { if (wr == 0) PG8_BAR; }
    PG8_BAR;
    if constexpr (Epi::AFTER_DRAIN) { E.fused(acc, cur, wr, wc, fr, fq, lds, wid, lane); S.done(cur); }
#undef PG8_SA
#undef PG8_SB
#undef PG8_STAGE
#undef PG8_LDA
#undef PG8_LDB
#undef PG8_MMA
#undef PG8_WAIT_V
#undef PG8_WAIT_L
#undef PG8_BAR
#undef PG8_SCHED
}
}


template <class F> struct EpiAdapt {
  static constexpr bool PERM = false, AFTER_DRAIN = false; F f;
  __device__ __forceinline__ void operator()(const pg8::f32x4 (&acc)[2][2][4][2], const pg8::Unit& u, int wr, int wc, int fr, int fq) const {
#pragma unroll
    for (int ai = 0; ai < 2; ++ai)
#pragma unroll
      for (int m = 0; m < 4; ++m) { const int row = u.pm * 256 + 128 * ai + 64 * wr + 16 * m + fr;
#pragma unroll
        for (int bj = 0; bj < 2; ++bj)
#pragma unroll
          for (int n = 0; n < 2; ++n) f(row, u.pn * 256 + 128 * bj + 32 * wc + 16 * n + 4 * fq, acc[ai][bj][m][n]); }
  }
};
template <class F>
__device__ __forceinline__ void gemm_phase(char* smem, const bf16_t* A, int lda, const bf16_t* Bt, int ldb, int M, int N, int K, const F f) {
  (void)ldb;
  asm volatile("" : "+s"(K));
  pg8::Gemm g{A, Bt, M, N, K, lda}; pg8::StaticOrder S; S.init(M, N, (int)gridDim.x, (int)blockIdx.x);
  EpiAdapt<F> E{f};
  pg8::gemm_phase<EpiAdapt<F>, pg8::StaticOrder, true, true>((PG8_LAS unsigned char*)smem, g, S, E);
  __syncthreads();
}

__device__ __forceinline__ void phase_prep0(const Params& p) {
  const int tid = threadIdx.x, wid = tid >> 6, lane = tid & 63;
  const bf16_t* PROJ = (const bf16_t*)(p.ws + A_PROJ);
  bf16_t* GQKV[3] = {(bf16_t*)(p.ws + A_GQ), (bf16_t*)(p.ws + A_GK), (bf16_t*)(p.ws + A_GV)};
  float* GA = (float*)(p.ws + A_GA); float* GB = (float*)(p.ws + A_GB);
  bf16_t* QLAT = (bf16_t*)(p.ws + A_QLAT); bf16_t* KVLAT = (bf16_t*)(p.ws + A_KVLAT);
  const float* cw = p.in[6];
  const int gw = blockIdx.x * NW + wid, nw = gridDim.x * NW;
  const float gA = expf(p.in[7][lane & 7]), gdt = p.in[8][lane & 7];
#pragma unroll 2
  for (int row = gw; row < MTOK; row += nw) {
    const int s = row & (SEQ - 1);
    const bf16_t* pr = PROJ + (size_t)row * PROJ_LD;
#pragma unroll
    for (int part = 0; part < 3; ++part) {
      const int col = part * 512 + lane * 8;
      float acc[8];
#pragma unroll
      for (int e = 0; e < 8; ++e) acc[e] = 0.f;
#pragma unroll
      for (int j = 0; j < 4; ++j) {
        const int ds = 3 - j;
        if (s - ds >= 0) {
          const u32x4 t = *(const u32x4*)(pr - (size_t)ds * PROJ_LD + col);
          const f32x4 w0 = *(const f32x4*)(cw + j * 1536 + col), w1 = *(const f32x4*)(cw + j * 1536 + col + 4);
          acc[0] += w0[0] * bflo(t.x); acc[1] += w0[1] * bfhi(t.x); acc[2] += w0[2] * bflo(t.y); acc[3] += w0[3] * bfhi(t.y);
          acc[4] += w1[0] * bflo(t.z); acc[5] += w1[1] * bfhi(t.z); acc[6] += w1[2] * bflo(t.w); acc[7] += w1[3] * bfhi(t.w);
        }
      }
      float ss = 0.f;
#pragma unroll
      for (int e = 0; e < 8; ++e) { acc[e] = siluf_(acc[e]); ss += acc[e] * acc[e]; }
      if (part < 2) {
        ss = group_sum<8>(ss);
        const float r = rsqrtf(ss + 1e-12f);
#pragma unroll
        for (int e = 0; e < 8; ++e) acc[e] *= r;
      }
      u32x4 w = {pk2(acc[0], acc[1]), pk2(acc[2], acc[3]), pk2(acc[4], acc[5]), pk2(acc[6], acc[7])};
      *(u32x4*)(GQKV[part] + ((size_t)((row >> 14) * 8 + (lane >> 3)) * SEQ + s) * 64 + (lane & 7) * 8) = w;
    }
    if (lane < 8) {
      const float a = bf2f(pr[2048 + lane]), bb = bf2f(pr[2056 + lane]);
      const float g = -gA * softplus_fast(a + gdt);
      GA[(size_t)row * 8 + lane] = __expf(g);
      ((float*)(p.ws + A_GG))[(size_t)row * 8 + lane] = g;
      GB[(size_t)row * 8 + lane] = sigmoidf_(bb);
    }
    {
      *(u32x4*)((bf16_t*)(p.ws + A_Z) + (size_t)row * 512 + lane * 8) = *(const u32x4*)(pr + 1536 + lane * 8);
      if (lane < 16) *(unsigned*)((bf16_t*)(p.ws + A_KR) + (size_t)row * 32 + lane * 2) = *(const unsigned*)(pr + 2448 + lane * 2);
    }
    {
      const u32x2 t = *(const u32x2*)(pr + 2064 + lane * 4);
      float v0 = bflo(t.x), v1 = bfhi(t.x), v2 = bflo(t.y), v3 = bfhi(t.y);
      float ss = wave_sum(v0 * v0 + v1 * v1 + v2 * v2 + v3 * v3);
      const float r = rsqrtf(ss * (1.f / 256.f) + 1e-6f);
      const f32x4 g = *(const f32x4*)(p.in[10] + lane * 4);
      u32x2 w = {pk2(v0 * r * g[0], v1 * r * g[1]), pk2(v2 * r * g[2], v3 * r * g[3])};
      *(u32x2*)(QLAT + (size_t)row * 256 + lane * 4) = w;
    }
    {
      const unsigned t = *(const unsigned*)(pr + 2320 + lane * 2);
      float v0 = bflo(t), v1 = bfhi(t);
      float ss = wave_sum(v0 * v0 + v1 * v1);
      const float r = rsqrtf(ss * (1.f / 128.f) + 1e-6f);
      const f32x2 g = *(const f32x2*)(p.in[11] + lane * 2);
      *(unsigned*)(KVLAT + (size_t)row * 128 + lane * 2) = pk2(v0 * r * g[0], v1 * r * g[1]);
    }
  }
}

__device__ __forceinline__ void phase_qkrope(const Params& p) {
  const int tid = threadIdx.x, wid = tid >> 6, lane = tid & 63;
  const int h = lane >> 3, sub = lane & 7;
  bf16_t* QH = (bf16_t*)((char*)p.out + O_QH); bf16_t* KH = (bf16_t*)((char*)p.out + O_KH);
  const bf16_t* KN = (const bf16_t*)(p.ws + A_KN); const bf16_t* PROJ = (const bf16_t*)(p.ws + A_PROJ);
  const int* pos = (const int*)p.in[2];
  const float* qg = p.in[14]; const float* kg = p.in[15];
  float qgn[8], kgn[8], qg1[2], qg2[2], kg1[2], kg2[2];
#pragma unroll
  for (int e = 0; e < 8; ++e) { qgn[e] = qg[sub * 8 + e]; kgn[e] = kg[sub * 8 + e]; }
#pragma unroll
  for (int e = 0; e < 2; ++e) { qg1[e] = qg[64 + 2 * sub + e]; qg2[e] = qg[80 + 2 * sub + e]; kg1[e] = kg[64 + 2 * sub + e]; kg2[e] = kg[80 + 2 * sub + e]; }
  float invf[2];
#pragma unroll
  for (int e = 0; e < 2; ++e) invf[e] = powf(10000.0f, -(float)(2 * (2 * sub + e)) / 32.0f);
  const float qscale = 0.10206207261596577f * 1.4426950408889634f;
  const int gw = blockIdx.x * NW + wid, nw = gridDim.x * NW;
#pragma unroll 2
  for (int row = gw; row < MTOK; row += nw) {
    const float fp = (float)pos[row];
    float cs[2], sn[2];
#pragma unroll
    for (int e = 0; e < 2; ++e) {
      const float ang = fp * invf[e];
      const double rev = (double)ang * 0.15915494309189535;
      const float fr = (float)(rev - rint(rev));
      sn[e] = __builtin_amdgcn_sinf(fr); cs[e] = __builtin_amdgcn_cosf(fr);
    }
    {
      bf16_t* q = QH + (size_t)row * 768 + h * 96;
      const u32x4 t = *(const u32x4*)(q + sub * 8);
      const unsigned t1 = *(const unsigned*)(q + 64 + 2 * sub), t2 = *(const unsigned*)(q + 80 + 2 * sub);
      float v[8] = {bflo(t.x), bfhi(t.x), bflo(t.y), bfhi(t.y), bflo(t.z), bfhi(t.z), bflo(t.w), bfhi(t.w)};
      float x1[2] = {bflo(t1), bfhi(t1)}, x2[2] = {bflo(t2), bfhi(t2)};
      float ss = x1[0] * x1[0] + x1[1] * x1[1] + x2[0] * x2[0] + x2[1] * x2[1];
#pragma unroll
      for (int e = 0; e < 8; ++e) ss += v[e] * v[e];
      ss = group_sum<8>(ss);
      const float r = rsqrtf(ss * (1.f / 96.f) + 1e-6f) * qscale;
#pragma unroll
      for (int e = 0; e < 8; ++e) v[e] *= r * qgn[e];
      float o1[2], o2[2];
#pragma unroll
      for (int e = 0; e < 2; ++e) { const float a = x1[e] * r * qg1[e], b = x2[e] * r * qg2[e]; o1[e] = a * cs[e] - b * sn[e]; o2[e] = b * cs[e] + a * sn[e]; }
      u32x4 w = {pk2(v[0], v[1]), pk2(v[2], v[3]), pk2(v[4], v[5]), pk2(v[6], v[7])};
      *(u32x4*)(q + sub * 8) = w; *(unsigned*)(q + 64 + 2 * sub) = pk2(o1[0], o1[1]); *(unsigned*)(q + 80 + 2 * sub) = pk2(o2[0], o2[1]);
    }
    {
      const bf16_t* kn = KN + (size_t)row * 512 + h * 64; const bf16_t* kr = (const bf16_t*)(p.ws + A_KR) + (size_t)row * 32;
      bf16_t* k = KH + (size_t)row * 768 + h * 96;
      const u32x4 t = *(const u32x4*)(kn + sub * 8);
      const unsigned t1 = *(const unsigned*)(kr + 2 * sub), t2 = *(const unsigned*)(kr + 16 + 2 * sub);
      float v[8] = {bflo(t.x), bfhi(t.x), bflo(t.y), bfhi(t.y), bflo(t.z), bfhi(t.z), bflo(t.w), bfhi(t.w)};
      float x1[2] = {bflo(t1), bfhi(t1)}, x2[2] = {bflo(t2), bfhi(t2)};
      float ss = x1[0] * x1[0] + x1[1] * x1[1] + x2[0] * x2[0] + x2[1] * x2[1];
#pragma unroll
      for (int e = 0; e < 8; ++e) ss += v[e] * v[e];
      ss = group_sum<8>(ss);
      const float r = rsqrtf(ss * (1.f / 96.f) + 1e-6f);
#pragma unroll
      for (int e = 0; e < 8; ++e) v[e] *= r * kgn[e];
      float o1[2], o2[2];
#pragma unroll
      for (int e = 0; e < 2; ++e) { const float a = x1[e] * r * kg1[e], b = x2[e] * r * kg2[e]; o1[e] = a * cs[e] - b * sn[e]; o2[e] = b * cs[e] + a * sn[e]; }
      u32x4 w = {pk2(v[0], v[1]), pk2(v[2], v[3]), pk2(v[4], v[5]), pk2(v[6], v[7])};
      *(u32x4*)(k + sub * 8) = w; *(unsigned*)(k + 64 + 2 * sub) = pk2(o1[0], o1[1]); *(unsigned*)(k + 80 + 2 * sub) = pk2(o2[0], o2[1]);
    }
  }
}

__device__ __forceinline__ float row32_sum(float x) {
  x = row16_sum(x);
  auto rr = __builtin_amdgcn_permlane32_swap(__float_as_uint(x), __float_as_uint(x), false, false);
  return __uint_as_float(rr[0]) + __uint_as_float(rr[1]);
}
template <int MODE> __device__ __forceinline__ void scan_unit(char* smem, const Params& p, int unit) {
  constexpr int T = 16, STEPF = 328, NH = MODE == 0 ? 8 : 16;
  const bool producer = threadIdx.x >= 256;
  const int tid = threadIdx.x & 255, rowl = (tid >> 6) * 2 + ((tid >> 4) & 1), j = (tid & 15) + ((tid >> 5) & 1) * 16;
  const int st = tid >> 4, sj = tid & 15;
  const int bh = unit >> 3, row0 = (unit & 7) * 8;
  const int b = bh / NH, h = bh % NH;
  float* buf = (float*)smem;
  const bf16_t* GQ = (const bf16_t*)(p.ws + A_GQ); const bf16_t* GK = (const bf16_t*)(p.ws + A_GK); const bf16_t* GV = (const bf16_t*)(p.ws + A_GV);
  const float* GA = (const float*)(p.ws + A_GA); const float* GB = (const float*)(p.ws + A_GB);
  bf16_t* GO = (bf16_t*)(p.ws + A_GO);
  const bf16_t* RKV = (const bf16_t*)(p.ws + A_RKV); const bf16_t* EE = (const bf16_t*)(p.ws + A_WL); const bf16_t* AA = (const bf16_t*)(p.ws + A_AL);
  const float* INV = (const float*)(p.ws + A_INV);
  bf16_t* Y = (bf16_t*)(p.ws + WS_H);
  f32x4 ckk = {0.f, 0.f, 0.f, 0.f}, cka = {0.f, 0.f, 0.f, 0.f};
  if (MODE == 1) { ckk = *(const f32x4*)(p.in[30] + h * 64 + 4 * sj); cka = *(const f32x4*)(p.in[31] + h * 64 + 4 * sj); }
  u32x2 g0, g1, g2, g3; float gs0 = 0.f, gs1 = 0.f; bf16_t gv = 0;
  auto gload = [&](int chunk) {
    const size_t tok = (size_t)b * SEQ + (size_t)chunk * T + st;
    if (MODE == 0) {
      g0 = *(const u32x2*)(GQ + tok * 512 + h * 64 + 4 * sj); g1 = *(const u32x2*)(GK + tok * 512 + h * 64 + 4 * sj);
      gs0 = GA[tok * 8 + h]; gs1 = GB[tok * 8 + h]; if (sj < 8) gv = GV[tok * 512 + h * 64 + row0 + sj];
    } else {
      g0 = *(const u32x2*)(RKV + tok * 3072 + h * 64 + 4 * sj); g1 = *(const u32x2*)(RKV + tok * 3072 + 1024 + h * 64 + 4 * sj);
      g2 = *(const u32x2*)(EE + tok * 1024 + h * 64 + 4 * sj); g3 = *(const u32x2*)(AA + tok * 1024 + h * 64 + 4 * sj);
      gs0 = INV[tok * 16 + h]; if (sj < 8) gv = RKV[tok * 3072 + 2048 + h * 64 + row0 + sj];
    }
  };
  auto gstore = [&](float* dst) {
    float* d = dst + st * STEPF;
    f32x4 r, w, k, a, bb; float v;
    if (MODE == 0) {
      const f32x4 q = {bflo(g0.x), bfhi(g0.x), bflo(g0.y), bfhi(g0.y)};
      k = (f32x4){bflo(g1.x), bfhi(g1.x), bflo(g1.y), bfhi(g1.y)};
      const float al = gs0, be = gs1;
      r = q * 0.125f; w = (f32x4){al, al, al, al}; a = k * (-al * be); bb = k; v = be * bf2f(gv);
    } else {
      r = (f32x4){bflo(g0.x), bfhi(g0.x), bflo(g0.y), bfhi(g0.y)};
      const f32x4 k0 = {bflo(g1.x), bfhi(g1.x), bflo(g1.y), bfhi(g1.y)};
      const f32x4 e = {bflo(g2.x), bfhi(g2.x), bflo(g2.y), bfhi(g2.y)};
      const f32x4 av = {bflo(g3.x), bfhi(g3.x), bflo(g3.y), bfhi(g3.y)};
      const f32x4 kk = k0 * ckk * gs0;
      a = -kk; bb = kk * av; k = k0 * (1.f + (av - 1.f) * cka);
      w = (f32x4){__expf(-e[0]), __expf(-e[1]), __expf(-e[2]), __expf(-e[3])};
      v = bf2f(gv);
    }
    *(f32x4*)(d + 4 * sj) = r; *(f32x4*)(d + 64 + 4 * sj) = w; *(f32x4*)(d + 128 + 4 * sj) = k; *(f32x4*)(d + 192 + 4 * sj) = a; *(f32x4*)(d + 256 + 4 * sj) = bb;
    if (sj < 8) d[320 + sj] = v;
  };
  f32x2 s = {0.f, 0.f};
  constexpr int NCH = SEQ / T;
  if (producer) { gload(0); gstore(buf); gload(1); }
  __syncthreads();
  for (int c = 0; c < NCH; ++c) {
    const float* cur = buf + (c & 1) * (T * STEPF);
    float* nxt = buf + ((c + 1) & 1) * (T * STEPF);
    if (producer) {
      if (c + 1 < NCH) gstore(nxt);
      if (c + 2 < NCH) gload(c + 2);
    } else {
    float yp[T];
    f32x2 r = *(const f32x2*)(cur + 2 * j), w = *(const f32x2*)(cur + 64 + 2 * j), k = *(const f32x2*)(cur + 128 + 2 * j),
          a = *(const f32x2*)(cur + 192 + 2 * j), bb = *(const f32x2*)(cur + 256 + 2 * j);
    float v = cur[320 + rowl];
#pragma unroll
    for (int t = 0; t < T; ++t) {
      f32x2 nr = r, nw = w, nk = k, na = a, nb = bb; float nv = v;
      if (t + 1 < T) {
        const float* d = cur + (t + 1) * STEPF;
        nr = *(const f32x2*)(d + 2 * j); nw = *(const f32x2*)(d + 64 + 2 * j); nk = *(const f32x2*)(d + 128 + 2 * j);
        na = *(const f32x2*)(d + 192 + 2 * j); nb = *(const f32x2*)(d + 256 + 2 * j); nv = d[320 + rowl];
      }
      float pa = s[0] * a[0] + s[1] * a[1];
      const f32x2 tkw = s * w + k * v;
      pa = row32_sum(pa);
      s = tkw + bb * pa;
      yp[t] = s[0] * r[0] + s[1] * r[1];
      r = nr; w = nw; k = nk; a = na; bb = nb; v = nv;
    }
    {
      float z[8];
#pragma unroll
      for (int i = 0; i < 8; ++i) { auto rr = __builtin_amdgcn_permlane32_swap(__float_as_uint(yp[i]), __float_as_uint(yp[i + 8]), false, false);
        z[i] = __uint_as_float(rr[0]) + __uint_as_float(rr[1]); }
      const int ln = threadIdx.x & 63;
      const bool b3 = (ln & 8) != 0, b2 = (ln & 4) != 0, b1 = (ln & 2) != 0;
      float n4[4], n2[2];
#pragma unroll
      for (int i = 0; i < 4; ++i) { const float wv = b3 ? z[i + 4] : z[i], ov = b3 ? z[i] : z[i + 4];
        n4[i] = wv + __int_as_float(__builtin_amdgcn_update_dpp(0, __float_as_int(ov), 0x140, 0xf, 0xf, false)); }
#pragma unroll
      for (int i = 0; i < 2; ++i) { const float wv = b2 ? n4[i + 2] : n4[i], ov = b2 ? n4[i] : n4[i + 2];
        n2[i] = wv + __int_as_float(__builtin_amdgcn_update_dpp(0, __float_as_int(ov), 0x141, 0xf, 0xf, false)); }
      const float wv = b1 ? n2[1] : n2[0], ov = b1 ? n2[0] : n2[1];
      const float n1 = wv + __int_as_float(__builtin_amdgcn_update_dpp(0, __float_as_int(ov), 0x1B, 0xf, 0xf, false));
      const float yt = n1 + __int_as_float(__builtin_amdgcn_update_dpp(0, __float_as_int(n1), 0xB1, 0xf, 0xf, false));
      if ((ln & 1) == 0) {
        const int t = 8 * (ln >> 5) + ((ln >> 1) & 7);
        const size_t tok = (size_t)b * SEQ + (size_t)c * T + t;
        if (MODE == 0) GO[tok * 512 + h * 64 + row0 + rowl] = f2bf(yt);
        else Y[tok * 1024 + h * 64 + row0 + rowl] = f2bf(yt);
      }
    }
    }
    LDS_BARRIER();
  }
  __syncthreads();
}

__device__ __forceinline__ void attn_unit(char* smem, const Params& p, int b, int h, int qb) {
  const int tid = threadIdx.x, wid = tid >> 6, lane = tid & 63, r32 = lane & 31, hi = lane >> 5;
  const bf16_t* QH = (const bf16_t*)((const char*)p.out + O_QH); const bf16_t* KH = (const bf16_t*)((const char*)p.out + O_KH);
  const bf16_t* VT = (const bf16_t*)((const char*)p.out + O_VT);
  bf16_t* MIX = (bf16_t*)(p.ws + WS_H);
  const int q0 = qb * 256, qrow = q0 + wid * 32 + r32;
  const size_t tokq = (size_t)b * SEQ + qrow;
  bf16x8 qr[6];
#pragma unroll
  for (int ks = 0; ks < 6; ++ks) qr[ks] = *(const bf16x8*)(QH + tokq * 768 + h * 96 + ks * 16 + hi * 8);
  f32x16 o0 = {}, o1 = {};
  float m = -1e30f, l = 0.f;
  const int ntiles = (q0 + 256) / 64;
  const bf16_t* Kg = KH + ((size_t)b * SEQ) * 768 + h * 96;
  const bf16_t* Vg = VT + ((size_t)(b * 8 + h) * 64) * SEQ;
  int krow[2], kc[2];
#pragma unroll
  for (int i = 0; i < 2; ++i) { const int id = tid + 512 * i; krow[i] = id / 12; kc[i] = id % 12; }
  const bool k2 = tid < 256;
  const int vrow = tid >> 3, vc = tid & 7;
  u32x4 rk[2], rv;
  rk[1] = (u32x4){0u, 0u, 0u, 0u};
  constexpr int STG = 22528, KSZ = 13312;
  auto gload = [&](int t) {
    const int kv0 = t * 64;
    rk[0] = *(const u32x4*)(Kg + (size_t)(kv0 + krow[0]) * 768 + kc[0] * 8);
    if (k2) rk[1] = *(const u32x4*)(Kg + (size_t)(kv0 + krow[1]) * 768 + kc[1] * 8);
    rv = *(const u32x4*)(Vg + (size_t)vrow * SEQ + kv0 + vc * 8);
  };
  auto sstore = [&](char* st) {
    *(u32x4*)(st + krow[0] * 208 + kc[0] * 16) = rk[0];
    if (k2) *(u32x4*)(st + krow[1] * 208 + kc[1] * 16) = rk[1];
    { char* d = st + KSZ + vrow * 144 + (vc >> 1) * 32 + (vc & 1) * 8;
      *(u32x2*)d = (u32x2){rv.x, rv.y}; *(u32x2*)(d + 16) = (u32x2){rv.z, rv.w}; }
  };
  gload(0); sstore(smem);
  __syncthreads();
  for (int t = 0; t < ntiles; ++t) {
    char* cur = smem + (t & 1) * STG; char* nxt = smem + ((t + 1) & 1) * STG;
    const bool more = t + 1 < ntiles;
    if (more) gload(t + 1);
    const int kv0 = t * 64;
    const int wq0 = q0 + wid * 32;
    if (kv0 <= wq0 + 31) {
      f32x16 s0 = {}, s1 = {};
#pragma unroll
      for (int ks = 0; ks < 6; ++ks) {
        const bf16x8 k0 = *(const bf16x8*)(cur + r32 * 208 + ks * 32 + hi * 16);
        const bf16x8 k1 = *(const bf16x8*)(cur + (32 + r32) * 208 + ks * 32 + hi * 16);
        s0 = __builtin_amdgcn_mfma_f32_32x32x16_bf16(k0, qr[ks], s0, 0, 0, 0);
        s1 = __builtin_amdgcn_mfma_f32_32x32x16_bf16(k1, qr[ks], s1, 0, 0, 0);
      }
      if (kv0 + 63 > wq0) {
#pragma unroll
        for (int r = 0; r < 16; ++r) { const int kv = kv0 + (r & 3) + 8 * (r >> 2) + 4 * hi; if (kv > qrow) s0[r] = -INFINITY; if (kv + 32 > qrow) s1[r] = -INFINITY; }
      }
      float mx = fmaxf(s0[0], s1[0]);
#pragma unroll
      for (int r = 1; r < 16; ++r) mx = fmaxf(mx, fmaxf(s0[r], s1[r]));
      { auto rr = __builtin_amdgcn_permlane32_swap(__float_as_uint(mx), __float_as_uint(mx), false, false); mx = fmaxf(__uint_as_float(rr[0]), __uint_as_float(rr[1])); }
      const float mn = fmaxf(m, mx);
      if (__any(mn > m)) {
        const float f = __builtin_amdgcn_exp2f(m - mn);
        m = mn; l *= f;
#pragma unroll
        for (int r = 0; r < 16; ++r) { o0[r] *= f; o1[r] *= f; }
      }
      float ps = 0.f;
#pragma unroll
      for (int r = 0; r < 16; ++r) { s0[r] = __builtin_amdgcn_exp2f(s0[r] - mn); s1[r] = __builtin_amdgcn_exp2f(s1[r] - mn); ps += s0[r] + s1[r]; }
      l += ps;
      bf16x8 pf[4];
      { u32x4 w;
        w = (u32x4){pk2(s0[0], s0[1]), pk2(s0[2], s0[3]), pk2(s0[4], s0[5]), pk2(s0[6], s0[7])}; pf[0] = __builtin_bit_cast(bf16x8, w);
        w = (u32x4){pk2(s0[8], s0[9]), pk2(s0[10], s0[11]), pk2(s0[12], s0[13]), pk2(s0[14], s0[15])}; pf[1] = __builtin_bit_cast(bf16x8, w);
        w = (u32x4){pk2(s1[0], s1[1]), pk2(s1[2], s1[3]), pk2(s1[4], s1[5]), pk2(s1[6], s1[7])}; pf[2] = __builtin_bit_cast(bf16x8, w);
        w = (u32x4){pk2(s1[8], s1[9]), pk2(s1[10], s1[11]), pk2(s1[12], s1[13]), pk2(s1[14], s1[15])}; pf[3] = __builtin_bit_cast(bf16x8, w); }
#pragma unroll
      for (int ks = 0; ks < 4; ++ks) {
        const bf16x8 v0 = *(const bf16x8*)(cur + KSZ + r32 * 144 + ks * 32 + hi * 16);
        const bf16x8 v1 = *(const bf16x8*)(cur + KSZ + (32 + r32) * 144 + ks * 32 + hi * 16);
        o0 = __builtin_amdgcn_mfma_f32_32x32x16_bf16(v0, pf[ks], o0, 0, 0, 0);
        o1 = __builtin_amdgcn_mfma_f32_32x32x16_bf16(v1, pf[ks], o1, 0, 0, 0);
      }
    }
    if (more) sstore(nxt);
    __syncthreads();
  }
  { auto rr = __builtin_amdgcn_permlane32_swap(__float_as_uint(l), __float_as_uint(l), false, false); l = __uint_as_float(rr[0]) + __uint_as_float(rr[1]); }
  const float il = 1.f / l;
  bf16_t* orow = MIX + tokq * 1024 + 512 + h * 64;
#pragma unroll
  for (int g = 0; g < 4; ++g) {
    const int d = 8 * g + 4 * hi;
    u32x2 w0 = {pk2(o0[4 * g] * il, o0[4 * g + 1] * il), pk2(o0[4 * g + 2] * il, o0[4 * g + 3] * il)};
    u32x2 w1 = {pk2(o1[4 * g] * il, o1[4 * g + 1] * il), pk2(o1[4 * g + 2] * il, o1[4 * g + 3] * il)};
    *(u32x2*)(orow + d) = w0; *(u32x2*)(orow + 32 + d) = w1;
  }
}

__device__ __forceinline__ void phase_gdnchunk(char* smem, const Params& p) {
  const int tid = threadIdx.x, wid = tid >> 6, lane = tid & 63, r32 = lane & 31, hi = lane >> 5;
  if (wid >= 2) return;
  char* wl = smem + wid * 65536;
  float* At = (float*)wl;
  float* XU = (float*)(wl + 16384);
  float* XW = (float*)(wl + 32768);
  bf16_t* T1 = (bf16_t*)(wl + 49152);
  bf16_t* T2 = (bf16_t*)(wl + 57344);
  float* tab = (float*)(smem + CTLW + 256 + wid * 512);
  const bf16_t* GQ = (const bf16_t*)(p.ws + A_GQ); const bf16_t* GK = (const bf16_t*)(p.ws + A_GK); const bf16_t* GV = (const bf16_t*)(p.ws + A_GV);
  const float* GG = (const float*)(p.ws + A_GG); const float* GB = (const float*)(p.ws + A_GB);
  bf16_t* CW = (bf16_t*)(p.ws + A_CW); bf16_t* CU = (bf16_t*)(p.ws + A_CU); bf16_t* CQK = (bf16_t*)(p.ws + A_CQK);
  bf16_t* CKD = (bf16_t*)(p.ws + A_CKD); bf16_t* CQD = (bf16_t*)(p.ws + A_CQD); float* GL = (float*)(p.ws + A_GL);
  const int crw = lane >> 3, cch = lane & 7;
  const int c = lane;
#define LWAIT() asm volatile("s_waitcnt lgkmcnt(0)" ::: "memory")
#pragma unroll 1
  for (int unit = blockIdx.x * 2 + wid; unit < 4096; unit += gridDim.x * 2) {
    const int bh = unit >> 8, n = unit & 255, b = bh >> 3, h = bh & 7;
    const size_t tok0 = (size_t)b * SEQ + (size_t)n * 64;
    const size_t hoff = ((size_t)bh * SEQ + (size_t)n * 64) * 64;
    const bf16_t* kbase = GK + hoff; const bf16_t* qbase = GQ + hoff; const bf16_t* vbase = GV + hoff;
    float gc = GG[(tok0 + lane) * 8 + h]; const float be = GB[(tok0 + lane) * 8 + h];
#pragma unroll
    for (int o = 1; o < 64; o <<= 1) { const float t = __shfl_up(gc, o); if (lane >= o) gc += t; }
    tab[lane] = gc; tab[64 + lane] = be;
    const float gl = __shfl(gc, 63);
    LWAIT();
#pragma unroll 1
    for (int pass = 0; pass < 2; ++pass) {
      const bf16_t* abase = pass == 0 ? kbase : qbase;
      f32x16 acc[2][2];
#pragma unroll
      for (int i = 0; i < 2; ++i)
#pragma unroll
        for (int jj = 0; jj < 2; ++jj) acc[i][jj] = (f32x16){};
#pragma unroll
      for (int ks = 0; ks < 4; ++ks) {
        bf16x8 ka[2], aa[2];
#pragma unroll
        for (int ib = 0; ib < 2; ++ib) {
          ka[ib] = *(const bf16x8*)(kbase + (size_t)(ib * 32 + r32) * 64 + ks * 16 + hi * 8);
          aa[ib] = *(const bf16x8*)(abase + (size_t)(ib * 32 + r32) * 64 + ks * 16 + hi * 8);
        }
#pragma unroll
        for (int ib = 0; ib < 2; ++ib)
#pragma unroll
          for (int jb = 0; jb < 2; ++jb) acc[ib][jb] = __builtin_amdgcn_mfma_f32_32x32x16_bf16(aa[ib], ka[jb], acc[ib][jb], 0, 0, 0);
      }
#pragma unroll
      for (int ib = 0; ib < 2; ++ib)
#pragma unroll
        for (int jb = 0; jb < 2; ++jb) {
          const int j = jb * 32 + r32; const float gcj = tab[j];
#pragma unroll
          for (int r = 0; r < 16; ++r) {
            const int i = ib * 32 + (r & 3) + 8 * (r >> 2) + 4 * hi;
            const float dec = __expf(fminf(tab[i] - gcj, 0.f));
            if (pass == 0) At[j * 64 + i] = (i > j) ? tab[64 + i] * acc[ib][jb][r] * dec : 0.f;
            else T2[i * 64 + j] = f2bf((i >= j) ? acc[ib][jb][r] * 0.125f * dec : 0.f);
          }
        }
      LWAIT();
    }
#pragma unroll
    for (int it = 0; it < 8; ++it) {
      const int row = it * 8 + crw;
      *(u32x4*)(CQK + (size_t)unit * 4096 + row * 64 + cch * 8) = *(const u32x4*)(T2 + row * 64 + cch * 8);
      *(u32x4*)(T1 + row * 64 + cch * 8) = *(const u32x4*)(kbase + (size_t)row * 64 + cch * 8);
    }
    LWAIT();
#pragma unroll
    for (int it = 0; it < 8; ++it) { const int row = it * 8 + crw; *(u32x4*)(T2 + row * 64 + cch * 8) = *(const u32x4*)(vbase + (size_t)row * 64 + cch * 8); }
    LWAIT();
#pragma unroll 1
    for (int i0 = 0; i0 < 64; i0 += 8) {
      float kd[8];
#pragma unroll
      for (int q = 0; q < 8; ++q) {
        const int i = i0 + q; const float kv = bf2f(T1[i * 64 + c]), gci = tab[i], bi = tab[64 + i];
        kd[q] = kv * __expf(fminf(gl - gci, 0.f));
        XU[i * 64 + c] = bi * bf2f(T2[i * 64 + c]);
        XW[i * 64 + c] = bi * __expf(gci) * kv;
      }
      u32x4 w = {pk2(kd[0], kd[1]), pk2(kd[2], kd[3]), pk2(kd[4], kd[5]), pk2(kd[6], kd[7])};
      *(u32x4*)(CKD + (size_t)unit * 4096 + c * 64 + i0) = w;
    }
    LWAIT();
#pragma unroll 1
    for (int I = 0; I < 4; ++I) {
      const int i0 = 16 * I;
      float xu[16], xw[16];
#pragma unroll
      for (int ii = 0; ii < 16; ++ii) { xu[ii] = XU[(i0 + ii) * 64 + c]; xw[ii] = XW[(i0 + ii) * 64 + c]; }
#pragma unroll 2
      for (int j = 0; j < i0; ++j) {
        const float uj = XU[j * 64 + c], wj = XW[j * 64 + c];
        const f32x4 a0 = *(const f32x4*)(At + j * 64 + i0), a1 = *(const f32x4*)(At + j * 64 + i0 + 4),
                    a2 = *(const f32x4*)(At + j * 64 + i0 + 8), a3 = *(const f32x4*)(At + j * 64 + i0 + 12);
#pragma unroll
        for (int q = 0; q < 4; ++q) {
          xu[q] -= a0[q] * uj; xw[q] -= a0[q] * wj; xu[4 + q] -= a1[q] * uj; xw[4 + q] -= a1[q] * wj;
          xu[8 + q] -= a2[q] * uj; xw[8 + q] -= a2[q] * wj; xu[12 + q] -= a3[q] * uj; xw[12 + q] -= a3[q] * wj;
        }
      }
#pragma unroll
      for (int jj = 0; jj < 15; ++jj) {
        const float* ar = At + (i0 + jj) * 64 + i0;
#pragma unroll
        for (int ii = jj + 1; ii < 16; ++ii) { const float av = ar[ii]; xu[ii] -= av * xu[jj]; xw[ii] -= av * xw[jj]; }
      }
#pragma unroll
      for (int ii = 0; ii < 16; ++ii) { XU[(i0 + ii) * 64 + c] = xu[ii]; XW[(i0 + ii) * 64 + c] = xw[ii]; }
      LWAIT();
    }
#pragma unroll 8
    for (int i = 0; i < 64; ++i) { T2[i * 64 + c] = f2bf(XU[i * 64 + c]); T1[i * 64 + c] = f2bf(XW[i * 64 + c]); }
    LWAIT();
#pragma unroll
    for (int it = 0; it < 8; ++it) {
      const int row = it * 8 + crw;
      *(u32x4*)(CU + (size_t)unit * 4096 + row * 64 + cch * 8) = *(const u32x4*)(T2 + row * 64 + cch * 8);
      *(u32x4*)(CW + (size_t)unit * 4096 + row * 64 + cch * 8) = *(const u32x4*)(T1 + row * 64 + cch * 8);
      const u32x4 qv = *(const u32x4*)(qbase + (size_t)row * 64 + cch * 8);
      const float sc = 0.125f * __expf(tab[row]);
      u32x4 qo = {pk2(bflo(qv.x) * sc, bfhi(qv.x) * sc), pk2(bflo(qv.y) * sc, bfhi(qv.y) * sc), pk2(bflo(qv.z) * sc, bfhi(qv.z) * sc), pk2(bflo(qv.w) * sc, bfhi(qv.w) * sc)};
      *(u32x4*)(CQD + (size_t)unit * 4096 + row * 64 + cch * 8) = qo;
    }
    if (lane == 0) GL[unit] = __expf(gl);
    LWAIT();
  }
#undef LWAIT
}

__device__ __forceinline__ void gdn_chunk_scan(char* smem, const Params& p, int bh) {
  constexpr int TB = 9216, IMG = 5 * TB;
  const int tid = threadIdx.x, wid = tid >> 6, lane = tid & 63, r32 = lane & 31, hi = lane >> 5;
  const int sg = (r32 & ~12) | ((r32 & 4) << 1) | ((r32 & 8) >> 1);
  const int b = bh >> 3, h = bh & 7;
  const bf16_t* SRC[5] = {(const bf16_t*)(p.ws + A_CW), (const bf16_t*)(p.ws + A_CQD), (const bf16_t*)(p.ws + A_CQK), (const bf16_t*)(p.ws + A_CKD), (const bf16_t*)(p.ws + A_CU)};
  const float* GL = (const float*)(p.ws + A_GL);
  bf16_t* GO = (bf16_t*)(p.ws + A_GO);
  const bool loader = wid >= 2;
  const int ltid = tid - 128;
  u32x4 lr[7];
#pragma unroll
  for (int i = 0; i < 7; ++i) lr[i] = (u32x4){0u, 0u, 0u, 0u};
  auto lload = [&](int n) {
    const size_t ub = ((size_t)bh * 256 + n) * 4096;
#pragma unroll
    for (int i = 0; i < 7; ++i) { const int id = ltid + 384 * i;
      if (id < 2560) { const int tile = id >> 9, w = id & 511; const bf16_t* src = tile == 0 ? SRC[0] : tile == 1 ? SRC[1] : tile == 2 ? SRC[2] : tile == 3 ? SRC[3] : SRC[4];
        lr[i] = *(const u32x4*)(src + ub + (w >> 3) * 64 + (w & 7) * 8); } }
  };
  auto lstore = [&](char* img) {
#pragma unroll
    for (int i = 0; i < 7; ++i) { const int id = ltid + 384 * i;
      if (id < 2560) { const int tile = id >> 9, w = id & 511; *(u32x4*)(img + tile * TB + (w >> 3) * 144 + (w & 7) * 16) = lr[i]; } }
  };
  f32x16 S[2]; S[0] = (f32x16){}; S[1] = (f32x16){};
  const int dv = wid * 32 + r32;
  if (loader) { lload(0); lstore(smem); lload(1); }
  __syncthreads();
  float egl = loader ? 0.f : GL[bh * 256];
  for (int n = 0; n < 256; ++n) {
    const char* cur = smem + (n & 1) * IMG; char* nxt = smem + ((n + 1) & 1) * IMG;
    if (loader) {
      if (n + 1 < 256) lstore(nxt);
      if (n + 2 < 256) lload(n + 2);
    } else {
      const float egl_n = egl;
      if (n + 1 < 256) egl = GL[bh * 256 + n + 1];
      const size_t tok0 = (size_t)b * SEQ + (size_t)n * 64;
      bf16x8 sb[4];
#pragma unroll
      for (int ks = 0; ks < 4; ++ks) { const f32x16& q = S[ks >> 1]; const int o = 8 * (ks & 1);
        u32x4 w = {pk2(q[o], q[o + 1]), pk2(q[o + 2], q[o + 3]), pk2(q[o + 4], q[o + 5]), pk2(q[o + 6], q[o + 7])}; sb[ks] = __builtin_bit_cast(bf16x8, w); }
      f32x16 vn[2]; vn[0] = (f32x16){}; vn[1] = (f32x16){};
      f32x16 o[2]; o[0] = (f32x16){}; o[1] = (f32x16){};
#pragma unroll
      for (int tb = 0; tb < 2; ++tb)
#pragma unroll
        for (int ks = 0; ks < 4; ++ks) {
          const bf16x8 wf = *(const bf16x8*)(cur + 0 * TB + (tb * 32 + sg) * 144 + ks * 32 + hi * 16);
          const bf16x8 qf = *(const bf16x8*)(cur + 1 * TB + (tb * 32 + r32) * 144 + ks * 32 + hi * 16);
          vn[tb] = __builtin_amdgcn_mfma_f32_32x32x16_bf16(wf, sb[ks], vn[tb], 0, 0, 0);
          o[tb] = __builtin_amdgcn_mfma_f32_32x32x16_bf16(qf, sb[ks], o[tb], 0, 0, 0);
        }
#pragma unroll
      for (int tb = 0; tb < 2; ++tb)
#pragma unroll
        for (int r = 0; r < 16; ++r) { const int t = tb * 32 + 16 * (r >> 3) + 8 * hi + (r & 7);
          vn[tb][r] = bf2f(*(const bf16_t*)(cur + 4 * TB + t * 144 + dv * 2)) - vn[tb][r]; }
      bf16x8 vb[4];
#pragma unroll
      for (int ks = 0; ks < 4; ++ks) { const f32x16& q = vn[ks >> 1]; const int o8 = 8 * (ks & 1);
        u32x4 w = {pk2(q[o8], q[o8 + 1]), pk2(q[o8 + 2], q[o8 + 3]), pk2(q[o8 + 4], q[o8 + 5]), pk2(q[o8 + 6], q[o8 + 7])}; vb[ks] = __builtin_bit_cast(bf16x8, w); }
#pragma unroll
      for (int r = 0; r < 16; ++r) { S[0][r] *= egl_n; S[1][r] *= egl_n; }
#pragma unroll
      for (int tb = 0; tb < 2; ++tb)
#pragma unroll
        for (int ks = 0; ks < 4; ++ks) {
          const bf16x8 af = *(const bf16x8*)(cur + 2 * TB + (tb * 32 + r32) * 144 + ks * 32 + hi * 16);
          const bf16x8 kf = *(const bf16x8*)(cur + 3 * TB + (tb * 32 + sg) * 144 + ks * 32 + hi * 16);
          o[tb] = __builtin_amdgcn_mfma_f32_32x32x16_bf16(af, vb[ks], o[tb], 0, 0, 0);
          S[tb] = __builtin_amdgcn_mfma_f32_32x32x16_bf16(kf, vb[ks], S[tb], 0, 0, 0);
        }
#pragma unroll
      for (int tb = 0; tb < 2; ++tb)
#pragma unroll
        for (int r = 0; r < 16; ++r) { const int t = tb * 32 + (r & 3) + 8 * (r >> 2) + 4 * hi; GO[(tok0 + t) * 512 + h * 64 + dv] = f2bf(o[tb][r]); }
    }
    LDS_BARRIER();
  }
  __syncthreads();
}

__device__ __forceinline__ void phase_mix0(char* smem, const Params& p, int rep) {
  if (rep == 0 && blockIdx.x < 16) gdn_chunk_scan(smem, p, blockIdx.x);
  __syncthreads();
  unsigned* ctr = (unsigned*)(p.ws + WS_CTL) + rep;
  volatile int* sh = (volatile int*)(smem + CTLW);
  for (;;) {
    if (threadIdx.x == 0) sh[0] = (int)atomicAdd(ctr, 1u);
    __syncthreads();
    const int u = sh[0];
    __syncthreads();
    if (u >= 1024) break;
    attn_unit(smem, p, (u & 15) >> 3, u & 7, 63 - (u >> 4));
  }
}

__device__ __forceinline__ void phase_gdnpost(const Params& p) {
  const int tid = threadIdx.x, wid = tid >> 6, lane = tid & 63;
  const bf16_t* GO = (const bf16_t*)(p.ws + A_GO); const bf16_t* PROJ = (const bf16_t*)(p.ws + A_PROJ);
  bf16_t* MIX = (bf16_t*)(p.ws + WS_H);
  const int sub = lane & 7;
  float gn[8];
#pragma unroll
  for (int e = 0; e < 8; ++e) gn[e] = p.in[9][sub * 8 + e];
  const int gw = blockIdx.x * NW + wid, nw = gridDim.x * NW;
#pragma unroll 2
  for (int row = gw; row < MTOK; row += nw) {
    const u32x4 t = *(const u32x4*)(GO + (size_t)row * 512 + lane * 8);
    const u32x4 z = *(const u32x4*)((const bf16_t*)(p.ws + A_Z) + (size_t)row * 512 + lane * 8);
    float v[8] = {bflo(t.x), bfhi(t.x), bflo(t.y), bfhi(t.y), bflo(t.z), bfhi(t.z), bflo(t.w), bfhi(t.w)};
    float zz[8] = {bflo(z.x), bfhi(z.x), bflo(z.y), bfhi(z.y), bflo(z.z), bfhi(z.z), bflo(z.w), bfhi(z.w)};
    float ss = 0.f;
#pragma unroll
    for (int e = 0; e < 8; ++e) ss += v[e] * v[e];
    ss = group_sum<8>(ss);
    const float r = rsqrtf(ss * (1.f / 64.f) + 1e-6f);
#pragma unroll
    for (int e = 0; e < 8; ++e) v[e] = v[e] * r * gn[e] * siluf_(zz[e]);
    u32x4 w = {pk2(v[0], v[1]), pk2(v[2], v[3]), pk2(v[4], v[5]), pk2(v[6], v[7])};
    *(u32x4*)(MIX + (size_t)row * 1024 + lane * 8) = w;
  }
}

__device__ __forceinline__ void phase_prep1(const Params& p) {
  const int tid = threadIdx.x, wid = tid >> 6, lane = tid & 63;
  bf16_t* WL = (bf16_t*)(p.ws + A_WL); bf16_t* AL = (bf16_t*)(p.ws + A_AL);
  const bf16_t* RKV = (const bf16_t*)(p.ws + A_RKV);
  float* INV = (float*)(p.ws + A_INV); float* SB = (float*)(p.ws + A_SB);
  const int col = lane * 16, h = lane >> 2;
  const int gw = blockIdx.x * NW + wid, nw = gridDim.x * NW;
  float cw0[16], ca0[16], ckk[16], cka[16], crk[16];
#pragma unroll
  for (int e = 0; e < 16; ++e) { cw0[e] = p.in[22][col + e]; ca0[e] = p.in[25][col + e]; ckk[e] = p.in[30][col + e]; cka[e] = p.in[31][col + e]; crk[e] = p.in[32][col + e]; }
#pragma unroll 2
  for (int row = gw; row < MTOK; row += nw) {
    float ssk = 0.f, sb = 0.f;
#pragma unroll
    for (int half = 0; half < 2; ++half) {
      const int c0 = col + half * 8;
      const u32x4 tw = *(const u32x4*)(WL + (size_t)row * 1024 + c0), ta = *(const u32x4*)(AL + (size_t)row * 1024 + c0);
      const u32x4 tr = *(const u32x4*)(RKV + (size_t)row * 3072 + c0), tk = *(const u32x4*)(RKV + (size_t)row * 3072 + 1024 + c0);
      float wl[8] = {bflo(tw.x), bfhi(tw.x), bflo(tw.y), bfhi(tw.y), bflo(tw.z), bfhi(tw.z), bflo(tw.w), bfhi(tw.w)};
      float al[8] = {bflo(ta.x), bfhi(ta.x), bflo(ta.y), bfhi(ta.y), bflo(ta.z), bfhi(ta.z), bflo(ta.w), bfhi(ta.w)};
      float rr[8] = {bflo(tr.x), bfhi(tr.x), bflo(tr.y), bfhi(tr.y), bflo(tr.z), bfhi(tr.z), bflo(tr.w), bfhi(tr.w)};
      float kk[8] = {bflo(tk.x), bfhi(tk.x), bflo(tk.y), bfhi(tk.y), bflo(tk.z), bfhi(tk.z), bflo(tk.w), bfhi(tk.w)};
      float eo[8], ao[8];
#pragma unroll
      for (int e = 0; e < 8; ++e) {
        const int c = c0 + e;
        eo[e] = 0.6065306597126334f * sigmoidf_(cw0[half * 8 + e] + wl[e]);
        const float a = sigmoidf_(ca0[half * 8 + e] + al[e]);
        const unsigned ab = pk2(a, 0.f); const float ar = bflo(ab);
        ao[e] = a;
        const float kkv = kk[e] * ckk[half * 8 + e]; ssk += kkv * kkv;
        const float kp = kk[e] * (1.f + (ar - 1.f) * cka[half * 8 + e]);
        sb += rr[e] * kp * crk[half * 8 + e];
      }
      u32x4 we = {pk2(eo[0], eo[1]), pk2(eo[2], eo[3]), pk2(eo[4], eo[5]), pk2(eo[6], eo[7])};
      u32x4 wa = {pk2(ao[0], ao[1]), pk2(ao[2], ao[3]), pk2(ao[4], ao[5]), pk2(ao[6], ao[7])};
      *(u32x4*)(WL + (size_t)row * 1024 + c0) = we; *(u32x4*)(AL + (size_t)row * 1024 + c0) = wa;
    }
    ssk = group_sum<4>(ssk); sb = group_sum<4>(sb);
    if ((lane & 3) == 0) { INV[(size_t)row * 16 + h] = rsqrtf(ssk + 1e-12f); SB[(size_t)row * 16 + h] = sb; }
  }
}

__device__ __forceinline__ void phase_post1(const Params& p) {
  const int tid = threadIdx.x, wid = tid >> 6, lane = tid & 63;
  const bf16_t* Y = (const bf16_t*)(p.ws + WS_H); const bf16_t* G = (const bf16_t*)(p.ws + A_WL);
  const bf16_t* RKV = (const bf16_t*)(p.ws + A_RKV); const float* SB = (const float*)(p.ws + A_SB);
  bf16_t* YG = (bf16_t*)(p.ws + A_AL);
  const int col = lane * 16, h = lane >> 2;
  const int gw = blockIdx.x * NW + wid, nw = gridDim.x * NW;
  float lng[16], lnb[16];
#pragma unroll
  for (int e = 0; e < 16; ++e) { lng[e] = p.in[33][col + e]; lnb[e] = p.in[34][col + e]; }
#pragma unroll 2
  for (int row = gw; row < MTOK; row += nw) {
    float y[16]; float sm = 0.f;
#pragma unroll
    for (int half = 0; half < 2; ++half) {
      const u32x4 t = *(const u32x4*)(Y + (size_t)row * 1024 + col + half * 8);
      float* d = y + half * 8;
      d[0] = bflo(t.x); d[1] = bfhi(t.x); d[2] = bflo(t.y); d[3] = bfhi(t.y); d[4] = bflo(t.z); d[5] = bfhi(t.z); d[6] = bflo(t.w); d[7] = bfhi(t.w);
    }
#pragma unroll
    for (int e = 0; e < 16; ++e) sm += y[e];
    sm = group_sum<4>(sm);
    const float mean = sm * (1.f / 64.f);
    float vs = 0.f;
#pragma unroll
    for (int e = 0; e < 16; ++e) { const float dlt = y[e] - mean; vs += dlt * dlt; }
    vs = group_sum<4>(vs);
    const float rstd = rsqrtf(vs * (1.f / 64.f) + 64e-5f);
    const float sb = SB[(size_t)row * 16 + h];
#pragma unroll
    for (int half = 0; half < 2; ++half) {
      const int c0 = col + half * 8;
      const u32x4 tv = *(const u32x4*)(RKV + (size_t)row * 3072 + 2048 + c0), tg = *(const u32x4*)(G + (size_t)row * 1024 + c0);
      float vv[8] = {bflo(tv.x), bfhi(tv.x), bflo(tv.y), bfhi(tv.y), bflo(tv.z), bfhi(tv.z), bflo(tv.w), bfhi(tv.w)};
      float gg[8] = {bflo(tg.x), bfhi(tg.x), bflo(tg.y), bfhi(tg.y), bflo(tg.z), bfhi(tg.z), bflo(tg.w), bfhi(tg.w)};
      float o[8];
#pragma unroll
      for (int e = 0; e < 8; ++e) { const int c = c0 + e; o[e] = ((y[half * 8 + e] - mean) * rstd * lng[half * 8 + e] + lnb[half * 8 + e] + sb * vv[e]) * gg[e]; }
      u32x4 w = {pk2(o[0], o[1]), pk2(o[2], o[3]), pk2(o[4], o[5]), pk2(o[6], o[7])};
      *(u32x4*)(YG + (size_t)row * 1024 + c0) = w;
    }
  }
}

constexpr int NPHASE = 22;
__device__ __forceinline__ void run_phase(int ph, char* smem, const Params& p, int rep = 0) {
  bf16_t* WT = (bf16_t*)(p.ws + WS_WT);
  bf16_t* H = (bf16_t*)(p.ws + WS_H);
  const float* MOD = (const float*)(p.ws + WS_MOD);
  switch (ONLY >= 0 ? ONLY : ph) {
    case 0: phase_prologue(smem, p); break;
    case 1: phase_adaln<0>(p, p.in[0], 0, 0, H); break;
    case 2: gemm_phase(smem, H, 1024, WT + W_IN, 1024, MTOK, 2560, 1024, EpiStore{(bf16_t*)(p.ws + A_PROJ), PROJ_LD}); break;
    case 3: phase_prep0(p); break;
    case 4: gemm_phase(smem, (const bf16_t*)(p.ws + A_QLAT), 256, WT + W_UQ, 256, MTOK, 768, 256, EpiStore{(bf16_t*)((char*)p.out + O_QH), 768}); break;
    case 5: gemm_phase(smem, (const bf16_t*)(p.ws + A_KVLAT), 128, WT + W_UKV, 128, MTOK, 1024, 128, EpiKV{(bf16_t*)(p.ws + A_KN), (bf16_t*)((char*)p.out + O_VT)}); break;
    case 6: phase_qkrope(p); phase_gdnchunk(smem, p); break;
    case 7: phase_mix0(smem, p, rep); break;
    case 8: phase_gdnpost(p); break;
    case 9: gemm_phase(smem, H, 1024, WT + W_OUT, 1024, MTOK, 1024, 1024, EpiResid{p.in[0], p.out, MOD + 2048}); break;
    case 10: phase_adaln<0>(p, p.out, 0, 1, H); break;
    case 11: gemm_phase(smem, H, 1024, WT + W_UP0, 1024, MTOK, 4096, 1024, EpiUp{(bf16_t*)(p.ws + A_U)}); break;
    case 12: gemm_phase(smem, (const bf16_t*)(p.ws + A_U), 4096, WT + W_DN0, 4096, MTOK, 1024, 4096, EpiResid{p.out, p.out, MOD + 5120}); break;
    case 13: phase_adaln<1>(p, p.out, 1, 0, (bf16_t*)(p.ws + A_A2)); break;
    case 14: gemm_phase(smem, (const bf16_t*)(p.ws + A_A2), 2048, WT + W_RKV, 2048, MTOK, 3584, 2048, EpiRkv{(bf16_t*)(p.ws + A_RKV), (bf16_t*)(p.ws + A_LORA)}); break;
    case 15: gemm_phase(smem, (const bf16_t*)(p.ws + A_LORA), 384, WT + W_W2, 128, MTOK, 1024, 128, EpiStore{(bf16_t*)(p.ws + A_WL), 1024}); break;
    case 16: gemm_phase(smem, (const bf16_t*)(p.ws + A_LORA) + 64, 384, WT + W_A2, 128, MTOK, 1024, 128, EpiStore{(bf16_t*)(p.ws + A_AL), 1024}); break;
    case 17: phase_prep1(p); break;
    case 18: if (blockIdx.x < 256) { const int i = blockIdx.x, x = i & 7, sl = i >> 3; scan_unit<1>(smem, p, ((x * 4 + (sl >> 3)) << 3) | (sl & 7)); } break;
    case 19: gemm_phase(smem, (const bf16_t*)(p.ws + A_LORA) + 128, 384, WT + W_G2, 256, MTOK, 1024, 256, EpiStore{(bf16_t*)(p.ws + A_WL), 1024}); break;
    case 20: phase_post1(p); break;
    case 21: gemm_phase(smem, (const bf16_t*)(p.ws + A_AL), 1024, WT + W_O, 1024, MTOK, 1024, 1024, EpiResid{p.out, p.out, MOD + 2 * 6144 + 2048}); break;
    case 22: phase_adaln<0>(p, p.out, 1, 1, H); break;
    case 23: gemm_phase(smem, H, 1024, WT + W_UP1, 1024, MTOK, 4096, 1024, EpiUp{(bf16_t*)(p.ws + A_U)}); break;
    case 24: gemm_phase(smem, (const bf16_t*)(p.ws + A_U), 4096, WT + W_DN1, 4096, MTOK, 1024, 4096, EpiResid{p.out, p.out, MOD + 2 * 6144 + 5120}); break;
  }
}

__device__ __forceinline__ constexpr bool sync_after(int ph) { return !(ph == 4 || ph == 15); }
__device__ __forceinline__ void grid_barrier(const Params& p, unsigned& nbar) {
  __syncthreads();
  if (threadIdx.x == 0) {
    unsigned* ctr = (unsigned*)(p.ws + WS_CTL) + 32;
    nbar += gridDim.x;
    __builtin_amdgcn_fence(__ATOMIC_RELEASE, "agent");
    __hip_atomic_fetch_add(ctr, 1u, __ATOMIC_RELAXED, __HIP_MEMORY_SCOPE_AGENT);
    while (__hip_atomic_load(ctr, __ATOMIC_RELAXED, __HIP_MEMORY_SCOPE_AGENT) < nbar) __builtin_amdgcn_s_sleep(2);
    __builtin_amdgcn_fence(__ATOMIC_ACQUIRE, "agent");
  }
  __syncthreads();
}
template <int PH> __device__ __forceinline__ void do_phase(char* smem, const Params& p, int lo, int hi, unsigned& nbar) {
  if (lo <= PH && PH < hi) {
    if ((PROBE_MASK >> PH) & 1u) { run_phase(PH, smem, p, 1); grid_barrier(p, nbar); }
    run_phase(PH, smem, p);
    if (PH + 1 < hi && sync_after(PH)) { if (PH == 0) { __syncthreads(); cg::this_grid().sync(); } else grid_barrier(p, nbar); } else __syncthreads();
  }
}
__global__ void __launch_bounds__(NT, 2) fwd_kernel(Params p, int lo, int hi) {
  extern __shared__ __attribute__((aligned(16))) char smem[];
  unsigned nbar = 0u;
  do_phase<0>(smem, p, lo, hi, nbar); do_phase<1>(smem, p, lo, hi, nbar); do_phase<2>(smem, p, lo, hi, nbar); do_phase<3>(smem, p, lo, hi, nbar); do_phase<4>(smem, p, lo, hi, nbar); do_phase<5>(smem, p, lo, hi, nbar); do_phase<6>(smem, p, lo, hi, nbar); do_phase<7>(smem, p, lo, hi, nbar); do_phase<8>(smem, p, lo, hi, nbar); do_phase<9>(smem, p, lo, hi, nbar); do_phase<10>(smem, p, lo, hi, nbar); do_phase<11>(smem, p, lo, hi, nbar); do_phase<12>(smem, p, lo, hi, nbar); do_phase<13>(smem, p, lo, hi, nbar); do_phase<14>(smem, p, lo, hi, nbar); do_phase<15>(smem, p, lo, hi, nbar); do_phase<16>(smem, p, lo, hi, nbar); do_phase<17>(smem, p, lo, hi, nbar); do_phase<18>(smem, p, lo, hi, nbar); do_phase<19>(smem, p, lo, hi, nbar); do_phase<20>(smem, p, lo, hi, nbar); do_phase<21>(smem, p, lo, hi, nbar); do_phase<22>(smem, p, lo, hi, nbar); do_phase<23>(smem, p, lo, hi, nbar); do_phase<24>(smem, p, lo, hi, nbar);
}

extern "C" void kernel_launch(void* const* d_in, const int* in_sizes, int n_in, void* d_out, int out_size, void* d_ws, size_t ws_size, hipStream_t stream) {
  constexpr size_t kDynLds = CTLW + 256 + 4096;
  static int grid_blocks = 0;
  if (!grid_blocks) {
    int dev = 0, cus = 0, per_cu = 0;
    hipGetDevice(&dev);
    hipDeviceGetAttribute(&cus, hipDeviceAttributeMultiprocessorCount, dev);
    hipFuncSetAttribute((const void*)fwd_kernel, hipFuncAttributeMaxDynamicSharedMemorySize, (int)kDynLds);
    hipOccupancyMaxActiveBlocksPerMultiprocessor(&per_cu, fwd_kernel, NT, kDynLds);
    if (per_cu > 1) per_cu = 1;
    if (per_cu < 1) per_cu = 1;
    grid_blocks = cus * per_cu;
  }
  if (ws_size < WS_NEED) { fprintf(stderr, "workspace too small: %zu\n", ws_size); return; }
  Params p{};
  for (int i = 0; i < 37; ++i) p.in[i] = (const float*)d_in[i];
  p.out = (float*)d_out; p.ws = (char*)d_ws;
  constexpr int NPH = 25;
  (void)hipMemsetAsync((char*)d_ws + WS_CTL, 0, 256, stream);
#if COOP
  int lo = 0, hi = NPH;
  void* args[] = {&p, &lo, &hi};
  hipError_t e = hipLaunchCooperativeKernel((void*)fwd_kernel, dim3(grid_blocks), dim3(NT), args, kDynLds, stream);
  if (e != hipSuccess) fprintf(stderr, "cooperative launch failed: %s (grid %d)\n", hipGetErrorString(e), grid_blocks);
#else
  for (int ph = 0; ph < NPH; ++ph) fwd_kernel<<<grid_blocks, NT, kDynLds, stream>>>(p, ph, ph + 1);
#endif
}
```
